# Optimizing an MI355X kernel written in HIP

```python
import jax, jax.numpy as jnp
from jax import lax
import numpy as np

D_MODEL = 1024
BATCH = 1
SEQ = 16384
DEPTH = 4
DEC_BATCH = 8
DEC_SEQ = 16
PAST_LEN = 2048

CHUNK = 64
N_MIXERS = 3
N_GLA = (DEPTH + 2) // 3
N_LRU = (DEPTH + 1) // 3
N_SSD = DEPTH // 3
EPS = 1e-6
CONV_W = 4

GLA_HEADS = 4
GLA_QK = D_MODEL // 2
GLA_V = D_MODEL
GLA_DK = GLA_QK // GLA_HEADS
GLA_DV = GLA_V // GLA_HEADS
GLA_RANK = 16
GLA_TAU = 16.0

LRU_WIDTH = ((4 * D_MODEL // 3 + 127) // 128) * 128
LRU_BLOCKS = 16
LRU_BW = LRU_WIDTH // LRU_BLOCKS
LRU_C = 8.0

SSD_DI = 2 * D_MODEL
SSD_HEADDIM = 64
SSD_HEADS = SSD_DI // SSD_HEADDIM
SSD_STATE = 128
SSD_GROUPS = 4
SSD_HPG = SSD_HEADS // SSD_GROUPS
SSD_CONV_DIM = SSD_DI + 2 * SSD_GROUPS * SSD_STATE

kernel_name = "hybrid_gla_rglru_ssd_streaming_step"

F32 = jnp.float32


def rmsnorm(x, w):
    xf = x.astype(F32)
    y = xf * lax.rsqrt(jnp.mean(xf * xf, axis=-1, keepdims=True) + EPS)
    return (y * w.astype(F32)).astype(x.dtype)


def causal_conv(x, buf, w, b):
    L = x.shape[1]
    xp = jnp.concatenate([buf.astype(x.dtype), x], axis=1)
    y = b
    for k in range(CONV_W):
        y = y + w[k] * xp[:, k:k + L]
    return y, xp[:, xp.shape[1] - (CONV_W - 1):]


def scan_chunk_states(s0, decay, ds):
    def step(s, inp):
        dec, d = inp
        return dec * s + d, s
    s_fin, s_prev = lax.scan(step, s0, (jnp.moveaxis(decay, 1, 0), jnp.moveaxis(ds, 1, 0)))
    return s_fin, jnp.moveaxis(s_prev, 0, 1)


def gla_mix(h, s0, w_in, w_gate_up, b_gate, norm_w, w_out):
    B, L, _ = h.shape
    proj = h @ w_in
    q, k, v, g, glr = jnp.split(
        proj, [GLA_QK, 2 * GLA_QK, 2 * GLA_QK + GLA_V, 2 * GLA_QK + 2 * GLA_V], axis=-1)
    log_a = jax.nn.log_sigmoid((glr @ w_gate_up + b_gate).astype(F32)) / GLA_TAU
    c = min(CHUNK, L)
    nc = L // c
    q = q.astype(F32).reshape(B, nc, c, GLA_HEADS, GLA_DK) * (GLA_DK ** -0.5)
    k = k.astype(F32).reshape(B, nc, c, GLA_HEADS, GLA_DK)
    v = v.astype(F32).reshape(B, nc, c, GLA_HEADS, GLA_DV)
    bcum = jnp.cumsum(log_a.reshape(B, nc, c, GLA_HEADS, GLA_DK), axis=2)
    b_last = bcum[:, :, -1:]
    q_d = q * jnp.exp(bcum)
    k_d = k * jnp.exp(-bcum)
    k_end = k * jnp.exp(b_last - bcum)
    mask = jnp.tril(jnp.ones((c, c), dtype=bool))
    att = jnp.where(mask, jnp.einsum('bnihd,bnjhd->bnhij', q_d, k_d), 0.0)
    o = jnp.einsum('bnhij,bnjhv->bnihv', att, v)
    ds = jnp.einsum('bnjhd,bnjhv->bnhdv', k_end, v)
    decay = jnp.exp(b_last[:, :, 0])[..., None]
    s_fin, s_prev = scan_chunk_states(s0.astype(F32), decay, ds)
    o = o + jnp.einsum('bnihd,bnhdv->bnihv', q_d, s_prev)
    o = o * lax.rsqrt(jnp.mean(o * o, axis=-1, keepdims=True) + EPS) * norm_w.astype(F32)
    o = o.reshape(B, L, GLA_V) * jax.nn.silu(g.astype(F32))
    return o.astype(h.dtype) @ w_out, s_fin.astype(s0.dtype)


def lru_mix(h, conv_buf, h0, w_in, conv_w, conv_b, w_a, b_a, w_x, b_x, lam, w_out):
    B, L, _ = h.shape
    xb, gate = jnp.split(h @ w_in, 2, axis=-1)
    xc, new_buf = causal_conv(xb, conv_buf, conv_w, conv_b)
    xf = xc.astype(F32)
    xblk = xf.reshape(B, L, LRU_BLOCKS, LRU_BW)
    r = jax.nn.sigmoid(jnp.einsum('blkc,kcd->blkd', xblk, w_a.astype(F32)).reshape(B, L, LRU_WIDTH) + b_a)
    i = jax.nn.sigmoid(jnp.einsum('blkc,kcd->blkd', xblk, w_x.astype(F32)).reshape(B, L, LRU_WIDTH) + b_x)
    log_a = -LRU_C * r * jax.nn.softplus(-lam.astype(F32))
    a = jnp.exp(log_a)
    u = jnp.sqrt(-jnp.expm1(2.0 * log_a)) * (i * xf)

    def combine(c1, c2):
        a1, b1 = c1
        a2, b2 = c2
        return a1 * a2, a2 * b1 + b2

    a_cum, hs = lax.associative_scan(combine, (a, u), axis=1)
    hs = hs + a_cum * h0.astype(F32)[:, None]
    y = (hs * jax.nn.silu(gate.astype(F32))).astype(h.dtype) @ w_out
    return y, new_buf, hs[:, -1].astype(h0.dtype)


def ssd_mix(h, conv_buf, s0, w_in, conv_w, conv_b, dt_bias, a_log, d_skip, norm_w, w_out):
    B, L, _ = h.shape
    z, xbc, dt = jnp.split(h @ w_in, [SSD_DI, SSD_DI + SSD_CONV_DIM], axis=-1)
    xbc, new_buf = causal_conv(xbc, conv_buf, conv_w, conv_b)
    xbc = jax.nn.silu(xbc.astype(F32))
    x, bm, cm = jnp.split(xbc, [SSD_DI, SSD_DI + SSD_GROUPS * SSD_STATE], axis=-1)
    dt = jax.nn.softplus(dt.astype(F32) + dt_bias.astype(F32))
    A = -jnp.exp(a_log.astype(F32)).reshape(SSD_GROUPS, SSD_HPG)
    c = min(CHUNK, L)
    nc = L // c
    x = x.reshape(B, nc, c, SSD_GROUPS, SSD_HPG, SSD_HEADDIM)
    bm = bm.reshape(B, nc, c, SSD_GROUPS, SSD_STATE)
    cm = cm.reshape(B, nc, c, SSD_GROUPS, SSD_STATE)
    dt = dt.reshape(B, nc, c, SSD_GROUPS, SSD_HPG)
    cum = jnp.cumsum(dt * A, axis=2)
    mask = jnp.tril(jnp.ones((c, c), dtype=bool))[:, :, None, None]
    seg = cum[:, :, :, None] - cum[:, :, None]
    decay = jnp.exp(jnp.where(mask, seg, -jnp.inf))
    cb = jnp.einsum('bnigs,bnjgs->bnijg', cm, bm)
    wgt = cb[..., None] * decay * dt[:, :, None]
    y = jnp.einsum('bnijgr,bnjgrp->bnigrp', wgt, x)
    wB = jnp.exp(cum[:, :, -1:] - cum) * dt
    ds = jnp.einsum('bnjgs,bnjgrp->bngrps', bm, x * wB[..., None])
    chunk_decay = jnp.exp(cum[:, :, -1])[..., None, None]
    s_init = s0.astype(F32).reshape(B, SSD_GROUPS, SSD_HPG, SSD_HEADDIM, SSD_STATE)
    s_fin, s_prev = scan_chunk_states(s_init, chunk_decay, ds)
    y = y + jnp.einsum('bnigs,bngrps->bnigrp', cm, s_prev) * jnp.exp(cum)[..., None]
    y = y + d_skip.astype(F32).reshape(SSD_GROUPS, SSD_HPG)[:, :, None] * x
    yz = y.reshape(B, L, SSD_DI) * jax.nn.silu(z.astype(F32))
    yz = rmsnorm(yz, norm_w)
    y_out = yz.astype(h.dtype) @ w_out
    return y_out, new_buf, s_fin.reshape(s0.shape).astype(s0.dtype)


def trunk(x, st_gla, st_lru_conv, st_lru_h, st_ssd_conv, st_ssd_h,
          norm_w, final_norm_w, gla_p, lru_p, ssd_p):
    new_gla, new_lru_conv, new_lru_h, new_ssd_conv, new_ssd_h = [], [], [], [], []
    for i in range(DEPTH):
        j = i // N_MIXERS
        h = rmsnorm(x, norm_w[i])
        if i % N_MIXERS == 0:
            y, s = gla_mix(h, st_gla[j], *[p[j] for p in gla_p])
            new_gla.append(s)
        elif i % N_MIXERS == 1:
            y, cb, s = lru_mix(h, st_lru_conv[j], st_lru_h[j], *[p[j] for p in lru_p])
            new_lru_conv.append(cb)
            new_lru_h.append(s)
        else:
            y, cb, s = ssd_mix(h, st_ssd_conv[j], st_ssd_h[j], *[p[j] for p in ssd_p])
            new_ssd_conv.append(cb)
            new_ssd_h.append(s)
        x = x + y.astype(x.dtype)
    out = rmsnorm(x, final_norm_w)
    return (out, jnp.stack(new_gla), jnp.stack(new_lru_conv), jnp.stack(new_lru_h),
            jnp.stack(new_ssd_conv), jnp.stack(new_ssd_h))


def setup_inputs(seed: int = 0) -> dict:
    key = jax.random.key(seed)
    ks = list(jax.random.split(key, 40))

    def nk():
        return ks.pop()

    def nrm(shape, scale):
        return scale * jax.random.normal(nk(), shape, F32)

    u_lru = jax.random.uniform(nk(), (N_LRU, LRU_WIDTH), F32, minval=0.9, maxval=0.999)
    a_base = u_lru ** (1.0 / LRU_C)
    dt0 = jnp.exp(jax.random.uniform(nk(), (N_SSD, SSD_HEADS), F32,
                                     minval=float(np.log(1e-3)), maxval=float(np.log(1e-1))))
    return {
        'x_prompt': nrm((BATCH, SEQ, D_MODEL), 1.0),
        'x_sample': nrm((DEC_BATCH, DEC_SEQ, D_MODEL), 1.0),
        'state_gla': nrm((N_GLA, DEC_BATCH, GLA_HEADS, GLA_DK, GLA_DV), 0.5),
        'state_lru_conv': nrm((N_LRU, DEC_BATCH, CONV_W - 1, LRU_WIDTH), 1.0),
        'state_lru_h': nrm((N_LRU, DEC_BATCH, LRU_WIDTH), 0.5),
        'state_ssd_conv': nrm((N_SSD, DEC_BATCH, CONV_W - 1, SSD_CONV_DIM), 1.0),
        'state_ssd_h': nrm((N_SSD, DEC_BATCH, SSD_HEADS, SSD_HEADDIM, SSD_STATE), 0.1),
        'norm_w': 1.0 + nrm((DEPTH, D_MODEL), 0.01),
        'final_norm_w': 1.0 + nrm((D_MODEL,), 0.01),
        'gla_w_in': nrm((N_GLA, D_MODEL, 2 * GLA_QK + 2 * GLA_V + GLA_RANK), D_MODEL ** -0.5),
        'gla_w_gate_up': nrm((N_GLA, GLA_RANK, GLA_QK), GLA_RANK ** -0.5),
        'gla_b_gate': nrm((N_GLA, GLA_QK), 0.1),
        'gla_norm_w': 1.0 + nrm((N_GLA, GLA_DV), 0.01),
        'gla_w_out': nrm((N_GLA, GLA_V, D_MODEL), GLA_V ** -0.5),
        'lru_w_in': nrm((N_LRU, D_MODEL, 2 * LRU_WIDTH), D_MODEL ** -0.5),
        'lru_conv_w': nrm((N_LRU, CONV_W, LRU_WIDTH), 0.5),
        'lru_conv_b': nrm((N_LRU, LRU_WIDTH), 0.02),
        'lru_w_a': nrm((N_LRU, LRU_BLOCKS, LRU_BW, LRU_BW), LRU_BW ** -0.5),
        'lru_b_a': nrm((N_LRU, LRU_WIDTH), 0.02),
        'lru_w_x': nrm((N_LRU, LRU_BLOCKS, LRU_BW, LRU_BW), LRU_BW ** -0.5),
        'lru_b_x': nrm((N_LRU, LRU_WIDTH), 0.02),
        'lru_lambda': jnp.log(a_base) - jnp.log1p(-a_base),
        'lru_w_out': nrm((N_LRU, LRU_WIDTH, D_MODEL), LRU_WIDTH ** -0.5),
        'ssd_w_in': nrm((N_SSD, D_MODEL, SSD_DI + SSD_CONV_DIM + SSD_HEADS), D_MODEL ** -0.5),
        'ssd_conv_w': nrm((N_SSD, CONV_W, SSD_CONV_DIM), 0.5),
        'ssd_conv_b': nrm((N_SSD, SSD_CONV_DIM), 0.02),
        'ssd_dt_bias': dt0 + jnp.log(-jnp.expm1(-dt0)),
        'ssd_a_log': jnp.log(jax.random.uniform(nk(), (N_SSD, SSD_HEADS), F32, minval=1.0, maxval=16.0)),
        'ssd_d': 1.0 + nrm((N_SSD, SSD_HEADS), 0.1),
        'ssd_norm_w': 1.0 + nrm((N_SSD, SSD_DI), 0.01),
        'ssd_w_out': nrm((N_SSD, SSD_DI, D_MODEL), SSD_DI ** -0.5),
    }


def reference(x_prompt, x_sample, state_gla, state_lru_conv, state_lru_h, state_ssd_conv, state_ssd_h,
              norm_w, final_norm_w,
              gla_w_in, gla_w_gate_up, gla_b_gate, gla_norm_w, gla_w_out,
              lru_w_in, lru_conv_w, lru_conv_b, lru_w_a, lru_b_a, lru_w_x, lru_b_x, lru_lambda, lru_w_out,
              ssd_w_in, ssd_conv_w, ssd_conv_b, ssd_dt_bias, ssd_a_log, ssd_d, ssd_norm_w, ssd_w_out):
    gla_p = (gla_w_in, gla_w_gate_up, gla_b_gate, gla_norm_w, gla_w_out)
    lru_p = (lru_w_in, lru_conv_w, lru_conv_b, lru_w_a, lru_b_a, lru_w_x, lru_b_x, lru_lambda, lru_w_out)
    ssd_p = (ssd_w_in, ssd_conv_w, ssd_conv_b, ssd_dt_bias, ssd_a_log, ssd_d, ssd_norm_w, ssd_w_out)
    dt = x_prompt.dtype
    zero_gla = jnp.zeros((N_GLA, BATCH, GLA_HEADS, GLA_DK, GLA_DV), dt)
    zero_lru_conv = jnp.zeros((N_LRU, BATCH, CONV_W - 1, LRU_WIDTH), dt)
    zero_lru_h = jnp.zeros((N_LRU, BATCH, LRU_WIDTH), dt)
    zero_ssd_conv = jnp.zeros((N_SSD, BATCH, CONV_W - 1, SSD_CONV_DIM), dt)
    zero_ssd_h = jnp.zeros((N_SSD, BATCH, SSD_HEADS, SSD_HEADDIM, SSD_STATE), dt)
    y_prompt, gla_p_new, lru_conv_p_new, lru_h_p_new, ssd_conv_p_new, ssd_h_p_new = trunk(
        x_prompt, zero_gla, zero_lru_conv, zero_lru_h, zero_ssd_conv, zero_ssd_h,
        norm_w, final_norm_w, gla_p, lru_p, ssd_p)
    y_sample, gla_s_new, lru_conv_s_new, lru_h_s_new, ssd_conv_s_new, ssd_h_s_new = trunk(
        x_sample, state_gla, state_lru_conv, state_lru_h, state_ssd_conv, state_ssd_h,
        norm_w, final_norm_w, gla_p, lru_p, ssd_p)
    return (y_prompt, y_sample,
            gla_p_new, lru_conv_p_new, lru_h_p_new, ssd_conv_p_new, ssd_h_p_new,
            gla_s_new, lru_conv_s_new, lru_h_s_new, ssd_conv_s_new, ssd_h_s_new)
```

```cpp
#include <hip/hip_runtime.h>
#include <hip/hip_cooperative_groups.h>
#include <cstdio>
namespace cg = cooperative_groups;

#ifndef DUPMASK
#define DUPMASK 0u
#endif
#ifndef PREMASK
#define PREMASK 0u
#endif
#ifndef ONE_LAUNCH
#define ONE_LAUNCH 1
#endif

typedef unsigned short bf16_t;
using bf16x8 = __attribute__((ext_vector_type(8))) short;
using f32x4 = __attribute__((ext_vector_type(4))) float;
using u32x4 = __attribute__((ext_vector_type(4))) unsigned;

constexpr int T_P = 16384, T_S = 128, T = 16512;
constexpr int NCH = 264;
constexpr int NSEG_G = 32, NSEGT_G = NSEG_G + 8;
constexpr int NSEG_S = 16, NSEGT_S = NSEG_S + 8;
constexpr int LW = 1408;
constexpr float EPS = 1e-6f;

constexpr size_t O_YP = 0;
constexpr size_t O_YS = O_YP + (size_t)T_P * 1024;
constexpr size_t O_GLA_P = O_YS + (size_t)T_S * 1024;
constexpr size_t O_LCONV_P = O_GLA_P + (size_t)2 * 4 * 128 * 256;
constexpr size_t O_LH_P = O_LCONV_P + 3 * LW;
constexpr size_t O_SCONV_P = O_LH_P + LW;
constexpr size_t O_SH_P = O_SCONV_P + 3 * 3072;
constexpr size_t O_GLA_S = O_SH_P + (size_t)32 * 64 * 128;
constexpr size_t O_LCONV_S = O_GLA_S + (size_t)2 * 8 * 4 * 128 * 256;
constexpr size_t O_LH_S = O_LCONV_S + 8 * 3 * LW;
constexpr size_t O_SCONV_S = O_LH_S + 8 * LW;
constexpr size_t O_SH_S = O_SCONV_S + 8 * 3 * 3072;

constexpr size_t OFF_WIN = 0;
constexpr size_t OFF_WOUT = OFF_WIN + (size_t)5248 * 1024 * 2;
constexpr size_t OFF_WOUT1 = OFF_WOUT + (size_t)1024 * 2048 * 2;
constexpr size_t OFF_WG = OFF_WOUT1 + (size_t)1024 * 2048 * 2;
constexpr size_t OFF_H = OFF_WG + (size_t)2 * 16 * 96 * 96 * 2;
constexpr size_t OFF_BIG = OFF_H + (size_t)T * 1024 * 2;
constexpr size_t G_QD = OFF_BIG;
constexpr size_t G_KD = G_QD + (size_t)T * 512 * 2;
constexpr size_t G_KDT = G_KD + (size_t)T * 512 * 2;
constexpr size_t G_VT = G_KDT + (size_t)NCH * 512 * 64 * 2;
constexpr size_t G_G = G_VT + (size_t)NCH * 1024 * 64 * 2;
constexpr size_t G_O = G_G + (size_t)T * 1024 * 2;
constexpr size_t G_GLR = G_O + (size_t)T * 1024 * 2;
constexpr size_t G_SSQ = G_GLR + (size_t)T * 16 * 4;
constexpr size_t G_DEC = G_SSQ + (size_t)T * 16 * 4;
constexpr size_t G_SSEG = G_DEC + (size_t)NCH * 512 * 4;
constexpr size_t G_DSEG = G_SSEG + (size_t)NSEG_G * 4 * 256 * 128 * 4;
constexpr size_t G_END = G_DSEG + (size_t)NSEG_G * 512 * 4;
constexpr size_t L_XB = OFF_BIG;
constexpr size_t L_GATE = L_XB + (size_t)T * LW * 2;
constexpr size_t L_Y = L_GATE + (size_t)T * LW * 2;
constexpr size_t L_ASEG = L_Y + (size_t)T * LW * 2;
constexpr size_t L_HSEG = L_ASEG + (size_t)NCH * LW * 4;
constexpr size_t L_END = L_HSEG + (size_t)NCH * LW * 4;
constexpr size_t S_Z = OFF_BIG;
constexpr size_t S_XBCT = S_Z + (size_t)T * 2048 * 2;
constexpr size_t S_DT = S_XBCT + (size_t)NCH * 3072 * 64 * 2;
constexpr size_t S_TAIL = S_DT + (size_t)T * 32 * 4;
constexpr size_t S_SSQ = S_TAIL + (size_t)NCH * 3072 * 4 * 2;
constexpr size_t S_SSEG = S_SSQ + (size_t)T * 32 * 4;
constexpr size_t S_CDSEG = S_SSEG + (size_t)NSEG_S * 32 * 64 * 128 * 4;
constexpr size_t S_END = S_CDSEG + 4096;
constexpr size_t S_BRM = OFF_H;
constexpr size_t S_CRM = OFF_H + (size_t)T * 512 * 2;
static_assert(G_END <= 268435456ull - 4096 && L_END <= 268435456ull - 4096 && S_END <= 268435456ull - 4096, "ws overflow");

constexpr int SMEM_BYTES = 81920;
constexpr int SMEM_XB = 81856;

struct Params {
  const float* in[31];
  float* out;
  char* ws;
};

__device__ __forceinline__ int otid() { int t = threadIdx.x; asm volatile("" : "+v"(t)); return t; }
__device__ __forceinline__ bf16_t f2bf(float f) {
  unsigned u = __float_as_uint(f);
  u += 0x7fffu + ((u >> 16) & 1u);
  return (bf16_t)(u >> 16);
}
__device__ __forceinline__ float bf2f(bf16_t b) { return __uint_as_float(((unsigned)b) << 16); }
__device__ __forceinline__ unsigned pack2(float a, float b) { return (unsigned)f2bf(a) | ((unsigned)f2bf(b) << 16); }
__device__ __forceinline__ float lo_bf(unsigned w) { return __uint_as_float(w << 16); }
__device__ __forceinline__ float hi_bf(unsigned w) { return __uint_as_float(w & 0xffff0000u); }
__device__ __forceinline__ float sigmoid_(float x) { return __builtin_amdgcn_rcpf(1.f + __expf(-x)); }
__device__ __forceinline__ float silu_(float x) { return x * __builtin_amdgcn_rcpf(1.f + __expf(-x)); }
__device__ __forceinline__ float softplus_(float x) { return fmaxf(x, 0.f) + log1pf(__expf(-fabsf(x))); }

__device__ __forceinline__ void tok2chunk(int t, int& c, int& j) {
  if (t < T_P) { c = t >> 6; j = t & 63; }
  else { int u = t - T_P; c = 256 + (u >> 4); j = u & 15; }
}
__device__ __forceinline__ void chunk_info(int c, int& t0, int& len) {
  if (c < 256) { t0 = c * 64; len = 64; }
  else { t0 = T_P + (c - 256) * 16; len = 16; }
}
__device__ __forceinline__ void seg_info(int sg, int nseg, int& c0, int& nch, int& b) {
  if (sg < nseg) { const int cps = 256 / nseg; c0 = sg * cps; nch = cps; b = -1; }
  else { c0 = 256 + (sg - nseg); nch = 1; b = sg - nseg; }
}

template <int MT, int NT, int KS>
__device__ __forceinline__ void mma_lds(f32x4 (&acc)[MT][NT], const bf16_t* A, int lda, const bf16_t* B, int ldb, int r, int q) {
#pragma unroll
  for (int ks = 0; ks < KS; ++ks) {
    bf16x8 af[MT], bfr[NT];
#pragma unroll
    for (int mi = 0; mi < MT; ++mi) af[mi] = *(const bf16x8*)(A + (mi * 16 + r) * lda + ks * 32 + q * 8);
#pragma unroll
    for (int ni = 0; ni < NT; ++ni) bfr[ni] = *(const bf16x8*)(B + (ni * 16 + r) * ldb + ks * 32 + q * 8);
#pragma unroll
    for (int mi = 0; mi < MT; ++mi)
#pragma unroll
      for (int ni = 0; ni < NT; ++ni)
        acc[mi][ni] = __builtin_amdgcn_mfma_f32_16x16x32_bf16(af[mi], bfr[ni], acc[mi][ni], 0, 0, 0);
  }
}

__device__ __forceinline__ void ph_convT(const float* __restrict__ src, int K, int N, int Npad, bf16_t* __restrict__ dst,
                         const float* __restrict__ kscale, char* smem) {
  float* tile = (float*)smem;
  const int tid = otid();
  const int ktn = K / 64, ntn = Npad / 64;
  for (int it = blockIdx.x; it < ktn * ntn; it += gridDim.x) {
    const int kt = it / ntn, nt = it - kt * ntn;
    const int k0 = kt * 64, n0 = nt * 64;
    __syncthreads();
    {
      const int nn = tid & 63, n = n0 + nn;
#pragma unroll 4
      for (int i = 0; i < 16; ++i) {
        const int kk = (tid >> 6) + 4 * i;
        float v = 0.f;
        if (n < N) {
          v = src[(size_t)(k0 + kk) * N + n];
          if (kscale) v *= kscale[k0 + kk];
        }
        tile[kk * 65 + nn] = v;
      }
    }
    __syncthreads();
#pragma unroll
    for (int i = 0; i < 2; ++i) {
      const int nn = (tid >> 3) + 32 * i, kk = (tid & 7) * 8;
      uint4 u;
      u.x = pack2(tile[(kk + 0) * 65 + nn], tile[(kk + 1) * 65 + nn]);
      u.y = pack2(tile[(kk + 2) * 65 + nn], tile[(kk + 3) * 65 + nn]);
      u.z = pack2(tile[(kk + 4) * 65 + nn], tile[(kk + 5) * 65 + nn]);
      u.w = pack2(tile[(kk + 6) * 65 + nn], tile[(kk + 7) * 65 + nn]);
      *(uint4*)(dst + (size_t)(n0 + nn) * K + k0 + kk) = u;
    }
  }
}

__device__ __forceinline__ void ph_conv_gate(const float* __restrict__ w, bf16_t* __restrict__ dst) {
  for (int idx = blockIdx.x * 256 + otid(); idx < 16 * 96 * 96; idx += gridDim.x * 256) {
    const int k = idx / 9216, rem = idx - k * 9216, co = rem / 96, ci = rem - co * 96;
    float v = 0.f;
    if (co < 88 && ci < 88) v = w[(k * 88 + ci) * 88 + co];
    dst[idx] = f2bf(v);
  }
}

__device__ __forceinline__ void ph_norm(const float* __restrict__ xp, const float* __restrict__ xs, const float* __restrict__ w,
                        bf16_t* __restrict__ h, float* xcopy) {
  const int lane = otid() & 63, wave = otid() >> 6;
  for (int row = blockIdx.x * 4 + wave; row < T; row += gridDim.x * 4) {
    const float* src = row < T_P ? xp + (size_t)row * 1024 : xs + (size_t)(row - T_P) * 1024;
    float4 v[4];
    float ss = 0.f;
#pragma unroll
    for (int i = 0; i < 4; ++i) {
      v[i] = *(const float4*)(src + i * 256 + lane * 4);
      ss += v[i].x * v[i].x + v[i].y * v[i].y + v[i].z * v[i].z + v[i].w * v[i].w;
    }
#pragma unroll
    for (int off = 32; off >= 1; off >>= 1) ss += __shfl_xor(ss, off);
    const float rs = rsqrtf(ss * (1.f / 1024.f) + EPS);
    if (xcopy != nullptr && row >= T_P) {
#pragma unroll
      for (int i = 0; i < 4; ++i) *(float4*)(xcopy + (size_t)row * 1024 + i * 256 + lane * 4) = v[i];
    }
#pragma unroll
    for (int i = 0; i < 4; ++i) {
      const float4 ww = *(const float4*)(w + i * 256 + lane * 4);
      uint2 o;
      o.x = pack2(v[i].x * rs * ww.x, v[i].y * rs * ww.y);
      o.y = pack2(v[i].z * rs * ww.z, v[i].w * rs * ww.w);
      *(uint2*)(h + (size_t)row * 1024 + i * 256 + lane * 4) = o;
    }
  }
}

__device__ __forceinline__ void ph_final_norm(float* __restrict__ x, const float* __restrict__ w) {
  const int lane = otid() & 63, wave = otid() >> 6;
  for (int row = blockIdx.x * 4 + wave; row < T; row += gridDim.x * 4) {
    float* src = x + (size_t)row * 1024;
    float4 v[4];
    float ss = 0.f;
#pragma unroll
    for (int i = 0; i < 4; ++i) {
      v[i] = *(const float4*)(src + i * 256 + lane * 4);
      ss += v[i].x * v[i].x + v[i].y * v[i].y + v[i].z * v[i].z + v[i].w * v[i].w;
    }
#pragma unroll
    for (int off = 32; off >= 1; off >>= 1) ss += __shfl_xor(ss, off);
    const float rs = rsqrtf(ss * (1.f / 1024.f) + EPS);
#pragma unroll
    for (int i = 0; i < 4; ++i) {
      const float4 ww = *(const float4*)(w + i * 256 + lane * 4);
      float4 o;
      o.x = v[i].x * rs * ww.x; o.y = v[i].y * rs * ww.y; o.z = v[i].z * rs * ww.z; o.w = v[i].w * rs * ww.w;
      *(float4*)(src + i * 256 + lane * 4) = o;
    }
  }
}

#define GLDS16(gp, lp) __builtin_amdgcn_global_load_lds((const unsigned*)(gp), (unsigned*)(lp), 16, 0, 0)
template <class Epi, bool SWP>
__device__ __forceinline__ void gemm_tile(const bf16_t* __restrict__ A, int lda, const bf16_t* __restrict__ Bt, int ldb, int nk,
                                          int tm, int tn, Epi epi, char* smem) {
  const int tid = otid(), lane = tid & 63, wave = tid >> 6;
  const int wm = wave >> 1, wn = wave & 1, r = lane & 15, q = lane >> 4;
  const int srow = tid >> 2, skc = (tid & 3) * 8;
  char* l0 = smem + tid * 16;
  f32x4 acc[32];
#pragma unroll
  for (int i = 0; i < 32; ++i) acc[i] = f32x4{0.f, 0.f, 0.f, 0.f};
  const int a_off = wm * 8192 + r * 64 + q * 16;
  const int b_off = 16384 + wn * 4096 + r * 64 + q * 16;
  const int b_offp = 16384 + wn * 4096 + (8 * (r >> 2) + (r & 3)) * 64 + q * 16;
  const bf16_t* Ag = A + (size_t)(tm * 256 + srow) * lda + skc;
  const bf16_t* Bg = Bt + (size_t)(tn * 128 + srow) * ldb + skc;
  const size_t a64 = (size_t)64 * lda, b64 = (size_t)64 * ldb;
#define G_ISSUE(t_, st_)                                   \
  {                                                        \
    const int ko_ = (t_) * 32;                             \
    char* lb_ = l0 + (st_) * 24576;                        \
    GLDS16(Ag + ko_, lb_);                                 \
    GLDS16(Ag + a64 + ko_, lb_ + 4096);                    \
    GLDS16(Ag + 2 * a64 + ko_, lb_ + 8192);                \
    GLDS16(Ag + 3 * a64 + ko_, lb_ + 12288);               \
    GLDS16(Bg + ko_, lb_ + 16384);                         \
    GLDS16(Bg + b64 + ko_, lb_ + 20480);                   \
  }
#define G_STEP(t_, st_)                                                                                   \
  {                                                                                                       \
    const int tt_ = (t_);                                                                                 \
    if (tt_ + 1 < nk) asm volatile("s_waitcnt vmcnt(6) lgkmcnt(0)\n\ts_barrier" ::: "memory");            \
    else asm volatile("s_waitcnt vmcnt(0) lgkmcnt(0)\n\ts_barrier" ::: "memory");                         \
    if (tt_ + 2 < nk) G_ISSUE(tt_ + 2, ((st_) + 2) % 3)                                                   \
    const char* sb_ = smem + (st_) * 24576;                                                               \
    bf16x8 af_[8], bf_[4];                                                                                \
    _Pragma("unroll") for (int mi = 0; mi < 8; ++mi) af_[mi] = *(const bf16x8*)(sb_ + a_off + mi * 1024);  \
    _Pragma("unroll") for (int ni = 0; ni < 4; ++ni)                                                      \
      bf_[ni] = *(const bf16x8*)(sb_ + (SWP ? b_offp + (ni >> 1) * 2048 + (ni & 1) * 256 : b_off + ni * 1024)); \
    __builtin_amdgcn_s_setprio(1);                                                                        \
    _Pragma("unroll") for (int mi = 0; mi < 8; ++mi)                                                      \
    _Pragma("unroll") for (int ni = 0; ni < 4; ++ni)                                                      \
      acc[mi * 4 + ni] = SWP ? __builtin_amdgcn_mfma_f32_16x16x32_bf16(bf_[ni], af_[mi], acc[mi * 4 + ni], 0, 0, 0) \
                             : __builtin_amdgcn_mfma_f32_16x16x32_bf16(af_[mi], bf_[ni], acc[mi * 4 + ni], 0, 0, 0); \
    __builtin_amdgcn_s_setprio(0);                                                                        \
  }
  asm volatile("s_waitcnt vmcnt(0)" ::: "memory");
  G_ISSUE(0, 0)
  G_ISSUE(1, 1)
  {
    int st = 0;
    for (int t = 0; t < nk; ++t) {
      G_STEP(t, st)
      st = st == 2 ? 0 : st + 1;
    }
  }
#undef G_STEP
#undef G_ISSUE
  epi.begin(tm * 256 + wm * 128, lane);
#pragma unroll
  for (int mi = 0; mi < 8; ++mi)
#pragma unroll
    for (int ni = 0; ni < 4; ++ni) {
      if (SWP) {
        if ((ni & 1) == 0)
          epi.rowvec8(tm * 256 + wm * 128 + mi * 16 + r, tn * 128 + wn * 64 + (ni >> 1) * 32 + q * 8, acc[mi * 4 + ni], acc[mi * 4 + ni + 1]);
      } else epi.colvec(tm * 256 + wm * 128 + mi * 16 + q * 4, tn * 128 + wn * 64 + ni * 16 + r, acc[mi * 4 + ni]);
    }
}

template <class Epi>
__device__ __forceinline__ void gemm_main(const bf16_t* __restrict__ A, int lda, const bf16_t* __restrict__ Bt, int ldb, int K,
                                          int Ntiles, Epi epi, char* smem) {
  const int nk = K / 32;
  const int total = 64 * Ntiles;
  for (int sidx = blockIdx.x; sidx < total; sidx += gridDim.x) {
    const int u = sidx >> 3;
    const int tn = u >> 3, tm = (sidx & 7) * 8 + (u & 7);
    if (epi.swapped_col(tn * 128)) gemm_tile<Epi, true>(A, lda, Bt, ldb, nk, tm, tn, epi, smem);
    else gemm_tile<Epi, false>(A, lda, Bt, ldb, nk, tm, tn, epi, smem);
  }
}

template <class Epi>
__device__ __forceinline__ void gemm_side(const bf16_t* __restrict__ A, int lda, const bf16_t* __restrict__ Bt, int ldb, int K,
                                          int N, int Nfull, Epi epi) {
  const int tid = otid(), lane = tid & 63, wave = tid >> 6, r = lane & 15, q = lane >> 4;
  const int ncg = (N + 31) >> 5, cg_left0 = Nfull >> 5, nleft = ncg - cg_left0;
  constexpr int KS = Epi::KSPLIT;
  const int njobs0 = ncg + nleft * 128, njobs = njobs0 * KS;
  const int Kpart = K / KS;
  for (int jx = blockIdx.x; jx < njobs; jx += gridDim.x) {
    const int ks = KS > 1 ? jx / njobs0 : 0, j = jx - ks * njobs0;
    int row0, cg;
    if (j < ncg) { row0 = T_P; cg = j; }
    else { const int jj = j - ncg, rt = jj / nleft; row0 = rt * 128; cg = cg_left0 + (jj - rt * nleft); }
    const int col0 = cg * 32;
    const bool swp = epi.swapped_col(col0);
    f32x4 acc[4];
#pragma unroll
    for (int i = 0; i < 4; ++i) acc[i] = f32x4{0.f, 0.f, 0.f, 0.f};
    const bf16_t* Ap = A + (size_t)(row0 + 32 * wave + r) * lda + q * 8 + ks * Kpart;
    const bf16_t* Bp = Bt + (size_t)(col0 + r) * ldb + q * 8 + ks * Kpart;
    const size_t a16 = (size_t)16 * lda, b16 = (size_t)16 * ldb;
    if (swp) {
#pragma unroll 4
      for (int k0 = 0; k0 < Kpart; k0 += 32) {
        const bf16x8 a0 = *(const bf16x8*)(Ap + k0), a1 = *(const bf16x8*)(Ap + a16 + k0);
        const bf16x8 b0 = *(const bf16x8*)(Bp + k0), b1 = *(const bf16x8*)(Bp + b16 + k0);
        acc[0] = __builtin_amdgcn_mfma_f32_16x16x32_bf16(b0, a0, acc[0], 0, 0, 0);
        acc[1] = __builtin_amdgcn_mfma_f32_16x16x32_bf16(b1, a0, acc[1], 0, 0, 0);
        acc[2] = __builtin_amdgcn_mfma_f32_16x16x32_bf16(b0, a1, acc[2], 0, 0, 0);
        acc[3] = __builtin_amdgcn_mfma_f32_16x16x32_bf16(b1, a1, acc[3], 0, 0, 0);
      }
    } else {
#pragma unroll 4
      for (int k0 = 0; k0 < Kpart; k0 += 32) {
        const bf16x8 a0 = *(const bf16x8*)(Ap + k0), a1 = *(const bf16x8*)(Ap + a16 + k0);
        const bf16x8 b0 = *(const bf16x8*)(Bp + k0), b1 = *(const bf16x8*)(Bp + b16 + k0);
        acc[0] = __builtin_amdgcn_mfma_f32_16x16x32_bf16(a0, b0, acc[0], 0, 0, 0);
        acc[1] = __builtin_amdgcn_mfma_f32_16x16x32_bf16(a0, b1, acc[1], 0, 0, 0);
        acc[2] = __builtin_amdgcn_mfma_f32_16x16x32_bf16(a1, b0, acc[2], 0, 0, 0);
        acc[3] = __builtin_amdgcn_mfma_f32_16x16x32_bf16(a1, b1, acc[3], 0, 0, 0);
      }
    }
    epi.begin(row0 + 32 * wave, lane);
#pragma unroll
    for (int mi = 0; mi < 2; ++mi)
#pragma unroll
      for (int ni = 0; ni < 2; ++ni) {
        if (KS > 1) epi.rowvec_acc(row0 + 32 * wave + mi * 16 + r, col0 + ni * 16 + q * 4, acc[mi * 2 + ni]);
        else if (swp) epi.rowvec(row0 + 32 * wave + mi * 16 + r, col0 + ni * 16 + q * 4, acc[mi * 2 + ni]);
        else epi(row0 + 32 * wave + mi * 16 + q * 4, col0 + ni * 16 + r, acc[mi * 2 + ni]);
      }
  }
}

template <class Epi>
__device__ __forceinline__ void gemm_phase(const bf16_t* __restrict__ A, int lda, const bf16_t* __restrict__ Bt, int ldb, int K,
                                           int N, Epi epi, char* smem) {
  gemm_main(A, lda, Bt, ldb, K, N >> 7, epi, smem);
  gemm_side(A, lda, Bt, ldb, K, N, (N >> 7) << 7, epi);
}

struct EpiGlaIn {
  static constexpr int KSPLIT = 1;
  __device__ __forceinline__ void rowvec_acc(int, int, f32x4) const {}
  bf16_t *qd, *kd, *vT, *g;
  float* glr;
  __device__ __forceinline__ void begin(int, int) {}
  __device__ __forceinline__ bool swapped_col(int c) const { return c < 1024 || (c >= 2048 && c < 3072); }
  __device__ __forceinline__ void colvec(int row0, int col, f32x4 v) const {
    uint2 u;
    u.x = pack2(v[0], v[1]);
    u.y = pack2(v[2], v[3]);
    *(uint2*)(vT + ((size_t)(row0 >> 6) * 1024 + (col - 1024)) * 64 + (row0 & 63)) = u;
  }
  __device__ __forceinline__ void rowvec8(int row, int col0, f32x4 v, f32x4 w) const {
    const float sc = col0 < 512 ? 0.08838834764831845f : 1.f;
    const u32x4 u = u32x4{pack2(v[0] * sc, v[1] * sc), pack2(v[2] * sc, v[3] * sc), pack2(w[0] * sc, w[1] * sc), pack2(w[2] * sc, w[3] * sc)};
    bf16_t* dst = col0 < 512 ? qd + (size_t)row * 512 + col0
                : col0 < 1024 ? kd + (size_t)row * 512 + (col0 - 512) : g + (size_t)row * 1024 + (col0 - 2048);
    *(u32x4*)dst = u;
  }
  __device__ __forceinline__ void rowvec(int row, int col0, f32x4 v) const {
    uint2 u;
    if (col0 < 512) {
      const float sc = 0.08838834764831845f;
      u.x = pack2(v[0] * sc, v[1] * sc); u.y = pack2(v[2] * sc, v[3] * sc);
      *(uint2*)(qd + (size_t)row * 512 + col0) = u;
    } else if (col0 < 1024) {
      u.x = pack2(v[0], v[1]); u.y = pack2(v[2], v[3]);
      *(uint2*)(kd + (size_t)row * 512 + (col0 - 512)) = u;
    } else {
      u.x = pack2(v[0], v[1]); u.y = pack2(v[2], v[3]);
      *(uint2*)(g + (size_t)row * 1024 + (col0 - 2048)) = u;
    }
  }
  __device__ __forceinline__ void operator()(int row0, int col, f32x4 v) const {
    if (col < 512) {
#pragma unroll
      for (int jj = 0; jj < 4; ++jj) qd[(size_t)(row0 + jj) * 512 + col] = f2bf(v[jj] * 0.08838834764831845f);
    } else if (col < 1024) {
#pragma unroll
      for (int jj = 0; jj < 4; ++jj) kd[(size_t)(row0 + jj) * 512 + (col - 512)] = f2bf(v[jj]);
    } else if (col < 2048) {
      int c, j;
      tok2chunk(row0, c, j);
      uint2 u;
      u.x = pack2(v[0], v[1]);
      u.y = pack2(v[2], v[3]);
      *(uint2*)(vT + ((size_t)c * 1024 + (col - 1024)) * 64 + j) = u;
    } else if (col < 3072) {
#pragma unroll
      for (int jj = 0; jj < 4; ++jj) g[(size_t)(row0 + jj) * 1024 + (col - 2048)] = f2bf(v[jj]);
    } else if (col < 3088) {
#pragma unroll
      for (int jj = 0; jj < 4; ++jj) glr[(size_t)(row0 + jj) * 16 + (col - 3072)] = v[jj];
    }
  }
};

struct EpiLruIn {
  static constexpr int KSPLIT = 1;
  __device__ __forceinline__ void rowvec_acc(int, int, f32x4) const {}
  bf16_t *xb, *gate;
  __device__ __forceinline__ void begin(int, int) {}
  __device__ __forceinline__ bool swapped_col(int) const { return true; }
  __device__ __forceinline__ void colvec(int, int, f32x4) const {}
  __device__ __forceinline__ void rowvec8(int row, int col0, f32x4 v, f32x4 w) const {
    bf16_t* dst = col0 < LW ? xb + col0 : gate + (col0 - LW);
    *(u32x4*)(dst + (size_t)row * LW) = u32x4{pack2(v[0], v[1]), pack2(v[2], v[3]), pack2(w[0], w[1]), pack2(w[2], w[3])};
  }
  __device__ __forceinline__ void rowvec(int row, int col0, f32x4 v) const {
    bf16_t* dst = col0 < LW ? xb + col0 : gate + (col0 - LW);
    uint2 u;
    u.x = pack2(v[0], v[1]); u.y = pack2(v[2], v[3]);
    *(uint2*)(dst + (size_t)row * LW) = u;
  }
  __device__ __forceinline__ void operator()(int row0, int col, f32x4 v) const {
    bf16_t* dst = col < LW ? xb + col : gate + (col - LW);
#pragma unroll
    for (int jj = 0; jj < 4; ++jj) dst[(size_t)(row0 + jj) * LW] = f2bf(v[jj]);
  }
};

struct EpiSsdIn {
  static constexpr int KSPLIT = 1;
  __device__ __forceinline__ void rowvec_acc(int, int, f32x4) const {}
  bf16_t *z, *xbcT, *tails;
  float* dt;
  const float* dt_bias;
  __device__ __forceinline__ void begin(int, int) {}
  __device__ __forceinline__ bool swapped_col(int c) const { return c < 2048; }
  __device__ __forceinline__ void colvec(int row0, int col, f32x4 v) const {
    const int c = row0 >> 6, j = row0 & 63, cc = col - 2048;
    uint2 u;
    u.x = pack2(v[0], v[1]);
    u.y = pack2(v[2], v[3]);
    *(uint2*)(xbcT + ((size_t)c * 3072 + cc) * 64 + j) = u;
    if (j == 60) *(uint2*)(tails + ((size_t)c * 3072 + cc) * 4) = u;
  }
  __device__ __forceinline__ void rowvec8(int row, int col0, f32x4 v, f32x4 w) const {
    *(u32x4*)(z + (size_t)row * 2048 + col0) = u32x4{pack2(v[0], v[1]), pack2(v[2], v[3]), pack2(w[0], w[1]), pack2(w[2], w[3])};
  }
  __device__ __forceinline__ void rowvec(int row, int col0, f32x4 v) const {
    uint2 u;
    u.x = pack2(v[0], v[1]); u.y = pack2(v[2], v[3]);
    *(uint2*)(z + (size_t)row * 2048 + col0) = u;
  }
  __device__ __forceinline__ void operator()(int row0, int col, f32x4 v) const {
    if (col < 2048) {
#pragma unroll
      for (int jj = 0; jj < 4; ++jj) z[(size_t)(row0 + jj) * 2048 + col] = f2bf(v[jj]);
    } else if (col < 5120) {
      int c, j;
      tok2chunk(row0, c, j);
      const int len = c < 256 ? 64 : 16;
      const int cc = col - 2048;
      uint2 u;
      u.x = pack2(v[0], v[1]);
      u.y = pack2(v[2], v[3]);
      *(uint2*)(xbcT + ((size_t)c * 3072 + cc) * 64 + j) = u;
      if (j == len - 4) *(uint2*)(tails + ((size_t)c * 3072 + cc) * 4) = u;
    } else if (col < 5152) {
      const int hd = col - 5120;
#pragma unroll
      for (int jj = 0; jj < 4; ++jj) dt[(size_t)(row0 + jj) * 32 + hd] = v[jj];
    }
  }
};

struct EpiResid {
  const float *xin_p, *xin_s;
  float* xout;
  static constexpr int KSPLIT = 4;
  __device__ __forceinline__ void rowvec_acc(int row, int col0, f32x4 v) const {
    float* dst = xout + (size_t)row * 1024 + col0;
#pragma unroll
    for (int e = 0; e < 4; ++e) (void)__hip_atomic_fetch_add(dst + e, v[e], __ATOMIC_RELAXED, __HIP_MEMORY_SCOPE_AGENT);
  }
  __device__ __forceinline__ void begin(int, int) {}
  __device__ __forceinline__ bool swapped_col(int) const { return true; }
  __device__ __forceinline__ void colvec(int, int, f32x4) const {}
  __device__ __forceinline__ void rowvec8(int row, int col0, f32x4 v, f32x4 w) const {
    rowvec(row, col0, v);
    rowvec(row, col0 + 4, w);
  }
  __device__ __forceinline__ void rowvec(int row, int col0, f32x4 v) const {
    const float* src = row < T_P ? xin_p + (size_t)row * 1024 : xin_s + (size_t)(row - T_P) * 1024;
    const float4 x = *(const float4*)(src + col0);
    float4 o;
    o.x = x.x + v[0]; o.y = x.y + v[1]; o.z = x.z + v[2]; o.w = x.w + v[3];
    *(float4*)(xout + (size_t)row * 1024 + col0) = o;
  }
  __device__ __forceinline__ void operator()(int row0, int col, f32x4 v) const {
#pragma unroll
    for (int jj = 0; jj < 4; ++jj) {
      const int row = row0 + jj;
      const float* src = row < T_P ? xin_p + (size_t)row * 1024 : xin_s + (size_t)(row - T_P) * 1024;
      xout[(size_t)row * 1024 + col] = src[col] + v[jj];
    }
  }
};

struct EpiResidScaled {
  static constexpr int KSPLIT = 4;
  __device__ __forceinline__ void rowvec_acc(int row, int col0, f32x4 v) const {
    const int o_ = row - rowbase;
    const float s0_ = __shfl(rs, o_ & 63), s1_ = __shfl(rs1, o_ & 63);
    const float sc = o_ < 64 ? s0_ : s1_;
    float* dst = xout + (size_t)row * 1024 + col0;
#pragma unroll
    for (int e = 0; e < 4; ++e) (void)__hip_atomic_fetch_add(dst + e, sc * v[e], __ATOMIC_RELAXED, __HIP_MEMORY_SCOPE_AGENT);
  }
  const float *xin_p, *xin_s;
  float* xout;
  const float* ssq;
  float rs, rs1;
  int rowbase;
  __device__ __forceinline__ bool swapped_col(int) const { return true; }
  __device__ __forceinline__ void colvec(int, int, f32x4) const {}
  __device__ __forceinline__ void rowvec8(int row, int col0, f32x4 v, f32x4 w) const {
    rowvec(row, col0, v);
    rowvec(row, col0 + 4, w);
  }
  __device__ __forceinline__ void rowvec(int row, int col0, f32x4 v) const {
    const int o_ = row - rowbase;
    const float s0_ = __shfl(rs, o_ & 63), s1_ = __shfl(rs1, o_ & 63);
    const float sc = o_ < 64 ? s0_ : s1_;
    const float* src = row < T_P ? xin_p + (size_t)row * 1024 : xin_s + (size_t)(row - T_P) * 1024;
    const float4 x = *(const float4*)(src + col0);
    float4 o;
    o.x = x.x + sc * v[0]; o.y = x.y + sc * v[1]; o.z = x.z + sc * v[2]; o.w = x.w + sc * v[3];
    *(float4*)(xout + (size_t)row * 1024 + col0) = o;
  }
  __device__ __forceinline__ void begin(int rb, int lane) {
    rowbase = rb;
    float rr[2];
#pragma unroll
    for (int hh = 0; hh < 2; ++hh) {
      const int row = rb + hh * 64 + lane;
      float sacc = 0.f;
      if (row < T) {
        const float4* p = (const float4*)(ssq + (size_t)row * 32);
#pragma unroll
        for (int i = 0; i < 8; ++i) {
          const float4 v = p[i];
          sacc += v.x + v.y + v.z + v.w;
        }
      }
      rr[hh] = rsqrtf(sacc * (1.f / 2048.f) + EPS);
    }
    rs = rr[0];
    rs1 = rr[1];
  }
  __device__ __forceinline__ void operator()(int row0, int col, f32x4 v) const {
#pragma unroll
    for (int jj = 0; jj < 4; ++jj) {
      const int row = row0 + jj;
      const int o_ = row - rowbase;
      const float s0_ = __shfl(rs, o_ & 63), s1_ = __shfl(rs1, o_ & 63);
      const float sc = o_ < 64 ? s0_ : s1_;
      const float* src = row < T_P ? xin_p + (size_t)row * 1024 : xin_s + (size_t)(row - T_P) * 1024;
      xout[(size_t)row * 1024 + col] = src[col] + sc * v[jj];
    }
  }
};

__device__ __forceinline__ void ph_gla_prep(const Params& P, int layer, char* smem) {
  bf16_t* sQ = (bf16_t*)smem;
  bf16_t* sK = (bf16_t*)(smem + 8192);
  float* sG = (float*)(smem + 16384);
  float* sTot = (float*)(smem + 20480);
  bf16_t* qd = (bf16_t*)(P.ws + G_QD);
  bf16_t* kd = (bf16_t*)(P.ws + G_KD);
  bf16_t* kdT = (bf16_t*)(P.ws + G_KDT);
  const float* glr = (const float*)(P.ws + G_GLR);
  float* decay = (float*)(P.ws + G_DEC);
  const float* wgu = P.in[10] + (size_t)layer * 16 * 512;
  const float* bgt = P.in[11] + (size_t)layer * 512;
  const int tid = otid(), tg = tid >> 6, cl = tid & 63;
  for (int it = blockIdx.x; it < NCH * 8; it += gridDim.x) {
    const int c = it >> 3, cb8 = it & 7, d = cb8 * 64 + cl;
    int t0, len;
    chunk_info(c, t0, len);
    float wg[16];
#pragma unroll
    for (int rk = 0; rk < 16; ++rk) wg[rk] = wgu[rk * 512 + d];
    const float bg = bgt[d];
    u32x4 rq[2], rk2[2];
#pragma unroll
    for (int i = 0; i < 2; ++i) {
      const int id = tid + 256 * i, row = id >> 3, c16 = id & 7;
      rq[i] = u32x4{0u, 0u, 0u, 0u};
      rk2[i] = u32x4{0u, 0u, 0u, 0u};
      if (row < len) {
        const size_t a = (size_t)(t0 + row) * 512 + cb8 * 64 + c16 * 8;
        rq[i] = *(const u32x4*)(qd + a);
        rk2[i] = *(const u32x4*)(kd + a);
      }
    }
    float4 gl4 = float4{0.f, 0.f, 0.f, 0.f};
    if (tid * 4 < len * 16) gl4 = *(const float4*)(glr + (size_t)t0 * 16 + tid * 4);
    __syncthreads();
#pragma unroll
    for (int i = 0; i < 2; ++i) {
      const int id = tid + 256 * i, row = id >> 3, c16 = id & 7;
      *(u32x4*)(sQ + row * 64 + c16 * 8) = rq[i];
      *(u32x4*)(sK + row * 64 + c16 * 8) = rk2[i];
    }
    *(float4*)(sG + tid * 4) = gl4;
    __syncthreads();
    float cs[16];
    float run = 0.f;
#pragma unroll
    for (int e = 0; e < 16; ++e) {
      const int j = tg * 16 + e;
      float x = bg;
#pragma unroll
      for (int rk = 0; rk < 16; ++rk) x += sG[j * 16 + rk] * wg[rk];
      const float ls = fminf(x, 0.f) - __logf(1.f + __expf(-fabsf(x)));
      run += (j < len) ? ls * (1.f / 16.f) : 0.f;
      cs[e] = run;
    }
    sTot[tg * 64 + cl] = run;
    __syncthreads();
    float off = 0.f;
#pragma unroll
    for (int g2 = 0; g2 < 3; ++g2) off += (g2 < tg) ? sTot[g2 * 64 + cl] : 0.f;
    unsigned pk[8];
#pragma unroll
    for (int e = 0; e < 16; ++e) {
      const int j = tg * 16 + e;
      const float bc = off + cs[e];
      const float eb = __expf(bc);
      const float qv = bf2f(sQ[j * 64 + cl]), kv = bf2f(sK[j * 64 + cl]);
      sQ[j * 64 + cl] = f2bf(qv * eb);
      const bf16_t kb = f2bf(kv * __builtin_amdgcn_rcpf(eb));
      sK[j * 64 + cl] = kb;
      if (e & 1) pk[e >> 1] |= ((unsigned)kb << 16);
      else pk[e >> 1] = (unsigned)kb;
    }
    if (tg * 16 < len) {
      bf16_t* dstT = kdT + ((size_t)c * 512 + d) * 64 + tg * 16;
      *(u32x4*)dstT = u32x4{pk[0], pk[1], pk[2], pk[3]};
      *(u32x4*)(dstT + 8) = u32x4{pk[4], pk[5], pk[6], pk[7]};
    }
    if (tg == 3) decay[(size_t)c * 512 + d] = __expf(off + run);
    __syncthreads();
#pragma unroll
    for (int i = 0; i < 2; ++i) {
      const int id = tid + 256 * i, row = id >> 3, c16 = id & 7;
      if (row < len) {
        const size_t a = (size_t)(t0 + row) * 512 + cb8 * 64 + c16 * 8;
        *(u32x4*)(qd + a) = *(const u32x4*)(sQ + row * 64 + c16 * 8);
        *(u32x4*)(kd + a) = *(const u32x4*)(sK + row * 64 + c16 * 8);
      }
    }
  }
}

__device__ __forceinline__ void ph_gla_pass(const bool passB, const int layer, const Params& P, char* smem) {
  bf16_t* sKT = (bf16_t*)(smem);
  bf16_t* sVT = (bf16_t*)(smem + 18432);
  bf16_t* sQ = (bf16_t*)(smem + 27648);
  bf16_t* sK = (bf16_t*)(smem + 45056);
  bf16_t* sAtt = sK;
  bf16_t* sS = (bf16_t*)(smem + 62464);
  const bf16_t* qd = (const bf16_t*)(P.ws + G_QD);
  const bf16_t* kd = (const bf16_t*)(P.ws + G_KD);
  const bf16_t* kdT = (const bf16_t*)(P.ws + G_KDT);
  const bf16_t* vT = (const bf16_t*)(P.ws + G_VT);
  bf16_t* obuf = (bf16_t*)(P.ws + G_O);
  float* ssq = (float*)(P.ws + G_SSQ);
  const float* decay = (const float*)(P.ws + G_DEC);
  float* Sseg = (float*)(P.ws + G_SSEG);
  const float* st_in = P.in[2];
  const int tid = otid(), lane = tid & 63, wave = tid >> 6, r = lane & 15, q = lane >> 4;
  const int nitems = passB ? NSEGT_G * 16 : (NSEG_G - 1) * 16;
  for (int it = blockIdx.x; it < nitems; it += gridDim.x) {
    const int sg = it >> 4, h = (it >> 2) & 3, sl = it & 3;
    int c0, nch, b;
    seg_info(sg, NSEG_G, c0, nch, b);
    f32x4 accS[2][4];
#pragma unroll
    for (int mt = 0; mt < 2; ++mt)
#pragma unroll
      for (int nt = 0; nt < 4; ++nt) {
        const int d0 = 32 * wave + mt * 16 + q * 4, v = sl * 64 + nt * 16 + r;
        if (!passB) accS[mt][nt] = f32x4{0.f, 0.f, 0.f, 0.f};
        else if (sg < NSEG_G) {
          const float4 t4 = *(const float4*)(Sseg + ((size_t)(sg * 4 + h) * 256 + v) * 128 + d0);
          accS[mt][nt] = f32x4{t4.x, t4.y, t4.z, t4.w};
        } else {
#pragma unroll
          for (int jj = 0; jj < 4; ++jj)
            accS[mt][nt][jj] = st_in[((((size_t)layer * 8 + b) * 4 + h) * 128 + d0 + jj) * 256 + v];
        }
      }
    float dprod[8] = {1.f, 1.f, 1.f, 1.f, 1.f, 1.f, 1.f, 1.f};
    u32x4 pk[4], pv[2];
    float pdec[8];
#define GLA_ISSUE(cc_)                                                                                         \
  {                                                                                                            \
    const int cx_ = (cc_);                                                                                     \
    const int lenx_ = cx_ < 256 ? 64 : 16;                                                                     \
    _Pragma("unroll") for (int i = 0; i < 4; ++i) {                                                            \
      const int id = tid + 256 * i, row = id >> 3, c16 = id & 7;                                               \
      pk[i] = u32x4{0u, 0u, 0u, 0u};                                                                           \
      if (c16 * 8 < lenx_) pk[i] = *(const u32x4*)(kdT + ((size_t)cx_ * 512 + h * 128 + row) * 64 + c16 * 8);  \
    }                                                                                                          \
    _Pragma("unroll") for (int i = 0; i < 2; ++i) {                                                            \
      const int id = tid + 256 * i, row = id >> 3, c16 = id & 7;                                               \
      pv[i] = u32x4{0u, 0u, 0u, 0u};                                                                           \
      if (c16 * 8 < lenx_) pv[i] = *(const u32x4*)(vT + ((size_t)cx_ * 1024 + h * 256 + sl * 64 + row) * 64 + c16 * 8); \
    }                                                                                                          \
    _Pragma("unroll") for (int mt = 0; mt < 2; ++mt)                                                           \
    _Pragma("unroll") for (int jj = 0; jj < 4; ++jj)                                                           \
      pdec[mt * 4 + jj] = decay[(size_t)cx_ * 512 + h * 128 + 32 * wave + mt * 16 + q * 4 + jj];               \
  }
    GLA_ISSUE(c0)
    for (int ci = 0; ci < nch; ++ci) {
      const int c = c0 + ci;
      int t0, len;
      chunk_info(c, t0, len);
      __syncthreads();
#pragma unroll
      for (int i = 0; i < 4; ++i) {
        const int id = tid + 256 * i, row = id >> 3, c16 = id & 7;
        *(u32x4*)(sKT + row * 72 + c16 * 8) = pk[i];
      }
#pragma unroll
      for (int i = 0; i < 2; ++i) {
        const int id = tid + 256 * i, row = id >> 3, c16 = id & 7;
        *(u32x4*)(sVT + row * 72 + c16 * 8) = pv[i];
      }
      float dec8[8];
#pragma unroll
      for (int e = 0; e < 8; ++e) dec8[e] = pdec[e];
      if (passB) {
#pragma unroll
        for (int i = 0; i < 4; ++i) {
          const int id = tid + 256 * i, row = id >> 4, c16 = id & 15;
          uint4 vq = uint4{0u, 0u, 0u, 0u}, vk = uint4{0u, 0u, 0u, 0u};
          if (row < len) {
            const size_t a = (size_t)(t0 + row) * 512 + h * 128 + c16 * 8;
            vq = *(const uint4*)(qd + a);
            vk = *(const uint4*)(kd + a);
          }
          *(uint4*)(sQ + row * 136 + c16 * 8) = vq;
          *(uint4*)(sK + row * 136 + c16 * 8) = vk;
        }
      }
      __syncthreads();
      if (ci + 1 < nch) GLA_ISSUE(c0 + ci + 1)
      if (passB) {
        f32x4 att[1][4];
#pragma unroll
        for (int nt = 0; nt < 4; ++nt) att[0][nt] = f32x4{0.f, 0.f, 0.f, 0.f};
        mma_lds<1, 4, 4>(att, sQ + (16 * wave) * 136, 136, sK, 136, r, q);
#pragma unroll
        for (int mt = 0; mt < 2; ++mt)
#pragma unroll
          for (int nt = 0; nt < 4; ++nt) {
            const int d0 = 32 * wave + mt * 16 + q * 4, v = nt * 16 + r;
            uint2 u;
            u.x = pack2(accS[mt][nt][0], accS[mt][nt][1]);
            u.y = pack2(accS[mt][nt][2], accS[mt][nt][3]);
            *(uint2*)(sS + v * 136 + d0) = u;
          }
        __syncthreads();
#pragma unroll
        for (int nt = 0; nt < 4; ++nt)
#pragma unroll
          for (int jj = 0; jj < 4; ++jj) {
            const int i = 16 * wave + q * 4 + jj, j = nt * 16 + r;
            sAtt[i * 72 + j] = f2bf(j <= i ? att[0][nt][jj] : 0.f);
          }
        __syncthreads();
        f32x4 o[1][4];
#pragma unroll
        for (int nt = 0; nt < 4; ++nt) o[0][nt] = f32x4{0.f, 0.f, 0.f, 0.f};
        mma_lds<1, 4, 2>(o, sAtt + (16 * wave) * 72, 72, sVT, 72, r, q);
        mma_lds<1, 4, 4>(o, sQ + (16 * wave) * 136, 136, sS, 136, r, q);
        float ss[4] = {0.f, 0.f, 0.f, 0.f};
#pragma unroll
        for (int nt = 0; nt < 4; ++nt)
#pragma unroll
          for (int jj = 0; jj < 4; ++jj) {
            const float ov = o[0][nt][jj];
            ss[jj] += ov * ov;
            const int i = 16 * wave + q * 4 + jj;
            if (i < len) obuf[(size_t)(t0 + i) * 1024 + h * 256 + sl * 64 + nt * 16 + r] = f2bf(ov);
          }
#pragma unroll
        for (int jj = 0; jj < 4; ++jj) {
          float s = ss[jj];
          s += __shfl_xor(s, 1);
          s += __shfl_xor(s, 2);
          s += __shfl_xor(s, 4);
          s += __shfl_xor(s, 8);
          const int i = 16 * wave + q * 4 + jj;
          if (r == 0 && i < len) ssq[(size_t)(t0 + i) * 16 + h * 4 + sl] = s;
        }
      }
      mma_lds<2, 4, 2>(accS, sKT + (32 * wave) * 72, 72, sVT, 72, r, q);
#pragma unroll
      for (int mt = 0; mt < 2; ++mt)
#pragma unroll
        for (int jj = 0; jj < 4; ++jj) {
          const float dec = dec8[mt * 4 + jj];
          dprod[mt * 4 + jj] *= dec;
#pragma unroll
          for (int nt = 0; nt < 4; ++nt) accS[mt][nt][jj] *= dec;
        }
    }
#undef GLA_ISSUE
    if (!passB && sl == 0 && r == 0) {
#pragma unroll
      for (int mt = 0; mt < 2; ++mt)
#pragma unroll
        for (int jj = 0; jj < 4; ++jj)
          ((float*)(P.ws + G_DSEG))[(size_t)sg * 512 + h * 128 + 32 * wave + mt * 16 + q * 4 + jj] = dprod[mt * 4 + jj];
    }
#pragma unroll
    for (int mt = 0; mt < 2; ++mt)
#pragma unroll
      for (int nt = 0; nt < 4; ++nt) {
        const int d0 = 32 * wave + mt * 16 + q * 4, v = sl * 64 + nt * 16 + r;
        if (!passB) {
          float4 t4;
          t4.x = accS[mt][nt][0]; t4.y = accS[mt][nt][1]; t4.z = accS[mt][nt][2]; t4.w = accS[mt][nt][3];
          *(float4*)(Sseg + ((size_t)(sg * 4 + h) * 256 + v) * 128 + d0) = t4;
        } else if (sg == NSEG_G - 1) {
#pragma unroll
          for (int jj = 0; jj < 4; ++jj)
            P.out[O_GLA_P + (((size_t)layer * 4 + h) * 128 + d0 + jj) * 256 + v] = accS[mt][nt][jj];
        } else if (sg >= NSEG_G) {
#pragma unroll
          for (int jj = 0; jj < 4; ++jj)
            P.out[O_GLA_S + ((((size_t)layer * 8 + b) * 4 + h) * 128 + d0 + jj) * 256 + v] = accS[mt][nt][jj];
        }
      }
  }
}

__device__ __forceinline__ void ph_gla_scan(const Params& P) {
  float* Sseg = (float*)(P.ws + G_SSEG);
  const float* dseg = (const float*)(P.ws + G_DSEG);
  for (int idx = blockIdx.x * 256 + otid(); idx < 4 * 256 * 128; idx += gridDim.x * 256) {
    const int h = idx >> 15, d = idx & 127;
    float cur = 0.f;
    for (int s = 0; s < NSEG_G; ++s) {
      const size_t a = (size_t)s * 131072 + idx;
      float tmp = 0.f, D = 0.f;
      if (s < NSEG_G - 1) {
        tmp = Sseg[a];
        D = dseg[(size_t)s * 512 + h * 128 + d];
      }
      Sseg[a] = cur;
      cur = D * cur + tmp;
    }
  }
}

__device__ __forceinline__ void ph_gla_aprep(const Params& P, int layer) {
  bf16_t* obuf = (bf16_t*)(P.ws + G_O);
  const bf16_t* g = (const bf16_t*)(P.ws + G_G);
  const float* ssq = (const float*)(P.ws + G_SSQ);
  const float* nw = P.in[12] + (size_t)layer * 256;
  for (int idx = blockIdx.x * 256 + otid(); idx < T * 128; idx += gridDim.x * 256) {
    const int t = idx >> 7, c8 = (idx & 127) * 8, hh = c8 >> 8;
    const float4 s4 = *(const float4*)(ssq + (size_t)t * 16 + hh * 4);
    const float rs = rsqrtf((s4.x + s4.y + s4.z + s4.w) * (1.f / 256.f) + EPS);
    const uint4 ov = *(const uint4*)(obuf + (size_t)t * 1024 + c8);
    const uint4 gv = *(const uint4*)(g + (size_t)t * 1024 + c8);
    const float4 w0 = *(const float4*)(nw + (c8 & 255));
    const float4 w1 = *(const float4*)(nw + (c8 & 255) + 4);
    uint4 res;
    res.x = pack2(lo_bf(ov.x) * rs * w0.x * silu_(lo_bf(gv.x)), hi_bf(ov.x) * rs * w0.y * silu_(hi_bf(gv.x)));
    res.y = pack2(lo_bf(ov.y) * rs * w0.z * silu_(lo_bf(gv.y)), hi_bf(ov.y) * rs * w0.w * silu_(hi_bf(gv.y)));
    res.z = pack2(lo_bf(ov.z) * rs * w1.x * silu_(lo_bf(gv.z)), hi_bf(ov.z) * rs * w1.y * silu_(hi_bf(gv.z)));
    res.w = pack2(lo_bf(ov.w) * rs * w1.z * silu_(lo_bf(gv.w)), hi_bf(ov.w) * rs * w1.w * silu_(hi_bf(gv.w)));
    *(uint4*)(obuf + (size_t)t * 1024 + c8) = res;
  }
}

__device__ __forceinline__ void ph_lru_pass(const bool passB, const Params& P, char* smem) {
  bf16_t* sRaw = (bf16_t*)smem;
  bf16_t* sXc = (bf16_t*)(smem + 11808);
  float* sP = (float*)(smem + 25120);
  float* sCst = (float*)(smem + 74272);
  const bf16_t* xb = (const bf16_t*)(P.ws + L_XB);
  const bf16_t* gate = (const bf16_t*)(P.ws + L_GATE);
  bf16_t* ybuf = (bf16_t*)(P.ws + L_Y);
  float* Asum = (float*)(P.ws + L_ASEG);
  float* Hsum = (float*)(P.ws + L_HSEG);
  const bf16_t* WG = (const bf16_t*)(P.ws + OFF_WG);
  const float* st_conv = P.in[3];
  const float* st_h = P.in[4];
  const int tid = otid(), lane = tid & 63, wave = tid >> 6, r = lane & 15, q = lane >> 4;
  const int NIT = NCH * 16;
  const int per = (NIT + (int)gridDim.x - 1) / (int)gridDim.x;
  const int it_lo = blockIdx.x * per;
  const int it_hi = it_lo + per < NIT ? it_lo + per : NIT;
  const int gt = wave >> 1, mh = wave & 1;
  int kprev = -1;
  bf16x8 bw[3][6];
#pragma unroll
  for (int ks = 0; ks < 3; ++ks)
#pragma unroll
    for (int nt = 0; nt < 6; ++nt) bw[ks][nt] = bf16x8{0, 0, 0, 0, 0, 0, 0, 0};
  const int cg8 = tid % 11, crow = tid / 11;
  const int gg4 = tid % 22, grow = tid / 22;
  float cw[5][8];
  float gc[3][4];
#pragma unroll
  for (int a_ = 0; a_ < 5; ++a_)
#pragma unroll
    for (int e = 0; e < 8; ++e) cw[a_][e] = 0.f;
#pragma unroll
  for (int a_ = 0; a_ < 3; ++a_)
#pragma unroll
    for (int e = 0; e < 4; ++e) gc[a_][e] = 0.f;
  for (int idx = tid; idx < 64 * 8; idx += 256) sXc[(idx >> 3) * 104 + 88 + (idx & 7)] = 0;
  for (int it = it_lo; it < it_hi; ++it) {
    const int k = it / NCH, c = it - k * NCH;
    int t0, len;
    chunk_info(c, t0, len);
    const int b = c - 256;
    const bool has_prev = (c < 256) && (c > 0);
    const int ch = k * 88 + tid;
    u32x4 rraw[3], rgate[3];
#pragma unroll
    for (int i = 0; i < 3; ++i) {
      const int idx = tid + 256 * i, row = idx / 11, c16 = idx - row * 11;
      rraw[i] = u32x4{0u, 0u, 0u, 0u};
      rgate[i] = u32x4{0u, 0u, 0u, 0u};
      if (row < len + 3) {
        if (row >= 3 || has_prev) {
          rraw[i] = *(const u32x4*)(xb + (size_t)(t0 + row - 3) * LW + k * 88 + c16 * 8);
        } else if (c >= 256) {
          const float* sp = st_conv + ((size_t)b * 3 + row) * LW + k * 88 + c16 * 8;
          const float4 f0 = *(const float4*)sp, f1 = *(const float4*)(sp + 4);
          rraw[i] = u32x4{pack2(f0.x, f0.y), pack2(f0.z, f0.w), pack2(f1.x, f1.y), pack2(f1.z, f1.w)};
        }
      }
      if (passB && row < len) rgate[i] = *(const u32x4*)(gate + (size_t)(t0 + row) * LW + k * 88 + c16 * 8);
    }
    float hcur = 0.f, aprod = 1.f;
    if (passB && tid < 88) hcur = c < 256 ? Hsum[(size_t)c * LW + ch] : st_h[b * LW + ch];
    __syncthreads();
    if (k != kprev) {
      if (tid < 88) {
        sCst[0 * 96 + tid] = -8.f * softplus_(-P.in[21][ch]);
        sCst[1 * 96 + tid] = P.in[18][ch];
        sCst[2 * 96 + tid] = P.in[20][ch];
        sCst[3 * 96 + tid] = P.in[16][ch];
        sCst[4 * 96 + tid] = P.in[15][0 * LW + ch];
        sCst[5 * 96 + tid] = P.in[15][1 * LW + ch];
        sCst[6 * 96 + tid] = P.in[15][2 * LW + ch];
        sCst[7 * 96 + tid] = P.in[15][3 * LW + ch];
      }
      const bf16_t* Wt = WG + ((size_t)(gt * 16 + k) * 96) * 96;
#pragma unroll
      for (int ks = 0; ks < 3; ++ks)
#pragma unroll
        for (int nt = 0; nt < 6; ++nt) bw[ks][nt] = *(const bf16x8*)(Wt + (nt * 16 + r) * 96 + ks * 32 + q * 8);
    }
#pragma unroll
    for (int i = 0; i < 3; ++i) {
      const int idx = tid + 256 * i, row = idx / 11, c16 = idx - row * 11;
      if (row < 67) *(u32x4*)(sRaw + row * 88 + c16 * 8) = rraw[i];
    }
    __syncthreads();
    if (k != kprev) {
#pragma unroll
      for (int a_ = 0; a_ < 5; ++a_)
#pragma unroll
        for (int e = 0; e < 8; ++e) cw[a_][e] = sCst[(3 + a_) * 96 + cg8 * 8 + e];
#pragma unroll
      for (int a_ = 0; a_ < 3; ++a_)
#pragma unroll
        for (int e = 0; e < 4; ++e) gc[a_][e] = sCst[a_ * 96 + gg4 * 4 + e];
      kprev = k;
    }
    if (crow < 23) {
#pragma unroll
      for (int i = 0; i < 3; ++i) {
        const int j = crow + 23 * i;
        if (j < 64) {
          u32x4 o = u32x4{0u, 0u, 0u, 0u};
          if (j < len) {
            u32x4 rr[4];
#pragma unroll
            for (int kk = 0; kk < 4; ++kk) rr[kk] = *(const u32x4*)(sRaw + (j + kk) * 88 + cg8 * 8);
            float xc[8];
#pragma unroll
            for (int e = 0; e < 8; ++e) {
              float acc_ = cw[0][e];
#pragma unroll
              for (int kk = 0; kk < 4; ++kk) {
                const unsigned w_ = rr[kk][e >> 1];
                acc_ += cw[1 + kk][e] * ((e & 1) ? hi_bf(w_) : lo_bf(w_));
              }
              xc[e] = acc_;
            }
            o = u32x4{pack2(xc[0], xc[1]), pack2(xc[2], xc[3]), pack2(xc[4], xc[5]), pack2(xc[6], xc[7])};
          }
          *(u32x4*)(sXc + j * 104 + cg8 * 8) = o;
        }
      }
    }
    __syncthreads();
    {
      f32x4 acc[2][6];
#pragma unroll
      for (int mt = 0; mt < 2; ++mt)
#pragma unroll
        for (int nt = 0; nt < 6; ++nt) acc[mt][nt] = f32x4{0.f, 0.f, 0.f, 0.f};
#pragma unroll
      for (int ks = 0; ks < 3; ++ks) {
        bf16x8 af[2];
#pragma unroll
        for (int mt = 0; mt < 2; ++mt) af[mt] = *(const bf16x8*)(sXc + (32 * mh + mt * 16 + r) * 104 + ks * 32 + q * 8);
#pragma unroll
        for (int mt = 0; mt < 2; ++mt)
#pragma unroll
          for (int nt = 0; nt < 6; ++nt)
            acc[mt][nt] = __builtin_amdgcn_mfma_f32_16x16x32_bf16(bw[ks][nt], af[mt], acc[mt][nt], 0, 0, 0);
      }
#pragma unroll
      for (int mt = 0; mt < 2; ++mt)
#pragma unroll
        for (int nt = 0; nt < 6; ++nt)
          *(f32x4*)(sP + gt * 6144 + (32 * mh + mt * 16 + r) * 96 + nt * 16 + q * 4) = acc[mt][nt];
    }
    __syncthreads();
    if (grow < 11) {
#pragma unroll
      for (int i = 0; i < 6; ++i) {
        const int j = grow + 11 * i;
        if (j < len) {
          const f32x4 pr = *(const f32x4*)(sP + j * 96 + gg4 * 4);
          const f32x4 pi = *(const f32x4*)(sP + 6144 + j * 96 + gg4 * 4);
          const uint2 xu = *(const uint2*)(sXc + j * 104 + gg4 * 4);
          float xv[4];
          xv[0] = lo_bf(xu.x); xv[1] = hi_bf(xu.x); xv[2] = lo_bf(xu.y); xv[3] = hi_bf(xu.y);
          f32x4 av, uv;
#pragma unroll
          for (int e = 0; e < 4; ++e) {
            const float rr_ = sigmoid_(pr[e] + gc[1][e]), ii_ = sigmoid_(pi[e] + gc[2][e]);
            const float a = __expf(gc[0][e] * rr_);
            const float m = __builtin_amdgcn_sqrtf(fmaxf(1.f - a * a, 0.f));
            av[e] = a;
            uv[e] = m * ii_ * xv[e];
          }
          *(f32x4*)(sP + j * 96 + gg4 * 4) = av;
          *(f32x4*)(sP + 6144 + j * 96 + gg4 * 4) = uv;
        }
      }
    }
    __syncthreads();
    if (tid < 88) {
      for (int j0 = 0; j0 < len; j0 += 16) {
        float av[16], uv[16];
#pragma unroll
        for (int e = 0; e < 16; ++e) {
          av[e] = sP[(j0 + e) * 96 + tid];
          uv[e] = sP[6144 + (j0 + e) * 96 + tid];
        }
#pragma unroll
        for (int e = 0; e < 16; ++e) {
          hcur = av[e] * hcur + uv[e];
          aprod *= av[e];
          uv[e] = hcur;
        }
        if (passB) {
#pragma unroll
          for (int e = 0; e < 16; ++e) sP[6144 + (j0 + e) * 96 + tid] = uv[e];
        }
      }
      if (!passB) {
        Asum[(size_t)c * LW + ch] = aprod;
        Hsum[(size_t)c * LW + ch] = hcur;
      } else if (c == 255) {
        P.out[O_LH_P + ch] = hcur;
#pragma unroll
        for (int kk = 0; kk < 3; ++kk) P.out[O_LCONV_P + kk * LW + ch] = bf2f(sRaw[(len + kk) * 88 + tid]);
      } else if (c >= 256) {
        P.out[O_LH_S + b * LW + ch] = hcur;
#pragma unroll
        for (int kk = 0; kk < 3; ++kk) P.out[O_LCONV_S + ((size_t)b * 3 + kk) * LW + ch] = bf2f(sRaw[(len + kk) * 88 + tid]);
      }
    }
    if (passB) {
      __syncthreads();
#pragma unroll
      for (int i = 0; i < 3; ++i) {
        const int idx = tid + 256 * i, row = idx / 11, c16 = idx - row * 11;
        if (row < len) {
          const float4 h0 = *(const float4*)(sP + 6144 + row * 96 + c16 * 8);
          const float4 h1 = *(const float4*)(sP + 6144 + row * 96 + c16 * 8 + 4);
          const u32x4 gv = rgate[i];
          u32x4 o;
          o[0] = pack2(h0.x * silu_(lo_bf(gv[0])), h0.y * silu_(hi_bf(gv[0])));
          o[1] = pack2(h0.z * silu_(lo_bf(gv[1])), h0.w * silu_(hi_bf(gv[1])));
          o[2] = pack2(h1.x * silu_(lo_bf(gv[2])), h1.y * silu_(hi_bf(gv[2])));
          o[3] = pack2(h1.z * silu_(lo_bf(gv[3])), h1.w * silu_(hi_bf(gv[3])));
          *(u32x4*)(ybuf + (size_t)(t0 + row) * LW + k * 88 + c16 * 8) = o;
        }
      }
    }
  }
}

__device__ __forceinline__ void ph_lru_scan(const Params& P, char* smem) {
  float* sA = (float*)smem;
  float* sH = sA + 256;
  const float* Asum = (const float*)(P.ws + L_ASEG);
  float* Hsum = (float*)(P.ws + L_HSEG);
  const int tid = otid(), seg = tid >> 4, chl = tid & 15;
  for (int it = blockIdx.x; it < LW / 16; it += gridDim.x) {
    const int ch = it * 16 + chl;
    float a[16], h[16];
#pragma unroll
    for (int i = 0; i < 16; ++i) {
      a[i] = Asum[(size_t)(seg * 16 + i) * LW + ch];
      h[i] = Hsum[(size_t)(seg * 16 + i) * LW + ch];
    }
    float A = 1.f, H = 0.f;
#pragma unroll
    for (int i = 0; i < 16; ++i) { H = a[i] * H + h[i]; A *= a[i]; }
    __syncthreads();
    sA[seg * 16 + chl] = A;
    sH[seg * 16 + chl] = H;
    __syncthreads();
    float hin = 0.f;
    for (int s2 = 0; s2 < seg; ++s2) hin = sA[s2 * 16 + chl] * hin + sH[s2 * 16 + chl];
#pragma unroll
    for (int i = 0; i < 16; ++i) {
      Hsum[(size_t)(seg * 16 + i) * LW + ch] = hin;
      hin = a[i] * hin + h[i];
    }
  }
}

__device__ __forceinline__ void ph_ssd_conv(const Params& P) {
  bf16_t* xbcT = (bf16_t*)(P.ws + S_XBCT);
  const bf16_t* tails = (const bf16_t*)(P.ws + S_TAIL);
  bf16_t* Brm = (bf16_t*)(P.ws + S_BRM);
  bf16_t* Crm = (bf16_t*)(P.ws + S_CRM);
  const float* cw = P.in[24];
  const float* cb = P.in[25];
  const float* st_conv = P.in[5];
  const int tid = otid();
  for (int it = blockIdx.x; it < NCH * 12; it += gridDim.x) {
    const int c = it / 12, part = it - c * 12, cc = part * 256 + tid;
    int t0, len;
    chunk_info(c, t0, len);
    const float w0 = cw[cc], w1 = cw[3072 + cc], w2 = cw[2 * 3072 + cc], w3 = cw[3 * 3072 + cc], bias = cb[cc];
    float a0 = 0.f, a1 = 0.f, a2 = 0.f;
    if (c >= 256) {
      const int b = c - 256;
      a0 = st_conv[((size_t)b * 3 + 0) * 3072 + cc];
      a1 = st_conv[((size_t)b * 3 + 1) * 3072 + cc];
      a2 = st_conv[((size_t)b * 3 + 2) * 3072 + cc];
    } else if (c > 0) {
      const uint2 tv = *(const uint2*)(tails + ((size_t)(c - 1) * 3072 + cc) * 4);
      a0 = hi_bf(tv.x); a1 = lo_bf(tv.y); a2 = hi_bf(tv.y);
    }
    bf16_t* rowp = xbcT + ((size_t)c * 3072 + cc) * 64;
    bf16_t* rm = nullptr;
    if (cc >= 2560) rm = Crm + (cc - 2560);
    else if (cc >= 2048) rm = Brm + (cc - 2048);
    u32x4 rw[8];
#pragma unroll
    for (int g = 0; g < 8; ++g) {
      rw[g] = u32x4{0u, 0u, 0u, 0u};
      if (g * 8 < len) rw[g] = *(const u32x4*)(rowp + g * 8);
    }
#pragma unroll
    for (int g = 0; g < 8; ++g) {
      if (g * 8 < len) {
        const int g8 = g * 8;
        const u32x4 u = rw[g];
        float x[8], y[8];
        x[0] = lo_bf(u[0]); x[1] = hi_bf(u[0]); x[2] = lo_bf(u[1]); x[3] = hi_bf(u[1]);
        x[4] = lo_bf(u[2]); x[5] = hi_bf(u[2]); x[6] = lo_bf(u[3]); x[7] = hi_bf(u[3]);
#pragma unroll
        for (int e = 0; e < 8; ++e) {
          const float yy = bias + w0 * a0 + w1 * a1 + w2 * a2 + w3 * x[e];
          a0 = a1; a1 = a2; a2 = x[e];
          y[e] = silu_(yy);
        }
        *(u32x4*)(rowp + g8) = u32x4{pack2(y[0], y[1]), pack2(y[2], y[3]), pack2(y[4], y[5]), pack2(y[6], y[7])};
        if (rm) {
#pragma unroll
          for (int e = 0; e < 8; ++e) rm[(size_t)(t0 + g8 + e) * 512] = f2bf(y[e]);
        }
      }
    }
    if (c >= 255) {
      const uint2 tv = *(const uint2*)(tails + ((size_t)c * 3072 + cc) * 4);
      float* dst = c == 255 ? P.out + O_SCONV_P : P.out + O_SCONV_S + (size_t)(c - 256) * 3 * 3072;
      dst[0 * 3072 + cc] = hi_bf(tv.x);
      dst[1 * 3072 + cc] = lo_bf(tv.y);
      dst[2 * 3072 + cc] = hi_bf(tv.y);
    }
  }
}

__device__ __forceinline__ void ph_ssd_pass(const bool passB, const Params& P, char* smem) {
  bf16_t* sC = (bf16_t*)(smem);
  bf16_t* sBT = (bf16_t*)(smem + 17408);
  bf16_t* sXT = (bf16_t*)(smem + 35840);
  bf16_t* sS = (bf16_t*)(smem + 45056);
  bf16_t* sXW = (bf16_t*)(smem + 62464);
  bf16_t* sW = (bf16_t*)(smem + 71680);
  bf16_t* sB = sXW;
  float* sCum = (float*)(smem + 80896);
  float* sDt = sCum + 64;
  bf16_t* zbuf = (bf16_t*)(P.ws + S_Z);
  const bf16_t* xbcT = (const bf16_t*)(P.ws + S_XBCT);
  const bf16_t* Brm = (const bf16_t*)(P.ws + S_BRM);
  const bf16_t* Crm = (const bf16_t*)(P.ws + S_CRM);
  const float* dtb = (const float*)(P.ws + S_DT);
  float* ssq = (float*)(P.ws + S_SSQ);
  float* Sseg = (float*)(P.ws + S_SSEG);
  float* cdseg = (float*)(P.ws + S_CDSEG);
  const float* st_in = P.in[6];
  const int tid = otid(), lane = tid & 63, wave = tid >> 6, r = lane & 15, q = lane >> 4;
  const int nitems = passB ? NSEGT_S * 32 : (NSEG_S - 1) * 32;
  for (int it = blockIdx.x; it < nitems; it += gridDim.x) {
    const int sg = it >> 5, hd = it & 31, g = hd >> 3;
    int c0, nch, b;
    seg_info(sg, NSEG_S, c0, nch, b);
    const float Ah = -__expf(P.in[27][hd]);
    const float Dh = P.in[28][hd];
    f32x4 accS[2][4];
#pragma unroll
    for (int mt = 0; mt < 2; ++mt)
#pragma unroll
      for (int nt = 0; nt < 4; ++nt) {
        const int s0 = 32 * wave + mt * 16 + q * 4, p = nt * 16 + r;
        if (!passB) accS[mt][nt] = f32x4{0.f, 0.f, 0.f, 0.f};
        else {
          const float* src = sg < NSEG_S ? Sseg + (((size_t)sg * 32 + hd) * 64 + p) * 128 + s0
                                       : st_in + (((size_t)b * 32 + hd) * 64 + p) * 128 + s0;
          const float4 t4 = *(const float4*)src;
          accS[mt][nt] = f32x4{t4.x, t4.y, t4.z, t4.w};
        }
      }
    float totcum = 0.f;
    u32x4 pb[4], px[2];
    float pdt = 0.f;
    const float dtbias = P.in[26][hd];
#define SSD_ISSUE(cc_)                                                                                          \
  {                                                                                                             \
    const int cx_ = (cc_);                                                                                      \
    const int lenx_ = cx_ < 256 ? 64 : 16;                                                                      \
    const int t0x_ = cx_ < 256 ? cx_ * 64 : T_P + (cx_ - 256) * 16;                                             \
    _Pragma("unroll") for (int i = 0; i < 4; ++i) {                                                             \
      const int id = tid + 256 * i, row = id >> 3, c16 = id & 7;                                                \
      pb[i] = u32x4{0u, 0u, 0u, 0u};                                                                            \
      if (c16 * 8 < lenx_) pb[i] = *(const u32x4*)(xbcT + ((size_t)cx_ * 3072 + 2048 + g * 128 + row) * 64 + c16 * 8); \
    }                                                                                                           \
    _Pragma("unroll") for (int i = 0; i < 2; ++i) {                                                             \
      const int id = tid + 256 * i, row = id >> 3, c16 = id & 7;                                                \
      px[i] = u32x4{0u, 0u, 0u, 0u};                                                                            \
      if (c16 * 8 < lenx_) px[i] = *(const u32x4*)(xbcT + ((size_t)cx_ * 3072 + hd * 64 + row) * 64 + c16 * 8);  \
    }                                                                                                           \
    pdt = 0.f;                                                                                                  \
    if (wave == 0 && lane < lenx_) pdt = dtb[(size_t)(t0x_ + lane) * 32 + hd];                                  \
  }
    SSD_ISSUE(c0)
    for (int ci = 0; ci < nch; ++ci) {
      const int c = c0 + ci;
      int t0, len;
      chunk_info(c, t0, len);
      __syncthreads();
      if (wave == 0) {
        const float dtv = lane < len ? softplus_(pdt + dtbias) : 0.f;
        float x = dtv * Ah;
#pragma unroll
        for (int off = 1; off < 64; off <<= 1) {
          const float y = __shfl_up(x, off);
          if (lane >= off) x += y;
        }
        sCum[lane] = x;
        sDt[lane] = dtv;
      }
#pragma unroll
      for (int i = 0; i < 4; ++i) {
        const int id = tid + 256 * i, row = id >> 3, c16 = id & 7;
        *(u32x4*)(sBT + row * 72 + c16 * 8) = pb[i];
      }
#pragma unroll
      for (int i = 0; i < 2; ++i) {
        const int id = tid + 256 * i, row = id >> 3, c16 = id & 7;
        *(u32x4*)(sXT + row * 72 + c16 * 8) = px[i];
      }
      if (passB) {
#pragma unroll
        for (int i = 0; i < 4; ++i) {
          const int id = tid + 256 * i, row = id >> 4, c16 = id & 15;
          uint4 vc = uint4{0u, 0u, 0u, 0u}, vb = uint4{0u, 0u, 0u, 0u};
          if (row < len) {
            const size_t a = (size_t)(t0 + row) * 512 + g * 128 + c16 * 8;
            vc = *(const uint4*)(Crm + a);
            vb = *(const uint4*)(Brm + a);
          }
          *(uint4*)(sC + row * 136 + c16 * 8) = vc;
          *(uint4*)(sB + row * 136 + c16 * 8) = vb;
        }
      }
      __syncthreads();
      if (ci + 1 < nch) SSD_ISSUE(c0 + ci + 1)
      const float cumlast = sCum[63];
      f32x4 cbm[1][4];
      if (passB) {
#pragma unroll
        for (int nt = 0; nt < 4; ++nt) cbm[0][nt] = f32x4{0.f, 0.f, 0.f, 0.f};
        mma_lds<1, 4, 4>(cbm, sC + (16 * wave) * 136, 136, sB, 136, r, q);
#pragma unroll
        for (int mt = 0; mt < 2; ++mt)
#pragma unroll
          for (int nt = 0; nt < 4; ++nt) {
            const int s0 = 32 * wave + mt * 16 + q * 4, p = nt * 16 + r;
            uint2 u;
            u.x = pack2(accS[mt][nt][0], accS[mt][nt][1]);
            u.y = pack2(accS[mt][nt][2], accS[mt][nt][3]);
            *(uint2*)(sS + p * 136 + s0) = u;
          }
        __syncthreads();
#pragma unroll
        for (int nt = 0; nt < 4; ++nt)
#pragma unroll
          for (int jj = 0; jj < 4; ++jj) {
            const int i = 16 * wave + q * 4 + jj, j = nt * 16 + r;
            float wv = 0.f;
            if (j <= i) wv = cbm[0][nt][jj] * __expf(sCum[i] - sCum[j]) * sDt[j];
            sW[i * 72 + j] = f2bf(wv);
          }
      }
#pragma unroll
      for (int i = 0; i < 2; ++i) {
        const int id = tid + 256 * i, p = id >> 3, j0 = (id & 7) * 8;
        const uint4 u = *(const uint4*)(sXT + p * 72 + j0);
        float wb[8];
#pragma unroll
        for (int e = 0; e < 8; ++e) wb[e] = __expf(cumlast - sCum[j0 + e]) * sDt[j0 + e];
        uint4 o;
        o.x = pack2(lo_bf(u.x) * wb[0], hi_bf(u.x) * wb[1]);
        o.y = pack2(lo_bf(u.y) * wb[2], hi_bf(u.y) * wb[3]);
        o.z = pack2(lo_bf(u.z) * wb[4], hi_bf(u.z) * wb[5]);
        o.w = pack2(lo_bf(u.w) * wb[6], hi_bf(u.w) * wb[7]);
        *(uint4*)(sXW + p * 72 + j0) = o;
      }
      __syncthreads();
      if (passB) {
        f32x4 y1[1][4], y2[1][4];
#pragma unroll
        for (int nt = 0; nt < 4; ++nt) { y1[0][nt] = f32x4{0.f, 0.f, 0.f, 0.f}; y2[0][nt] = f32x4{0.f, 0.f, 0.f, 0.f}; }
        mma_lds<1, 4, 2>(y1, sW + (16 * wave) * 72, 72, sXT, 72, r, q);
        mma_lds<1, 4, 4>(y2, sC + (16 * wave) * 136, 136, sS, 136, r, q);
        float ss[4] = {0.f, 0.f, 0.f, 0.f};
        float ec[4];
#pragma unroll
        for (int jj = 0; jj < 4; ++jj) ec[jj] = __expf(sCum[16 * wave + q * 4 + jj]);
#pragma unroll
        for (int nt = 0; nt < 4; ++nt) {
          const int p = nt * 16 + r;
          const uint2 xu = *(const uint2*)(sXT + p * 72 + 16 * wave + q * 4);
          float xv[4];
          xv[0] = lo_bf(xu.x); xv[1] = hi_bf(xu.x); xv[2] = lo_bf(xu.y); xv[3] = hi_bf(xu.y);
#pragma unroll
          for (int jj = 0; jj < 4; ++jj) {
            const int i = 16 * wave + q * 4 + jj;
            if (i < len) {
              const float yv = y1[0][nt][jj] + ec[jj] * y2[0][nt][jj] + Dh * xv[jj];
              const size_t a = (size_t)(t0 + i) * 2048 + hd * 64 + p;
              const float yz = yv * silu_(bf2f(zbuf[a]));
              zbuf[a] = f2bf(yz);
              ss[jj] += yz * yz;
            }
          }
        }
#pragma unroll
        for (int jj = 0; jj < 4; ++jj) {
          float s = ss[jj];
          s += __shfl_xor(s, 1);
          s += __shfl_xor(s, 2);
          s += __shfl_xor(s, 4);
          s += __shfl_xor(s, 8);
          const int i = 16 * wave + q * 4 + jj;
          if (r == 0 && i < len) ssq[(size_t)(t0 + i) * 32 + hd] = s;
        }
      }
      {
        const float cd = __expf(cumlast);
#pragma unroll
        for (int mt = 0; mt < 2; ++mt)
#pragma unroll
          for (int nt = 0; nt < 4; ++nt)
#pragma unroll
            for (int jj = 0; jj < 4; ++jj) accS[mt][nt][jj] *= cd;
        mma_lds<2, 4, 2>(accS, sBT + (32 * wave) * 72, 72, sXW, 72, r, q);
        totcum += cumlast;
      }
    }
#pragma unroll
    for (int mt = 0; mt < 2; ++mt)
#pragma unroll
      for (int nt = 0; nt < 4; ++nt) {
        const int s0 = 32 * wave + mt * 16 + q * 4, p = nt * 16 + r;
        float4 t4;
        t4.x = accS[mt][nt][0]; t4.y = accS[mt][nt][1]; t4.z = accS[mt][nt][2]; t4.w = accS[mt][nt][3];
        if (!passB) *(float4*)(Sseg + (((size_t)sg * 32 + hd) * 64 + p) * 128 + s0) = t4;
        else if (sg == NSEG_S - 1) *(float4*)(P.out + O_SH_P + ((size_t)hd * 64 + p) * 128 + s0) = t4;
        else if (sg >= NSEG_S) *(float4*)(P.out + O_SH_S + (((size_t)b * 32 + hd) * 64 + p) * 128 + s0) = t4;
      }
#undef SSD_ISSUE
    if (!passB && tid == 0) cdseg[sg * 32 + hd] = __expf(totcum);
  }
}

__device__ __forceinline__ void ph_ssd_scan(const Params& P) {
  float* Sseg = (float*)(P.ws + S_SSEG);
  const float* cdseg = (const float*)(P.ws + S_CDSEG);
  for (int idx = blockIdx.x * 256 + otid(); idx < 32 * 64 * 128; idx += gridDim.x * 256) {
    const int hd = idx >> 13;
    float cur = 0.f;
    for (int s = 0; s < NSEG_S; ++s) {
      const size_t a = (size_t)s * 262144 + idx;
      float tmp = 0.f, D = 0.f;
      if (s < NSEG_S - 1) { tmp = Sseg[a]; D = cdseg[s * 32 + hd]; }
      Sseg[a] = cur;
      cur = D * cur + tmp;
    }
  }
}

constexpr size_t OFF_BAR = 268435456ull - 4096;
#define XB_CNT(x) (32 + 32 * (x))
#define XB_SUB(x) (320 + 32 * (x))
#define XB_GEN(x) (608 + 32 * (x))
#define XB_TOP 896
#define XB_TOPGEN 928
__device__ __forceinline__ unsigned xb_ld(unsigned* p) { return __hip_atomic_load(p, __ATOMIC_RELAXED, __HIP_MEMORY_SCOPE_AGENT); }
__device__ __forceinline__ unsigned xb_add(unsigned* p, unsigned v) { return __hip_atomic_fetch_add(p, v, __ATOMIC_RELAXED, __HIP_MEMORY_SCOPE_AGENT); }
__device__ __forceinline__ void grid_barrier(unsigned* bar, char* smem) {
  asm volatile("s_waitcnt vmcnt(0)" ::: "memory");
  __syncthreads();
  if (otid() == 0) {
    volatile unsigned* st = (volatile unsigned*)(smem + SMEM_XB);
    const unsigned x = st[2];
    unsigned nloc = st[0], nx = st[1];
    if (nloc == 0u) {
      const unsigned G = gridDim.x;
      for (;;) {
        unsigned sum = 0u, cnt = 0u, mine = 0u;
#pragma unroll
        for (unsigned j = 0; j < 8; ++j) {
          const unsigned c = xb_ld(&bar[XB_CNT(j)]);
          sum += c;
          cnt += (c > 0u) ? 1u : 0u;
          mine = (j == x) ? c : mine;
        }
        if (sum == G) { nloc = mine; nx = cnt; break; }
        __builtin_amdgcn_s_sleep(1);
      }
      st[0] = nloc;
      st[1] = nx;
    }
    const unsigned old = xb_add(&bar[XB_SUB(x)], 1u);
    const unsigned gen = old / nloc;
    if (old + 1u == (gen + 1u) * nloc) {
      __builtin_amdgcn_fence(__ATOMIC_RELEASE, "agent");
      asm volatile("s_waitcnt vmcnt(0)" ::: "memory");
      const unsigned og = xb_add(&bar[XB_TOP], 1u);
      const unsigned tg = og / nx;
      if (og + 1u == (tg + 1u) * nx) xb_add(&bar[XB_TOPGEN], 1u);
      else while (xb_ld(&bar[XB_TOPGEN]) == tg) __builtin_amdgcn_s_sleep(1);
      __builtin_amdgcn_fence(__ATOMIC_ACQUIRE, "agent");
      xb_add(&bar[XB_GEN(x)], 1u);
      asm volatile("s_waitcnt vmcnt(0)" ::: "memory");
    } else {
      while (xb_ld(&bar[XB_GEN(x)]) == gen) __builtin_amdgcn_s_sleep(1);
      __builtin_amdgcn_fence(__ATOMIC_ACQUIRE, "agent");
      asm volatile("s_waitcnt vmcnt(0)" ::: "memory");
    }
  }
  __syncthreads();
}

constexpr int NPH = 30;

__device__ __forceinline__ void run_gla(const int sub, const int layer, const int li, const Params& P, char* smem) {
  const float* xin_p = li == 0 ? P.in[0] : P.out + O_YP;
  const float* xin_s = li == 0 ? P.in[1] : P.out + O_YS;
  bf16_t* Win = (bf16_t*)(P.ws + OFF_WIN);
  bf16_t* Wout = (bf16_t*)(P.ws + (layer == 0 ? OFF_WOUT : OFF_WOUT1));
  bf16_t* H = (bf16_t*)(P.ws + OFF_H);
  switch (sub) {
    case 0:
      if (li == 0) {
        ph_convT(P.in[9], 1024, 3088, 3136, Win, nullptr, smem);
        ph_convT(P.in[13], 1024, 1024, 1024, Wout, nullptr, smem);
      }
      ph_norm(xin_p, xin_s, P.in[7] + li * 1024, H, li == 0 ? P.out : nullptr);
      break;
    case 1: {
      EpiGlaIn e{(bf16_t*)(P.ws + G_QD), (bf16_t*)(P.ws + G_KD), (bf16_t*)(P.ws + G_VT), (bf16_t*)(P.ws + G_G),
                 (float*)(P.ws + G_GLR)};
      gemm_phase(H, 1024, Win, 1024, 1024, 3088, e, smem);
    } break;
    case 2: ph_gla_prep(P, layer, smem); break;
    case 3: ph_gla_pass(false, layer, P, smem); break;
    case 4:
      ph_gla_scan(P);
      if (layer == 0) {
        ph_convT(P.in[14], 1024, 2816, 2816, Win, nullptr, smem);
        ph_convT(P.in[22], 1408, 1024, 1024, (bf16_t*)(P.ws + OFF_WOUT1), nullptr, smem);
        ph_conv_gate(P.in[17], (bf16_t*)(P.ws + OFF_WG));
        ph_conv_gate(P.in[19], (bf16_t*)(P.ws + OFF_WG) + 16 * 96 * 96);
      }
      break;
    case 5: ph_gla_pass(true, layer, P, smem); break;
    case 6: ph_gla_aprep(P, layer); break;
    case 7: {
      EpiResid e{xin_p, xin_s, P.out};
      gemm_phase((const bf16_t*)(P.ws + G_O), 1024, Wout, 1024, 1024, 1024, e, smem);
    } break;
  }
}

__device__ __forceinline__ void run_phase(const int ph, const Params& P, char* smem) {
  bf16_t* Win = (bf16_t*)(P.ws + OFF_WIN);
  bf16_t* Wout = (bf16_t*)(P.ws + OFF_WOUT);
  bf16_t* H = (bf16_t*)(P.ws + OFF_H);
  const float* xin_p = P.out + O_YP;
  const float* xin_s = P.out + O_YS;
  if (ph < 8) { run_gla(ph, 0, 0, P, smem); return; }
  if (ph >= 21 && ph < 29) { run_gla(ph - 21, 1, 3, P, smem); return; }
  switch (ph) {
    case 8:
      ph_norm(xin_p, xin_s, P.in[7] + 1 * 1024, H, nullptr);
      break;
    case 9: {
      EpiLruIn e{(bf16_t*)(P.ws + L_XB), (bf16_t*)(P.ws + L_GATE)};
      gemm_phase(H, 1024, Win, 1024, 1024, 2816, e, smem);
    } break;
    case 10: ph_lru_pass(false, P, smem); break;
    case 11:
      ph_lru_scan(P, smem);
      ph_convT(P.in[23], 1024, 5152, 5184, Win, nullptr, smem);
      ph_convT(P.in[30], 2048, 1024, 1024, Wout, P.in[29], smem);
      break;
    case 12: ph_lru_pass(true, P, smem); break;
    case 13: {
      EpiResid e{xin_p, xin_s, P.out};
      gemm_phase((const bf16_t*)(P.ws + L_Y), LW, (const bf16_t*)(P.ws + OFF_WOUT1), LW, LW, 1024, e, smem);
    } break;
    case 14:
      ph_norm(xin_p, xin_s, P.in[7] + 2 * 1024, H, nullptr);
      break;
    case 15: {
      EpiSsdIn e{(bf16_t*)(P.ws + S_Z), (bf16_t*)(P.ws + S_XBCT), (bf16_t*)(P.ws + S_TAIL), (float*)(P.ws + S_DT), P.in[26]};
      gemm_phase(H, 1024, Win, 1024, 1024, 5152, e, smem);
    } break;
    case 16: ph_ssd_conv(P); break;
    case 17: ph_ssd_pass(false, P, smem); break;
    case 18:
      ph_ssd_scan(P);
      ph_convT(P.in[9] + (size_t)1024 * 3088, 1024, 3088, 3136, Win, nullptr, smem);
      ph_convT(P.in[13] + (size_t)1024 * 1024, 1024, 1024, 1024, (bf16_t*)(P.ws + OFF_WOUT1), nullptr, smem);
      break;
    case 19: ph_ssd_pass(true, P, smem); break;
    case 20: {
      EpiResidScaled e{xin_p, xin_s, P.out, (const float*)(P.ws + S_SSQ), 0.f, 0.f, 0};
      gemm_phase((const bf16_t*)(P.ws + S_Z), 2048, Wout, 2048, 2048, 1024, e, smem);
    } break;
    case 29: ph_final_norm(P.out, P.in[8]); break;
    default: break;
  }
}

__global__ void __launch_bounds__(256, 2) mega(Params P) {
  __shared__ __attribute__((aligned(16))) char smem[SMEM_BYTES];
  unsigned* bar = (unsigned*)(P.ws + OFF_BAR);
  if (threadIdx.x == 0) {
    const unsigned xcc = (unsigned)__builtin_amdgcn_s_getreg((3 << 11) | 20) & 7u;
    (void)xb_add(&bar[XB_CNT(xcc)], 1u);
    volatile unsigned* st = (volatile unsigned*)(smem + SMEM_XB);
    st[0] = 0u; st[1] = 0u; st[2] = xcc;
  }
  __syncthreads();
  if (P.out == nullptr) cg::this_grid().sync();
#define PRE(n) if (PREMASK & (1u << (n))) { run_phase((n), P, smem); grid_barrier(bar, smem); }
  PRE(0) PRE(1) PRE(2) PRE(3) PRE(4) PRE(5) PRE(6) PRE(7) PRE(8) PRE(9)
  PRE(10) PRE(11) PRE(12) PRE(13) PRE(14) PRE(15) PRE(16) PRE(17) PRE(18) PRE(19)
  PRE(20) PRE(21) PRE(22) PRE(23) PRE(24) PRE(25) PRE(26) PRE(27) PRE(28) PRE(29)
#undef PRE
#define PHASE(n) { if ((n) > 0 || PREMASK) grid_barrier(bar, smem); run_phase((n), P, smem); if (DUPMASK & (1u << (n))) { grid_barrier(bar, smem); run_phase((n), P, smem); } }
  PHASE(0) PHASE(1) PHASE(2) PHASE(3) PHASE(4) PHASE(5) PHASE(6) PHASE(7) PHASE(8) PHASE(9)
  PHASE(10) PHASE(11) PHASE(12) PHASE(13) PHASE(14) PHASE(15) PHASE(16) PHASE(17) PHASE(18) PHASE(19)
  PHASE(20) PHASE(21) PHASE(22) PHASE(23) PHASE(24) PHASE(25) PHASE(26) PHASE(27) PHASE(28) PHASE(29)
#undef PHASE
}

extern "C" void kernel_launch(void* const* d_in, const int* in_sizes, int n_in, void* d_out, int out_size, void* d_ws,
                              size_t ws_size, hipStream_t stream) {
  Params P{};
  for (int i = 0; i < 31; ++i) P.in[i] = (const float*)d_in[i];
  P.out = (float*)d_out;
  P.ws = (char*)d_ws;
  static int grid = 0;
  void* args[] = {&P};
  (void)hipMemsetAsync(P.ws + OFF_BAR, 0, 4096, stream);
  if (!grid) {
    int dev = 0, cus = 0;
    (void)hipGetDevice(&dev);
    (void)hipDeviceGetAttribute(&cus, hipDeviceAttributeMultiprocessorCount, dev);
    grid = cus * 2;
    hipError_t e0 = hipLaunchCooperativeKernel((void*)mega, dim3(grid), dim3(256), args, 0, stream);
    if (e0 != hipSuccess) {
      (void)hipGetLastError();
      grid = cus;
      e0 = hipLaunchCooperativeKernel((void*)mega, dim3(grid), dim3(256), args, 0, stream);
      if (e0 != hipSuccess) fprintf(stderr, "cooperative launch failed: %s (grid %d)\n", hipGetErrorString(e0), grid);
    }
    return;
  }
  hipError_t e = hipLaunchCooperativeKernel((void*)mega, dim3(grid), dim3(256), args, 0, stream);
  if (e != hipSuccess) fprintf(stderr, "cooperative launch failed: %s (grid %d)\n", hipGetErrorString(e), grid);
}
```

```cpp
#include <hip/hip_runtime.h>
#include <hip/hip_cooperative_groups.h>
#include <cstdio>
namespace cg = cooperative_groups;

#ifndef DUPMASK
#define DUPMASK 0u
#endif
#ifndef PREMASK
#define PREMASK 0u
#endif
#ifndef ONE_LAUNCH
#define ONE_LAUNCH 1
#endif

typedef unsigned short bf16_t;
using bf16x8 = __attribute__((ext_vector_type(8))) short;
using f32x4 = __attribute__((ext_vector_type(4))) float;
using u32x4 = __attribute__((ext_vector_type(4))) unsigned;

constexpr int T_P = 16384, T_S = 128, T = 16512;
constexpr int NCH = 264;
constexpr int NSEG_G = 32, NSEGT_G = NSEG_G + 8;
constexpr int NSEG_S = 16, NSEGT_S = NSEG_S + 8;
constexpr int LW = 1408;
constexpr float EPS = 1e-6f;

constexpr size_t O_YP = 0;
constexpr size_t O_YS = O_YP + (size_t)T_P * 1024;
constexpr size_t O_GLA_P = O_YS + (size_t)T_S * 1024;
constexpr size_t O_LCONV_P = O_GLA_P + (size_t)2 * 4 * 128 * 256;
constexpr size_t O_LH_P = O_LCONV_P + 3 * LW;
constexpr size_t O_SCONV_P = O_LH_P + LW;
constexpr size_t O_SH_P = O_SCONV_P + 3 * 3072;
constexpr size_t O_GLA_S = O_SH_P + (size_t)32 * 64 * 128;
constexpr size_t O_LCONV_S = O_GLA_S + (size_t)2 * 8 * 4 * 128 * 256;
constexpr size_t O_LH_S = O_LCONV_S + 8 * 3 * LW;
constexpr size_t O_SCONV_S = O_LH_S + 8 * LW;
constexpr size_t O_SH_S = O_SCONV_S + 8 * 3 * 3072;

constexpr size_t OFF_WIN = 0;
constexpr size_t OFF_WOUT = OFF_WIN + (size_t)5248 * 1024 * 2;
constexpr size_t OFF_WOUT1 = OFF_WOUT + (size_t)1024 * 2048 * 2;
constexpr size_t OFF_WG = OFF_WOUT1 + (size_t)1024 * 2048 * 2;
constexpr size_t OFF_H = OFF_WG + (size_t)2 * 16 * 96 * 96 * 2;
constexpr size_t OFF_BIG = OFF_H + (size_t)T * 1024 * 2;
constexpr size_t G_QD = OFF_BIG;
constexpr size_t G_KD = G_QD + (size_t)T * 512 * 2;
constexpr size_t G_KDT = G_KD + (size_t)T * 512 * 2;
constexpr size_t G_VT = G_KDT + (size_t)NCH * 512 * 64 * 2;
constexpr size_t G_G = G_VT + (size_t)NCH * 1024 * 64 * 2;
constexpr size_t G_O = G_G + (size_t)T * 1024 * 2;
constexpr size_t G_GLR = G_O + (size_t)T * 1024 * 2;
constexpr size_t G_SSQ = G_GLR + (size_t)T * 16 * 4;
constexpr size_t G_DEC = G_SSQ + (size_t)T * 16 * 4;
constexpr size_t G_SSEG = G_DEC + (size_t)NCH * 512 * 4;
constexpr size_t G_DSEG = G_SSEG + (size_t)NSEG_G * 4 * 256 * 128 * 4;
constexpr size_t G_END = G_DSEG + (size_t)NSEG_G * 512 * 4;
constexpr size_t L_XB = OFF_BIG;
constexpr size_t L_GATE = L_XB + (size_t)T * LW * 2;
constexpr size_t L_Y = L_GATE + (size_t)T * LW * 2;
constexpr size_t L_ASEG = L_Y + (size_t)T * LW * 2;
constexpr size_t L_HSEG = L_ASEG + (size_t)NCH * LW * 4;
constexpr size_t L_END = L_HSEG + (size_t)NCH * LW * 4;
constexpr size_t S_Z = OFF_BIG;
constexpr size_t S_XBCT = S_Z + (size_t)T * 2048 * 2;
constexpr size_t S_DT = S_XBCT + (size_t)NCH * 3072 * 64 * 2;
constexpr size_t S_TAIL = S_DT + (size_t)T * 32 * 4;
constexpr size_t S_SSQ = S_TAIL + (size_t)NCH * 3072 * 4 * 2;
constexpr size_t S_SSEG = S_SSQ + (size_t)T * 32 * 4;
constexpr size_t S_CDSEG = S_SSEG + (size_t)NSEG_S * 32 * 64 * 128 * 4;
constexpr size_t S_END = S_CDSEG + 4096;
constexpr size_t S_BRM = OFF_H;
constexpr size_t S_CRM = OFF_H + (size_t)T * 512 * 2;
static_assert(G_END <= 268435456ull - 4096 && L_END <= 268435456ull - 4096 && S_END <= 268435456ull - 4096, "ws overflow");

constexpr int SMEM_BYTES = 81920;
constexpr int SMEM_XB = 81856;

struct Params {
  const float* in[31];
  float* out;
  char* ws;
};

__device__ __forceinline__ int otid() { int t = threadIdx.x; asm volatile("" : "+v"(t)); return t; }
__device__ __forceinline__ bf16_t f2bf(float f) {
  unsigned u = __float_as_uint(f);
  u += 0x7fffu + ((u >> 16) & 1u);
  return (bf16_t)(u >> 16);
}
__device__ __forceinline__ float bf2f(bf16_t b) { return __uint_as_float(((unsigned)b) << 16); }
__device__ __forceinline__ unsigned pack2(float a, float b) { return (unsigned)f2bf(a) | ((unsigned)f2bf(b) << 16); }
__device__ __forceinline__ float lo_bf(unsigned w) { return __uint_as_float(w << 16); }
__device__ __forceinline__ float hi_bf(unsigned w) { return __uint_as_float(w & 0xffff0000u); }
__device__ __forceinline__ float sigmoid_(float x) { return __builtin_amdgcn_rcpf(1.f + __expf(-x)); }
__device__ __forceinline__ float silu_(float x) { return x * __builtin_amdgcn_rcpf(1.f + __expf(-x)); }
__device__ __forceinline__ float softplus_(float x) { return fmaxf(x, 0.f) + log1pf(__expf(-fabsf(x))); }

__device__ __forceinline__ void tok2chunk(int t, int& c, int& j) {
  if (t < T_P) { c = t >> 6; j = t & 63; }
  else { int u = t - T_P; c = 256 + (u >> 4); j = u & 15; }
}
__device__ __forceinline__ void chunk_info(int c, int& t0, int& len) {
  if (c < 256) { t0 = c * 64; len = 64; }
  else { t0 = T_P + (c - 256) * 16; len = 16; }
}
__device__ __forceinline__ void seg_info(int sg, int nseg, int& c0, int& nch, int& b) {
  if (sg < nseg) { const int cps = 256 / nseg; c0 = sg * cps; nch = cps; b = -1; }
  else { c0 = 256 + (sg - nseg); nch = 1; b = sg - nseg; }
}

template <int MT, int NT, int KS>
__device__ __forceinline__ void mma_lds(f32x4 (&acc)[MT][NT], const bf16_t* A, int lda, const bf16_t* B, int ldb, int r, int q) {
#pragma unroll
  for (int ks = 0; ks < KS; ++ks) {
    bf16x8 af[MT], bfr[NT];
#pragma unroll
    for (int mi = 0; mi < MT; ++mi) af[mi] = *(const bf16x8*)(A + (mi * 16 + r) * lda + ks * 32 + q * 8);
#pragma unroll
    for (int ni = 0; ni < NT; ++ni) bfr[ni] = *(const bf16x8*)(B + (ni * 16 + r) * ldb + ks * 32 + q * 8);
#pragma unroll
    for (int mi = 0; mi < MT; ++mi)
#pragma unroll
      for (int ni = 0; ni < NT; ++ni)
        acc[mi][ni] = __builtin_amdgcn_mfma_f32_16x16x32_bf16(af[mi], bfr[ni], acc[mi][ni], 0, 0, 0);
  }
}

__device__ __forceinline__ void ph_convT(const float* __restrict__ src, int K, int N, int Npad, bf16_t* __restrict__ dst,
                         const float* __restrict__ kscale, char* smem) {
  float* tile = (float*)smem;
  const int tid = otid();
  const int ktn = K / 64, ntn = Npad / 64;
  for (int it = blockIdx.x; it < ktn * ntn; it += gridDim.x) {
    const int kt = it / ntn, nt = it - kt * ntn;
    const int k0 = kt * 64, n0 = nt * 64;
    __syncthreads();
    {
      const int nn = tid & 63, n = n0 + nn;
#pragma unroll 4
      for (int i = 0; i < 16; ++i) {
        const int kk = (tid >> 6) + 4 * i;
        float v = 0.f;
        if (n < N) {
          v = src[(size_t)(k0 + kk) * N + n];
          if (kscale) v *= kscale[k0 + kk];
        }
        tile[kk * 65 + nn] = v;
      }
    }
    __syncthreads();
#pragma unroll
    for (int i = 0; i < 2; ++i) {
      const int nn = (tid >> 3) + 32 * i, kk = (tid & 7) * 8;
      uint4 u;
      u.x = pack2(tile[(kk + 0) * 65 + nn], tile[(kk + 1) * 65 + nn]);
      u.y = pack2(tile[(kk + 2) * 65 + nn], tile[(kk + 3) * 65 + nn]);
      u.z = pack2(tile[(kk + 4) * 65 + nn], tile[(kk + 5) * 65 + nn]);
      u.w = pack2(tile[(kk + 6) * 65 + nn], tile[(kk + 7) * 65 + nn]);
      *(uint4*)(dst + (size_t)(n0 + nn) * K + k0 + kk) = u;
    }
  }
}

__device__ __forceinline__ void ph_conv_gate(const float* __restrict__ w, bf16_t* __restrict__ dst) {
  for (int idx = blockIdx.x * 256 + otid(); idx < 16 * 96 * 96; idx += gridDim.x * 256) {
    const int k = idx / 9216, rem = idx - k * 9216, co = rem / 96, ci = rem - co * 96;
    float v = 0.f;
    if (co < 88 && ci < 88) v = w[(k * 88 + ci) * 88 + co];
    dst[idx] = f2bf(v);
  }
}

__device__ __forceinline__ void ph_norm(const float* __restrict__ xp, const float* __restrict__ xs, const float* __restrict__ w,
                        bf16_t* __restrict__ h, float* xcopy) {
  const int lane = otid() & 63, wave = otid() >> 6;
  for (int row = blockIdx.x * 4 + wave; row < T; row += gridDim.x * 4) {
    const float* src = row < T_P ? xp + (size_t)row * 1024 : xs + (size_t)(row - T_P) * 1024;
    float4 v[4];
    float ss = 0.f;
#pragma unroll
    for (int i = 0; i < 4; ++i) {
      v[i] = *(const float4*)(src + i * 256 + lane * 4);
      ss += v[i].x * v[i].x + v[i].y * v[i].y + v[i].z * v[i].z + v[i].w * v[i].w;
    }
#pragma unroll
    for (int off = 32; off >= 1; off >>= 1) ss += __shfl_xor(ss, off);
    const float rs = rsqrtf(ss * (1.f / 1024.f) + EPS);
    if (xcopy != nullptr && row >= T_P) {
#pragma unroll
      for (int i = 0; i < 4; ++i) *(float4*)(xcopy + (size_t)row * 1024 + i * 256 + lane * 4) = v[i];
    }
#pragma unroll
    for (int i = 0; i < 4; ++i) {
      const float4 ww = *(const float4*)(w + i * 256 + lane * 4);
      uint2 o;
      o.x = pack2(v[i].x * rs * ww.x, v[i].y * rs * ww.y);
      o.y = pack2(v[i].z * rs * ww.z, v[i].w * rs * ww.w);
      *(uint2*)(h + (size_t)row * 1024 + i * 256 + lane * 4) = o;
    }
  }
}

__device__ __forceinline__ void ph_final_norm(float* __restrict__ x, const float* __restrict__ w) {
  const int lane = otid() & 63, wave = otid() >> 6;
  for (int row = blockIdx.x * 4 + wave; row < T; row += gridDim.x * 4) {
    float* src = x + (size_t)row * 1024;
    float4 v[4];
    float ss = 0.f;
#pragma unroll
    for (int i = 0; i < 4; ++i) {
      v[i] = *(const float4*)(src + i * 256 + lane * 4);
      ss += v[i].x * v[i].x + v[i].y * v[i].y + v[i].z * v[i].z + v[i].w * v[i].w;
    }
#pragma unroll
    for (int off = 32; off >= 1; off >>= 1) ss += __shfl_xor(ss, off);
    const float rs = rsqrtf(ss * (1.f / 1024.f) + EPS);
#pragma unroll
    for (int i = 0; i < 4; ++i) {
      const float4 ww = *(const float4*)(w + i * 256 + lane * 4);
      float4 o;
      o.x = v[i].x * rs * ww.x; o.y = v[i].y * rs * ww.y; o.z = v[i].z * rs * ww.z; o.w = v[i].w * rs * ww.w;
      *(float4*)(src + i * 256 + lane * 4) = o;
    }
  }
}

#define GLDS16(gp, lp) __builtin_amdgcn_global_load_lds((const unsigned*)(gp), (unsigned*)(lp), 16, 0, 0)
template <class Epi, bool SWP>
__device__ __forceinline__ void gemm_tile(const bf16_t* __restrict__ A, int lda, const bf16_t* __restrict__ Bt, int ldb, int nk,
                                          int tm, int tn, Epi epi, char* smem) {
  const int tid = otid(), lane = tid & 63, wave = tid >> 6;
  const int wm = wave >> 1, wn = wave & 1, r = lane & 15, q = lane >> 4;
  const int srow = tid >> 2, skc = (tid & 3) * 8;
  char* l0 = smem + tid * 16;
  f32x4 acc[32];
#pragma unroll
  for (int i = 0; i < 32; ++i) acc[i] = f32x4{0.f, 0.f, 0.f, 0.f};
  const int a_off = wm * 8192 + r * 64 + q * 16;
  const int b_off = 16384 + wn * 4096 + r * 64 + q * 16;
  const int b_offp = 16384 + wn * 4096 + (8 * (r >> 2) + (r & 3)) * 64 + q * 16;
  const bf16_t* Ag = A + (size_t)(tm * 256 + srow) * lda + skc;
  const bf16_t* Bg = Bt + (size_t)(tn * 128 + srow) * ldb + skc;
  const size_t a64 = (size_t)64 * lda, b64 = (size_t)64 * ldb;
#define G_ISSUE(t_, st_)                                   \
  {                                                        \
    const int ko_ = (t_) * 32;                             \
    char* lb_ = l0 + (st_) * 24576;                        \
    GLDS16(Ag + ko_, lb_);                                 \
    GLDS16(Ag + a64 + ko_, lb_ + 4096);                    \
    GLDS16(Ag + 2 * a64 + ko_, lb_ + 8192);                \
    GLDS16(Ag + 3 * a64 + ko_, lb_ + 12288);               \
    GLDS16(Bg + ko_, lb_ + 16384);                         \
    GLDS16(Bg + b64 + ko_, lb_ + 20480);                   \
  }
#define G_STEP(t_, st_)                                                                                   \
  {                                                                                                       \
    const int tt_ = (t_);                                                                                 \
    if (tt_ + 1 < nk) asm volatile("s_waitcnt vmcnt(6) lgkmcnt(0)\n\ts_barrier" ::: "memory");            \
    else asm volatile("s_waitcnt vmcnt(0) lgkmcnt(0)\n\ts_barrier" ::: "memory");                         \
    if (tt_ + 2 < nk) G_ISSUE(tt_ + 2, ((st_) + 2) % 3)                                                   \
    const char* sb_ = smem + (st_) * 24576;                                                               \
    bf16x8 af_[8], bf_[4];                                                                                \
    _Pragma("unroll") for (int mi = 0; mi < 8; ++mi) af_[mi] = *(const bf16x8*)(sb_ + a_off + mi * 1024);  \
    _Pragma("unroll") for (int ni = 0; ni < 4; ++ni)                                                      \
      bf_[ni] = *(const bf16x8*)(sb_ + (SWP ? b_offp + (ni >> 1) * 2048 + (ni & 1) * 256 : b_off + ni * 1024)); \
    __builtin_amdgcn_s_setprio(1);                                                                        \
    _Pragma("unroll") for (int mi = 0; mi < 8; ++mi)                                                      \
    _Pragma("unroll") for (int ni = 0; ni < 4; ++ni)                                                      \
      acc[mi * 4 + ni] = SWP ? __builtin_amdgcn_mfma_f32_16x16x32_bf16(bf_[ni], af_[mi], acc[mi * 4 + ni], 0, 0, 0) \
                             : __builtin_amdgcn_mfma_f32_16x16x32_bf16(af_[mi], bf_[ni], acc[mi * 4 + ni], 0, 0, 0); \
    __builtin_amdgcn_s_setprio(0);                                                                        \
  }
  asm volatile("s_waitcnt vmcnt(0)" ::: "memory");
  G_ISSUE(0, 0)
  G_ISSUE(1, 1)
  {
    int st = 0;
    for (int t = 0; t < nk; ++t) {
      G_STEP(t, st)
      st = st == 2 ? 0 : st + 1;
    }
  }
#undef G_STEP
#undef G_ISSUE
  epi.begin(tm * 256 + wm * 128, lane);
#pragma unroll
  for (int mi = 0; mi < 8; ++mi)
#pragma unroll
    for (int ni = 0; ni < 4; ++ni) {
      if (SWP) {
        if ((ni & 1) == 0)
          epi.rowvec8(tm * 256 + wm * 128 + mi * 16 + r, tn * 128 + wn * 64 + (ni >> 1) * 32 + q * 8, acc[mi * 4 + ni], acc[mi * 4 + ni + 1]);
      } else epi.colvec(tm * 256 + wm * 128 + mi * 16 + q * 4, tn * 128 + wn * 64 + ni * 16 + r, acc[mi * 4 + ni]);
    }
}

template <class Epi>
__device__ __forceinline__ void gemm_main(const bf16_t* __restrict__ A, int lda, const bf16_t* __restrict__ Bt, int ldb, int K,
                                          int Ntiles, Epi epi, char* smem) {
  const int nk = K / 32;
  const int total = 64 * Ntiles;
  for (int sidx = blockIdx.x; sidx < total; sidx += gridDim.x) {
    const int u = sidx >> 3;
    const int tn = u >> 3, tm = (sidx & 7) * 8 + (u & 7);
    if (epi.swapped_col(tn * 128)) gemm_tile<Epi, true>(A, lda, Bt, ldb, nk, tm, tn, epi, smem);
    else gemm_tile<Epi, false>(A, lda, Bt, ldb, nk, tm, tn, epi, smem);
  }
}

template <class Epi>
__device__ __forceinline__ void gemm_side(const bf16_t* __restrict__ A, int lda, const bf16_t* __restrict__ Bt, int ldb, int K,
                                          int N, int Nfull, Epi epi) {
  const int tid = otid(), lane = tid & 63, wave = tid >> 6, r = lane & 15, q = lane >> 4;
  const int ncg = (N + 31) >> 5, cg_left0 = Nfull >> 5, nleft = ncg - cg_left0;
  constexpr int KS = Epi::KSPLIT;
  const int njobs0 = ncg + nleft * 128, njobs = njobs0 * KS;
  const int Kpart = K / KS;
  for (int jx = blockIdx.x; jx < njobs; jx += gridDim.x) {
    const int ks = KS > 1 ? jx / njobs0 : 0, j = jx - ks * njobs0;
    int row0, cg;
    if (j < ncg) { row0 = T_P; cg = j; }
    else { const int jj = j - ncg, rt = jj / nleft; row0 = rt * 128; cg = cg_left0 + (jj - rt * nleft); }
    const int col0 = cg * 32;
    const bool swp = epi.swapped_col(col0);
    f32x4 acc[4];
#pragma unroll
    for (int i = 0; i < 4; ++i) acc[i] = f32x4{0.f, 0.f, 0.f, 0.f};
    const bf16_t* Ap = A + (size_t)(row0 + 32 * wave + r) * lda + q * 8 + ks * Kpart;
    const bf16_t* Bp = Bt + (size_t)(col0 + r) * ldb + q * 8 + ks * Kpart;
    const size_t a16 = (size_t)16 * lda, b16 = (size_t)16 * ldb;
    if (swp) {
#pragma unroll 4
      for (int k0 = 0; k0 < Kpart; k0 += 32) {
        const bf16x8 a0 = *(const bf16x8*)(Ap + k0), a1 = *(const bf16x8*)(Ap + a16 + k0);
        const bf16x8 b0 = *(const bf16x8*)(Bp + k0), b1 = *(const bf16x8*)(Bp + b16 + k0);
        acc[0] = __builtin_amdgcn_mfma_f32_16x16x32_bf16(b0, a0, acc[0], 0, 0, 0);
        acc[1] = __builtin_amdgcn_mfma_f32_16x16x32_bf16(b1, a0, acc[1], 0, 0, 0);
        acc[2] = __builtin_amdgcn_mfma_f32_16x16x32_bf16(b0, a1, acc[2], 0, 0, 0);
        acc[3] = __builtin_amdgcn_mfma_f32_16x16x32_bf16(b1, a1, acc[3], 0, 0, 0);
      }
    } else {
#pragma unroll 4
      for (int k0 = 0; k0 < Kpart; k0 += 32) {
        const bf16x8 a0 = *(const bf16x8*)(Ap + k0), a1 = *(const bf16x8*)(Ap + a16 + k0);
        const bf16x8 b0 = *(const bf16x8*)(Bp + k0), b1 = *(const bf16x8*)(Bp + b16 + k0);
        acc[0] = __builtin_amdgcn_mfma_f32_16x16x32_bf16(a0, b0, acc[0], 0, 0, 0);
        acc[1] = __builtin_amdgcn_mfma_f32_16x16x32_bf16(a0, b1, acc[1], 0, 0, 0);
        acc[2] = __builtin_amdgcn_mfma_f32_16x16x32_bf16(a1, b0, acc[2], 0, 0, 0);
        acc[3] = __builtin_amdgcn_mfma_f32_16x16x32_bf16(a1, b1, acc[3], 0, 0, 0);
      }
    }
    epi.begin(row0 + 32 * wave, lane);
#pragma unroll
    for (int mi = 0; mi < 2; ++mi)
#pragma unroll
      for (int ni = 0; ni < 2; ++ni) {
        if (KS > 1) epi.rowvec_acc(row0 + 32 * wave + mi * 16 + r, col0 + ni * 16 + q * 4, acc[mi * 2 + ni]);
        else if (swp) epi.rowvec(row0 + 32 * wave + mi * 16 + r, col0 + ni * 16 + q * 4, acc[mi * 2 + ni]);
        else epi(row0 + 32 * wave + mi * 16 + q * 4, col0 + ni * 16 + r, acc[mi * 2 + ni]);
      }
  }
}

template <class Epi>
__device__ __forceinline__ void gemm_phase(const bf16_t* __restrict__ A, int lda, const bf16_t* __restrict__ Bt, int ldb, int K,
                                           int N, Epi epi, char* smem) {
  gemm_main(A, lda, Bt, ldb, K, N >> 7, epi, smem);
  gemm_side(A, lda, Bt, ldb, K, N, (N >> 7) << 7, epi);
}

struct EpiGlaIn {
  static constexpr int KSPLIT = 1;
  __device__ __forceinline__ void rowvec_acc(int, int, f32x4) const {}
  bf16_t *qd, *kd, *vT, *g;
  float* glr;
  __device__ __forceinline__ void begin(int, int) {}
  __device__ __forceinline__ bool swapped_col(int c) const { return c < 1024 || (c >= 2048 && c < 3072); }
  __device__ __forceinline__ void colvec(int row0, int col, f32x4 v) const {
    uint2 u;
    u.x = pack2(v[0], v[1]);
    u.y = pack2(v[2], v[3]);
    *(uint2*)(vT + ((size_t)(row0 >> 6) * 1024 + (col - 1024)) * 64 + (row0 & 63)) = u;
  }
  __device__ __forceinline__ void rowvec8(int row, int col0, f32x4 v, f32x4 w) const {
    const float sc = col0 < 512 ? 0.08838834764831845f : 1.f;
    const u32x4 u = u32x4{pack2(v[0] * sc, v[1] * sc), pack2(v[2] * sc, v[3] * sc), pack2(w[0] * sc, w[1] * sc), pack2(w[2] * sc, w[3] * sc)};
    bf16_t* dst = col0 < 512 ? qd + (size_t)row * 512 + col0
                : col0 < 1024 ? kd + (size_t)row * 512 + (col0 - 512) : g + (size_t)row * 1024 + (col0 - 2048);
    *(u32x4*)dst = u;
  }
  __device__ __forceinline__ void rowvec(int row, int col0, f32x4 v) const {
    uint2 u;
    if (col0 < 512) {
      const float sc = 0.08838834764831845f;
      u.x = pack2(v[0] * sc, v[1] * sc); u.y = pack2(v[2] * sc, v[3] * sc);
      *(uint2*)(qd + (size_t)row * 512 + col0) = u;
    } else if (col0 < 1024) {
      u.x = pack2(v[0], v[1]); u.y = pack2(v[2], v[3]);
      *(uint2*)(kd + (size_t)row * 512 + (col0 - 512)) = u;
    } else {
      u.x = pack2(v[0], v[1]); u.y = pack2(v[2], v[3]);
      *(uint2*)(g + (size_t)row * 1024 + (col0 - 2048)) = u;
    }
  }
  __device__ __forceinline__ void operator()(int row0, int col, f32x4 v) const {
    if (col < 512) {
#pragma unroll
      for (int jj = 0; jj < 4; ++jj) qd[(size_t)(row0 + jj) * 512 + col] = f2bf(v[jj] * 0.08838834764831845f);
    } else if (col < 1024) {
#pragma unroll
      for (int jj = 0; jj < 4; ++jj) kd[(size_t)(row0 + jj) * 512 + (col - 512)] = f2bf(v[jj]);
    } else if (col < 2048) {
      int c, j;
      tok2chunk(row0, c, j);
      uint2 u;
      u.x = pack2(v[0], v[1]);
      u.y = pack2(v[2], v[3]);
      *(uint2*)(vT + ((size_t)c * 1024 + (col - 1024)) * 64 + j) = u;
    } else if (col < 3072) {
#pragma unroll
      for (int jj = 0; jj < 4; ++jj) g[(size_t)(row0 + jj) * 1024 + (col - 2048)] = f2bf(v[jj]);
    } else if (col < 3088) {
#pragma unroll
      for (int jj = 0; jj < 4; ++jj) glr[(size_t)(row0 + jj) * 16 + (col - 3072)] = v[jj];
    }
  }
};

struct EpiLruIn {
  static constexpr int KSPLIT = 1;
  __device__ __forceinline__ void rowvec_acc(int, int, f32x4) const {}
  bf16_t *xb, *gate;
  __device__ __forceinline__ void begin(int, int) {}
  __device__ __forceinline__ bool swapped_col(int) const { return true; }
  __device__ __forceinline__ void colvec(int, int, f32x4) const {}
  __device__ __forceinline__ void rowvec8(int row, int col0, f32x4 v, f32x4 w) const {
    bf16_t* dst = col0 < LW ? xb + col0 : gate + (col0 - LW);
    *(u32x4*)(dst + (size_t)row * LW) = u32x4{pack2(v[0], v[1]), pack2(v[2], v[3]), pack2(w[0], w[1]), pack2(w[2], w[3])};
  }
  __device__ __forceinline__ void rowvec(int row, int col0, f32x4 v) const {
    bf16_t* dst = col0 < LW ? xb + col0 : gate + (col0 - LW);
    uint2 u;
    u.x = pack2(v[0], v[1]); u.y = pack2(v[2], v[3]);
    *(uint2*)(dst + (size_t)row * LW) = u;
  }
  __device__ __forceinline__ void operator()(int row0, int col, f32x4 v) const {
    bf16_t* dst = col < LW ? xb + col : gate + (col - LW);
#pragma unroll
    for (int jj = 0; jj < 4; ++jj) dst[(size_t)(row0 + jj) * LW] = f2bf(v[jj]);
  }
};

struct EpiSsdIn {
  static constexpr int KSPLIT = 1;
  __device__ __forceinline__ void rowvec_acc(int, int, f32x4) const {}
  bf16_t *z, *xbcT, *tails;
  float* dt;
  const float* dt_bias;
  __device__ __forceinline__ void begin(int, int) {}
  __device__ __forceinline__ bool swapped_col(int c) const { return c < 2048; }
  __device__ __forceinline__ void colvec(int row0, int col, f32x4 v) const {
    const int c = row0 >> 6, j = row0 & 63, cc = col - 2048;
    uint2 u;
    u.x = pack2(v[0], v[1]);
    u.y = pack2(v[2], v[3]);
    *(uint2*)(xbcT + ((size_t)c * 3072 + cc) * 64 + j) = u;
    if (j == 60) *(uint2*)(tails + ((size_t)c * 3072 + cc) * 4) = u;
  }
  __device__ __forceinline__ void rowvec8(int row, int col0, f32x4 v, f32x4 w) const {
    *(u32x4*)(z + (size_t)row * 2048 + col0) = u32x4{pack2(v[0], v[1]), pack2(v[2], v[3]), pack2(w[0], w[1]), pack2(w[2], w[3])};
  }
  __device__ __forceinline__ void rowvec(int row, int col0, f32x4 v) const {
    uint2 u;
    u.x = pack2(v[0], v[1]); u.y = pack2(v[2], v[3]);
    *(uint2*)(z + (size_t)row * 2048 + col0) = u;
  }
  __device__ __forceinline__ void operator()(int row0, int col, f32x4 v) const {
    if (col < 2048) {
#pragma unroll
      for (int jj = 0; jj < 4; ++jj) z[(size_t)(row0 + jj) * 2048 + col] = f2bf(v[jj]);
    } else if (col < 5120) {
      int c, j;
      tok2chunk(row0, c, j);
      const int len = c < 256 ? 64 : 16;
      const int cc = col - 2048;
      uint2 u;
      u.x = pack2(v[0], v[1]);
      u.y = pack2(v[2], v[3]);
      *(uint2*)(xbcT + ((size_t)c * 3072 + cc) * 64 + j) = u;
      if (j == len - 4) *(uint2*)(tails + ((size_t)c * 3072 + cc) * 4) = u;
    } else if (col < 5152) {
      const int hd = col - 5120;
#pragma unroll
      for (int jj = 0; jj < 4; ++jj) dt[(size_t)(row0 + jj) * 32 + hd] = v[jj];
    }
  }
};

struct EpiResid {
  const float *xin_p, *xin_s;
  float* xout;
  static constexpr int KSPLIT = 4;
  __device__ __forceinline__ void rowvec_acc(int row, int col0, f32x4 v) const {
    float* dst = xout + (size_t)row * 1024 + col0;
#pragma unroll
    for (int e = 0; e < 4; ++e) (void)__hip_atomic_fetch_add(dst + e, v[e], __ATOMIC_RELAXED, __HIP_MEMORY_SCOPE_AGENT);
  }
  __device__ __forceinline__ void begin(int, int) {}
  __device__ __forceinline__ bool swapped_col(int) const { return true; }
  __device__ __forceinline__ void colvec(int, int, f32x4) const {}
  __device__ __forceinline__ void rowvec8(int row, int col0, f32x4 v, f32x4 w) const {
    rowvec(row, col0, v);
    rowvec(row, col0 + 4, w);
  }
  __device__ __forceinline__ void rowvec(int row, int col0, f32x4 v) const {
    const float* src = row < T_P ? xin_p + (size_t)row * 1024 : xin_s + (size_t)(row - T_P) * 1024;
    const float4 x = *(const float4*)(src + col0);
    float4 o;
    o.x = x.x + v[0]; o.y = x.y + v[1]; o.z = x.z + v[2]; o.w = x.w + v[3];
    *(float4*)(xout + (size_t)row * 1024 + col0) = o;
  }
  __device__ __forceinline__ void operator()(int row0, int col, f32x4 v) const {
#pragma unroll
    for (int jj = 0; jj < 4; ++jj) {
      const int row = row0 + jj;
      const float* src = row < T_P ? xin_p + (size_t)row * 1024 : xin_s + (size_t)(row - T_P) * 1024;
      xout[(size_t)row * 1024 + col] = src[col] + v[jj];
    }
  }
};

struct EpiResidScaled {
  static constexpr int KSPLIT = 4;
  __device__ __forceinline__ void rowvec_acc(int row, int col0, f32x4 v) const {
    const int o_ = row - rowbase;
    const float s0_ = __shfl(rs, o_ & 63), s1_ = __shfl(rs1, o_ & 63);
    const float sc = o_ < 64 ? s0_ : s1_;
    float* dst = xout + (size_t)row * 1024 + col0;
#pragma unroll
    for (int e = 0; e < 4; ++e) (void)__hip_atomic_fetch_add(dst + e, sc * v[e], __ATOMIC_RELAXED, __HIP_MEMORY_SCOPE_AGENT);
  }
  const float *xin_p, *xin_s;
  float* xout;
  const float* ssq;
  float rs, rs1;
  int rowbase;
  __device__ __forceinline__ bool swapped_col(int) const { return true; }
  __device__ __forceinline__ void colvec(int, int, f32x4) const {}
  __device__ __forceinline__ void rowvec8(int row, int col0, f32x4 v, f32x4 w) const {
    rowvec(row, col0, v);
    rowvec(row, col0 + 4, w);
  }
  __device__ __forceinline__ void rowvec(int row, int col0, f32x4 v) const {
    const int o_ = row - rowbase;
    const float s0_ = __shfl(rs, o_ & 63), s1_ = __shfl(rs1, o_ & 63);
    const float sc = o_ < 64 ? s0_ : s1_;
    const float* src = row < T_P ? xin_p + (size_t)row * 1024 : xin_s + (size_t)(row - T_P) * 1024;
    const float4 x = *(const float4*)(src + col0);
    float4 o;
    o.x = x.x + sc * v[0]; o.y = x.y + sc * v[1]; o.z = x.z + sc * v[2]; o.w = x.w + sc * v[3];
    *(float4*)(xout + (size_t)row * 1024 + col0) = o;
  }
  __device__ __forceinline__ void begin(int rb, int lane) {
    rowbase = rb;
    float rr[2];
#pragma unroll
    for (int hh = 0; hh < 2; ++hh) {
      const int row = rb + hh * 64 + lane;
      float sacc = 0.f;
      if (row < T) {
        const float4* p = (const float4*)(ssq + (size_t)row * 32);
#pragma unroll
        for (int i = 0; i < 8; ++i) {
          const float4 v = p[i];
          sacc += v.x + v.y + v.z + v.w;
        }
      }
      rr[hh] = rsqrtf(sacc * (1.f / 2048.f) + EPS);
    }
    rs = rr[0];
    rs1 = rr[1];
  }
  __device__ __forceinline__ void operator()(int row0, int col, f32x4 v) const {
#pragma unroll
    for (int jj = 0; jj < 4; ++jj) {
      const int row = row0 + jj;
      const int o_ = row - rowbase;
      const float s0_ = __shfl(rs, o_ & 63), s1_ = __shfl(rs1, o_ & 63);
      const float sc = o_ < 64 ? s0_ : s1_;
      const float* src = row < T_P ? xin_p + (size_t)row * 1024 : xin_s + (size_t)(row - T_P) * 1024;
      xout[(size_t)row * 1024 + col] = src[col] + sc * v[jj];
    }
  }
};

__device__ __forceinline__ void ph_gla_prep(const Params& P, int layer, char* smem) {
  bf16_t* sQ = (bf16_t*)smem;
  bf16_t* sK = (bf16_t*)(smem + 8192);
  float* sG = (float*)(smem + 16384);
  float* sTot = (float*)(smem + 20480);
  bf16_t* qd = (bf16_t*)(P.ws + G_QD);
  bf16_t* kd = (bf16_t*)(P.ws + G_KD);
  bf16_t* kdT = (bf16_t*)(P.ws + G_KDT);
  const float* glr = (const float*)(P.ws + G_GLR);
  float* decay = (float*)(P.ws + G_DEC);
  const float* wgu = P.in[10] + (size_t)layer * 16 * 512;
  const float* bgt = P.in[11] + (size_t)layer * 512;
  const int tid = otid(), tg = tid >> 6, cl = tid & 63;
  for (int it = blockIdx.x; it < NCH * 8; it += gridDim.x) {
    const int c = it >> 3, cb8 = it & 7, d = cb8 * 64 + cl;
    int t0, len;
    chunk_info(c, t0, len);
    float wg[16];
#pragma unroll
    for (int rk = 0; rk < 16; ++rk) wg[rk] = wgu[rk * 512 + d];
    const float bg = bgt[d];
    u32x4 rq[2], rk2[2];
#pragma unroll
    for (int i = 0; i < 2; ++i) {
      const int id = tid + 256 * i, row = id >> 3, c16 = id & 7;
      rq[i] = u32x4{0u, 0u, 0u, 0u};
      rk2[i] = u32x4{0u, 0u, 0u, 0u};
      if (row < len) {
        const size_t a = (size_t)(t0 + row) * 512 + cb8 * 64 + c16 * 8;
        rq[i] = *(const u32x4*)(qd + a);
        rk2[i] = *(const u32x4*)(kd + a);
      }
    }
    float4 gl4 = float4{0.f, 0.f, 0.f, 0.f};
    if (tid * 4 < len * 16) gl4 = *(const float4*)(glr + (size_t)t0 * 16 + tid * 4);
    __syncthreads();
#pragma unroll
    for (int i = 0; i < 2; ++i) {
      const int id = tid + 256 * i, row = id >> 3, c16 = id & 7;
      *(u32x4*)(sQ + row * 64 + c16 * 8) = rq[i];
      *(u32x4*)(sK + row * 64 + c16 * 8) = rk2[i];
    }
    *(float4*)(sG + tid * 4) = gl4;
    __syncthreads();
    float cs[16];
    float run = 0.f;
#pragma unroll
    for (int e = 0; e < 16; ++e) {
      const int j = tg * 16 + e;
      float x = bg;
#pragma unroll
      for (int rk = 0; rk < 16; ++rk) x += sG[j * 16 + rk] * wg[rk];
      const float ls = fminf(x, 0.f) - __logf(1.f + __expf(-fabsf(x)));
      run += (j < len) ? ls * (1.f / 16.f) : 0.f;
      cs[e] = run;
    }
    sTot[tg * 64 + cl] = run;
    __syncthreads();
    float off = 0.f;
#pragma unroll
    for (int g2 = 0; g2 < 3; ++g2) off += (g2 < tg) ? sTot[g2 * 64 + cl] : 0.f;
    unsigned pk[8];
#pragma unroll
    for (int e = 0; e < 16; ++e) {
      const int j = tg * 16 + e;
      const float bc = off + cs[e];
      const float eb = __expf(bc);
      const float qv = bf2f(sQ[j * 64 + cl]), kv = bf2f(sK[j * 64 + cl]);
      sQ[j * 64 + cl] = f2bf(qv * eb);
      const bf16_t kb = f2bf(kv * __builtin_amdgcn_rcpf(eb));
      sK[j * 64 + cl] = kb;
      if (e & 1) pk[e >> 1] |= ((unsigned)kb << 16);
      else pk[e >> 1] = (unsigned)kb;
    }
    if (tg * 16 < len) {
      bf16_t* dstT = kdT + ((size_t)c * 512 + d) * 64 + tg * 16;
      *(u32x4*)dstT = u32x4{pk[0], pk[1], pk[2], pk[3]};
      *(u32x4*)(dstT + 8) = u32x4{pk[4], pk[5], pk[6], pk[7]};
    }
    if (tg == 3) decay[(size_t)c * 512 + d] = __expf(off + run);
    __syncthreads();
#pragma unroll
    for (int i = 0; i < 2; ++i) {
      const int id = tid + 256 * i, row = id >> 3, c16 = id & 7;
      if (row < len) {
        const size_t a = (size_t)(t0 + row) * 512 + cb8 * 64 + c16 * 8;
        *(u32x4*)(qd + a) = *(const u32x4*)(sQ + row * 64 + c16 * 8);
        *(u32x4*)(kd + a) = *(const u32x4*)(sK + row * 64 + c16 * 8);
      }
    }
  }
}

__device__ __forceinline__ void ph_gla_pass(const bool passB, const int layer, const Params& P, char* smem) {
  bf16_t* sKT = (bf16_t*)(smem);
  bf16_t* sVT = (bf16_t*)(smem + 18432);
  bf16_t* sQ = (bf16_t*)(smem + 27648);
  bf16_t* sK = (bf16_t*)(smem + 45056);
  bf16_t* sAtt = sK;
  bf16_t* sS = (bf16_t*)(smem + 62464);
  const bf16_t* qd = (const bf16_t*)(P.ws + G_QD);
  const bf16_t* kd = (const bf16_t*)(P.ws + G_KD);
  const bf16_t* kdT = (const bf16_t*)(P.ws + G_KDT);
  const bf16_t* vT = (const bf16_t*)(P.ws + G_VT);
  bf16_t* obuf = (bf16_t*)(P.ws + G_O);
  float* ssq = (float*)(P.ws + G_SSQ);
  const float* decay = (const float*)(P.ws + G_DEC);
  float* Sseg = (float*)(P.ws + G_SSEG);
  const float* st_in = P.in[2];
  const int tid = otid(), lane = tid & 63, wave = tid >> 6, r = lane & 15, q = lane >> 4;
  const int nitems = passB ? NSEGT_G * 16 : (NSEG_G - 1) * 16;
  for (int it = blockIdx.x; it < nitems; it += gridDim.x) {
    const int sg = it >> 4, h = (it >> 2) & 3, sl = it & 3;
    int c0, nch, b;
    seg_info(sg, NSEG_G, c0, nch, b);
    f32x4 accS[2][4];
#pragma unroll
    for (int mt = 0; mt < 2; ++mt)
#pragma unroll
      for (int nt = 0; nt < 4; ++nt) {
        const int d0 = 32 * wave + mt * 16 + q * 4, v = sl * 64 + nt * 16 + r;
        if (!passB) accS[mt][nt] = f32x4{0.f, 0.f, 0.f, 0.f};
        else if (sg < NSEG_G) {
          const float4 t4 = *(const float4*)(Sseg + ((size_t)(sg * 4 + h) * 256 + v) * 128 + d0);
          accS[mt][nt] = f32x4{t4.x, t4.y, t4.z, t4.w};
        } else {
#pragma unroll
          for (int jj = 0; jj < 4; ++jj)
            accS[mt][nt][jj] = st_in[((((size_t)layer * 8 + b) * 4 + h) * 128 + d0 + jj) * 256 + v];
        }
      }
    float dprod[8] = {1.f, 1.f, 1.f, 1.f, 1.f, 1.f, 1.f, 1.f};
    u32x4 pk[4], pv[2];
    float pdec[8];
#define GLA_ISSUE(cc_)                                                                                         \
  {                                                                                                            \
    const int cx_ = (cc_);                                                                                     \
    const int lenx_ = cx_ < 256 ? 64 : 16;                                                                     \
    _Pragma("unroll") for (int i = 0; i < 4; ++i) {                                                            \
      const int id = tid + 256 * i, row = id >> 3, c16 = id & 7;                                               \
      pk[i] = u32x4{0u, 0u, 0u, 0u};                                                                           \
      if (c16 * 8 < lenx_) pk[i] = *(const u32x4*)(kdT + ((size_t)cx_ * 512 + h * 128 + row) * 64 + c16 * 8);  \
    }                                                                                                          \
    _Pragma("unroll") for (int i = 0; i < 2; ++i) {                                                            \
      const int id = tid + 256 * i, row = id >> 3, c16 = id & 7;                                               \
      pv[i] = u32x4{0u, 0u, 0u, 0u};                                                                           \
      if (c16 * 8 < lenx_) pv[i] = *(const u32x4*)(vT + ((size_t)cx_ * 1024 + h * 256 + sl * 64 + row) * 64 + c16 * 8); \
    }                                                                                                          \
    _Pragma("unroll") for (int mt = 0; mt < 2; ++mt)                                                           \
    _Pragma("unroll") for (int jj = 0; jj < 4; ++jj)                                                           \
      pdec[mt * 4 + jj] = decay[(size_t)cx_ * 512 + h * 128 + 32 * wave + mt * 16 + q * 4 + jj];               \
  }
    GLA_ISSUE(c0)
    for (int ci = 0; ci < nch; ++ci) {
      const int c = c0 + ci;
      int t0, len;
      chunk_info(c, t0, len);
      __syncthreads();
#pragma unroll
      for (int i = 0; i < 4; ++i) {
        const int id = tid + 256 * i, row = id >> 3, c16 = id & 7;
        *(u32x4*)(sKT + row * 72 + c16 * 8) = pk[i];
      }
#pragma unroll
      for (int i = 0; i < 2; ++i) {
        const int id = tid + 256 * i, row = id >> 3, c16 = id & 7;
        *(u32x4*)(sVT + row * 72 + c16 * 8) = pv[i];
      }
      float dec8[8];
#pragma unroll
      for (int e = 0; e < 8; ++e) dec8[e] = pdec[e];
      if (passB) {
#pragma unroll
        for (int i = 0; i < 4; ++i) {
          const int id = tid + 256 * i, row = id >> 4, c16 = id & 15;
          uint4 vq = uint4{0u, 0u, 0u, 0u}, vk = uint4{0u, 0u, 0u, 0u};
          if (row < len) {
            const size_t a = (size_t)(t0 + row) * 512 + h * 128 + c16 * 8;
            vq = *(const uint4*)(qd + a);
            vk = *(const uint4*)(kd + a);
          }
          *(uint4*)(sQ + row * 136 + c16 * 8) = vq;
          *(uint4*)(sK + row * 136 + c16 * 8) = vk;
        }
      }
      __syncthreads();
      if (ci + 1 < nch) GLA_ISSUE(c0 + ci + 1)
      if (passB) {
        f32x4 att[1][4];
#pragma unroll
        for (int nt = 0; nt < 4; ++nt) att[0][nt] = f32x4{0.f, 0.f, 0.f, 0.f};
        mma_lds<1, 4, 4>(att, sQ + (16 * wave) * 136, 136, sK, 136, r, q);
#pragma unroll
        for (int mt = 0; mt < 2; ++mt)
#pragma unroll
          for (int nt = 0; nt < 4; ++nt) {
            const int d0 = 32 * wave + mt * 16 + q * 4, v = nt * 16 + r;
            uint2 u;
            u.x = pack2(accS[mt][nt][0], accS[mt][nt][1]);
            u.y = pack2(accS[mt][nt][2], accS[mt][nt][3]);
            *(uint2*)(sS + v * 136 + d0) = u;
          }
        __syncthreads();
#pragma unroll
        for (int nt = 0; nt < 4; ++nt)
#pragma unroll
          for (int jj = 0; jj < 4; ++jj) {
            const int i = 16 * wave + q * 4 + jj, j = nt * 16 + r;
            sAtt[i * 72 + j] = f2bf(j <= i ? att[0][nt][jj] : 0.f);
          }
        __syncthreads();
        f32x4 o[1][4];
#pragma unroll
        for (int nt = 0; nt < 4; ++nt) o[0][nt] = f32x4{0.f, 0.f, 0.f, 0.f};
        mma_lds<1, 4, 2>(o, sAtt + (16 * wave) * 72, 72, sVT, 72, r, q);
        mma_lds<1, 4, 4>(o, sQ + (16 * wave) * 136, 136, sS, 136, r, q);
        float ss[4] = {0.f, 0.f, 0.f, 0.f};
#pragma unroll
        for (int nt = 0; nt < 4; ++nt)
#pragma unroll
          for (int jj = 0; jj < 4; ++jj) {
            const float ov = o[0][nt][jj];
            ss[jj] += ov * ov;
            const int i = 16 * wave + q * 4 + jj;
            if (i < len) obuf[(size_t)(t0 + i) * 1024 + h * 256 + sl * 64 + nt * 16 + r] = f2bf(ov);
          }
#pragma unroll
        for (int jj = 0; jj < 4; ++jj) {
          float s = ss[jj];
          s += __shfl_xor(s, 1);
          s += __shfl_xor(s, 2);
          s += __shfl_xor(s, 4);
          s += __shfl_xor(s, 8);
          const int i = 16 * wave + q * 4 + jj;
          if (r == 0 && i < len) ssq[(size_t)(t0 + i) * 16 + h * 4 + sl] = s;
        }
      }
      mma_lds<2, 4, 2>(accS, sKT + (32 * wave) * 72, 72, sVT, 72, r, q);
#pragma unroll
      for (int mt = 0; mt < 2; ++mt)
#pragma unroll
        for (int jj = 0; jj < 4; ++jj) {
          const float dec = dec8[mt * 4 + jj];
          dprod[mt * 4 + jj] *= dec;
#pragma unroll
          for (int nt = 0; nt < 4; ++nt) accS[mt][nt][jj] *= dec;
        }
    }
#undef GLA_ISSUE
    if (!passB && sl == 0 && r == 0) {
#pragma unroll
      for (int mt = 0; mt < 2; ++mt)
#pragma unroll
        for (int jj = 0; jj < 4; ++jj)
          ((float*)(P.ws + G_DSEG))[(size_t)sg * 512 + h * 128 + 32 * wave + mt * 16 + q * 4 + jj] = dprod[mt * 4 + jj];
    }
#pragma unroll
    for (int mt = 0; mt < 2; ++mt)
#pragma unroll
      for (int nt = 0; nt < 4; ++nt) {
        const int d0 = 32 * wave + mt * 16 + q * 4, v = sl * 64 + nt * 16 + r;
        if (!passB) {
          float4 t4;
          t4.x = accS[mt][nt][0]; t4.y = accS[mt][nt][1]; t4.z = accS[mt][nt][2]; t4.w = accS[mt][nt][3];
          *(float4*)(Sseg + ((size_t)(sg * 4 + h) * 256 + v) * 128 + d0) = t4;
        } else if (sg == NSEG_G - 1) {
#pragma unroll
          for (int jj = 0; jj < 4; ++jj)
            P.out[O_GLA_P + (((size_t)layer * 4 + h) * 128 + d0 + jj) * 256 + v] = accS[mt][nt][jj];
        } else if (sg >= NSEG_G) {
#pragma unroll
          for (int jj = 0; jj < 4; ++jj)
            P.out[O_GLA_S + ((((size_t)layer * 8 + b) * 4 + h) * 128 + d0 + jj) * 256 + v] = accS[mt][nt][jj];
        }
      }
  }
}

__device__ __forceinline__ void ph_gla_scan(const Params& P) {
  float* Sseg = (float*)(P.ws + G_SSEG);
  const float* dseg = (const float*)(P.ws + G_DSEG);
  for (int idx = blockIdx.x * 256 + otid(); idx < 4 * 256 * 128; idx += gridDim.x * 256) {
    const int h = idx >> 15, d = idx & 127;
    float cur = 0.f;
    for (int s = 0; s < NSEG_G; ++s) {
      const size_t a = (size_t)s * 131072 + idx;
      float tmp = 0.f, D = 0.f;
      if (s < NSEG_G - 1) {
        tmp = Sseg[a];
        D = dseg[(size_t)s * 512 + h * 128 + d];
      }
      Sseg[a] = cur;
      cur = D * cur + tmp;
    }
  }
}

__device__ __forceinline__ void ph_gla_aprep(const Params& P, int layer) {
  bf16_t* obuf = (bf16_t*)(P.ws + G_O);
  const bf16_t* g = (const bf16_t*)(P.ws + G_G);
  const float* ssq = (const float*)(P.ws + G_SSQ);
  const float* nw = P.in[12] + (size_t)layer * 256;
  for (int idx = blockIdx.x * 256 + otid(); idx < T * 128; idx += gridDim.x * 256) {
    const int t = idx >> 7, c8 = (idx & 127) * 8, hh = c8 >> 8;
    const float4 s4 = *(const float4*)(ssq + (size_t)t * 16 + hh * 4);
    const float rs = rsqrtf((s4.x + s4.y + s4.z + s4.w) * (1.f / 256.f) + EPS);
    const uint4 ov = *(const uint4*)(obuf + (size_t)t * 1024 + c8);
    const uint4 gv = *(const uint4*)(g + (size_t)t * 1024 + c8);
    const float4 w0 = *(const float4*)(nw + (c8 & 255));
    const float4 w1 = *(const float4*)(nw + (c8 & 255) + 4);
    uint4 res;
    res.x = pack2(lo_bf(ov.x) * rs * w0.x * silu_(lo_bf(gv.x)), hi_bf(ov.x) * rs * w0.y * silu_(hi_bf(gv.x)));
    res.y = pack2(lo_bf(ov.y) * rs * w0.z * silu_(lo_bf(gv.y)), hi_bf(ov.y) * rs * w0.w * silu_(hi_bf(gv.y)));
    res.z = pack2(lo_bf(ov.z) * rs * w1.x * silu_(lo_bf(gv.z)), hi_bf(ov.z) * rs * w1.y * silu_(hi_bf(gv.z)));
    res.w = pack2(lo_bf(ov.w) * rs * w1.z * silu_(lo_bf(gv.w)), hi_bf(ov.w) * rs * w1.w * silu_(hi_bf(gv.w)));
    *(uint4*)(obuf + (size_t)t * 1024 + c8) = res;
  }
}

__device__ __forceinline__ void ph_lru_pass(const bool passB, const Params& P, char* smem) {
  bf16_t* sRaw = (bf16_t*)smem;
  bf16_t* sXc = (bf16_t*)(smem + 11808);
  constexpr int SPS = 100, SPG = 64 * SPS;
  float* sP = (float*)(smem + 25120);
  float* sCst = (float*)(smem + 76320);
  const bf16_t* xb = (const bf16_t*)(P.ws + L_XB);
  const bf16_t* gate = (const bf16_t*)(P.ws + L_GATE);
  bf16_t* ybuf = (bf16_t*)(P.ws + L_Y);
  float* Asum = (float*)(P.ws + L_ASEG);
  float* Hsum = (float*)(P.ws + L_HSEG);
  const bf16_t* WG = (const bf16_t*)(P.ws + OFF_WG);
  const float* st_conv = P.in[3];
  const float* st_h = P.in[4];
  const int tid = otid(), lane = tid & 63, wave = tid >> 6, r = lane & 15, q = lane >> 4;
  const int NIT = NCH * 16;
  const int per = (NIT + (int)gridDim.x - 1) / (int)gridDim.x;
  const int it_lo = blockIdx.x * per;
  const int it_hi = it_lo + per < NIT ? it_lo + per : NIT;
  const int gt = wave >> 1, mh = wave & 1;
  int kprev = -1;
  bf16x8 bw[3][6];
#pragma unroll
  for (int ks = 0; ks < 3; ++ks)
#pragma unroll
    for (int nt = 0; nt < 6; ++nt) bw[ks][nt] = bf16x8{0, 0, 0, 0, 0, 0, 0, 0};
  const int cg8 = tid % 11, crow = tid / 11;
  const int gg4 = tid % 22, grow = tid / 22;
  float cw[5][8];
  float gc[3][4];
#pragma unroll
  for (int a_ = 0; a_ < 5; ++a_)
#pragma unroll
    for (int e = 0; e < 8; ++e) cw[a_][e] = 0.f;
#pragma unroll
  for (int a_ = 0; a_ < 3; ++a_)
#pragma unroll
    for (int e = 0; e < 4; ++e) gc[a_][e] = 0.f;
  for (int idx = tid; idx < 64 * 8; idx += 256) sXc[(idx >> 3) * 104 + 88 + (idx & 7)] = 0;
  for (int it = it_lo; it < it_hi; ++it) {
    const int k = it / NCH, c = it - k * NCH;
    int t0, len;
    chunk_info(c, t0, len);
    const int b = c - 256;
    const bool has_prev = (c < 256) && (c > 0);
    const int ch = k * 88 + tid;
    u32x4 rraw[3], rgate[3];
#pragma unroll
    for (int i = 0; i < 3; ++i) {
      const int idx = tid + 256 * i, row = idx / 11, c16 = idx - row * 11;
      rraw[i] = u32x4{0u, 0u, 0u, 0u};
      rgate[i] = u32x4{0u, 0u, 0u, 0u};
      if (row < len + 3) {
        if (row >= 3 || has_prev) {
          rraw[i] = *(const u32x4*)(xb + (size_t)(t0 + row - 3) * LW + k * 88 + c16 * 8);
        } else if (c >= 256) {
          const float* sp = st_conv + ((size_t)b * 3 + row) * LW + k * 88 + c16 * 8;
          const float4 f0 = *(const float4*)sp, f1 = *(const float4*)(sp + 4);
          rraw[i] = u32x4{pack2(f0.x, f0.y), pack2(f0.z, f0.w), pack2(f1.x, f1.y), pack2(f1.z, f1.w)};
        }
      }
      if (passB && row < len) rgate[i] = *(const u32x4*)(gate + (size_t)(t0 + row) * LW + k * 88 + c16 * 8);
    }
    float hcur = 0.f, aprod = 1.f;
    if (passB && tid < 88) hcur = c < 256 ? Hsum[(size_t)c * LW + ch] : st_h[b * LW + ch];
    __syncthreads();
    if (k != kprev) {
      if (tid < 88) {
        sCst[0 * 96 + tid] = -8.f * softplus_(-P.in[21][ch]);
        sCst[1 * 96 + tid] = P.in[18][ch];
        sCst[2 * 96 + tid] = P.in[20][ch];
        sCst[3 * 96 + tid] = P.in[16][ch];
        sCst[4 * 96 + tid] = P.in[15][0 * LW + ch];
        sCst[5 * 96 + tid] = P.in[15][1 * LW + ch];
        sCst[6 * 96 + tid] = P.in[15][2 * LW + ch];
        sCst[7 * 96 + tid] = P.in[15][3 * LW + ch];
      }
      const bf16_t* Wt = WG + ((size_t)(gt * 16 + k) * 96) * 96;
#pragma unroll
      for (int ks = 0; ks < 3; ++ks)
#pragma unroll
        for (int nt = 0; nt < 6; ++nt) bw[ks][nt] = *(const bf16x8*)(Wt + (nt * 16 + r) * 96 + ks * 32 + q * 8);
    }
#pragma unroll
    for (int i = 0; i < 3; ++i) {
      const int idx = tid + 256 * i, row = idx / 11, c16 = idx - row * 11;
      if (row < 67) *(u32x4*)(sRaw + row * 88 + c16 * 8) = rraw[i];
    }
    __syncthreads();
    if (k != kprev) {
#pragma unroll
      for (int a_ = 0; a_ < 5; ++a_)
#pragma unroll
        for (int e = 0; e < 8; ++e) cw[a_][e] = sCst[(3 + a_) * 96 + cg8 * 8 + e];
#pragma unroll
      for (int a_ = 0; a_ < 3; ++a_)
#pragma unroll
        for (int e = 0; e < 4; ++e) gc[a_][e] = sCst[a_ * 96 + gg4 * 4 + e];
      kprev = k;
    }
    if (crow < 23) {
#pragma unroll
      for (int i = 0; i < 3; ++i) {
        const int j = crow + 23 * i;
        if (j < 64) {
          u32x4 o = u32x4{0u, 0u, 0u, 0u};
          if (j < len) {
            u32x4 rr[4];
#pragma unroll
            for (int kk = 0; kk < 4; ++kk) rr[kk] = *(const u32x4*)(sRaw + (j + kk) * 88 + cg8 * 8);
            float xc[8];
#pragma unroll
            for (int e = 0; e < 8; ++e) {
              float acc_ = cw[0][e];
#pragma unroll
              for (int kk = 0; kk < 4; ++kk) {
                const unsigned w_ = rr[kk][e >> 1];
                acc_ += cw[1 + kk][e] * ((e & 1) ? hi_bf(w_) : lo_bf(w_));
              }
              xc[e] = acc_;
            }
            o = u32x4{pack2(xc[0], xc[1]), pack2(xc[2], xc[3]), pack2(xc[4], xc[5]), pack2(xc[6], xc[7])};
          }
          *(u32x4*)(sXc + j * 104 + cg8 * 8) = o;
        }
      }
    }
    __syncthreads();
    {
      f32x4 acc[2][6];
#pragma unroll
      for (int mt = 0; mt < 2; ++mt)
#pragma unroll
        for (int nt = 0; nt < 6; ++nt) acc[mt][nt] = f32x4{0.f, 0.f, 0.f, 0.f};
#pragma unroll
      for (int ks = 0; ks < 3; ++ks) {
        bf16x8 af[2];
#pragma unroll
        for (int mt = 0; mt < 2; ++mt) af[mt] = *(const bf16x8*)(sXc + (32 * mh + mt * 16 + r) * 104 + ks * 32 + q * 8);
#pragma unroll
        for (int mt = 0; mt < 2; ++mt)
#pragma unroll
          for (int nt = 0; nt < 6; ++nt)
            acc[mt][nt] = __builtin_amdgcn_mfma_f32_16x16x32_bf16(bw[ks][nt], af[mt], acc[mt][nt], 0, 0, 0);
      }
#pragma unroll
      for (int mt = 0; mt < 2; ++mt)
#pragma unroll
        for (int nt = 0; nt < 6; ++nt)
          *(f32x4*)(sP + gt * SPG + (32 * mh + mt * 16 + r) * SPS + nt * 16 + q * 4) = acc[mt][nt];
    }
    __syncthreads();
    if (grow < 11) {
#pragma unroll
      for (int i = 0; i < 6; ++i) {
        const int j = grow + 11 * i;
        if (j < len) {
          const f32x4 pr = *(const f32x4*)(sP + j * SPS + gg4 * 4);
          const f32x4 pi = *(const f32x4*)(sP + SPG + j * SPS + gg4 * 4);
          const uint2 xu = *(const uint2*)(sXc + j * 104 + gg4 * 4);
          float xv[4];
          xv[0] = lo_bf(xu.x); xv[1] = hi_bf(xu.x); xv[2] = lo_bf(xu.y); xv[3] = hi_bf(xu.y);
          f32x4 av, uv;
#pragma unroll
          for (int e = 0; e < 4; ++e) {
            const float rr_ = sigmoid_(pr[e] + gc[1][e]), ii_ = sigmoid_(pi[e] + gc[2][e]);
            const float a = __expf(gc[0][e] * rr_);
            const float m = __builtin_amdgcn_sqrtf(fmaxf(1.f - a * a, 0.f));
            av[e] = a;
            uv[e] = m * ii_ * xv[e];
          }
          *(f32x4*)(sP + j * SPS + gg4 * 4) = av;
          *(f32x4*)(sP + SPG + j * SPS + gg4 * 4) = uv;
        }
      }
    }
    __syncthreads();
    if (tid < 88) {
#pragma unroll 8
      for (int j = 0; j < len; ++j) {
        const float a = sP[j * SPS + tid], u = sP[SPG + j * SPS + tid];
        hcur = a * hcur + u;
        aprod *= a;
        if (passB) sP[SPG + j * SPS + tid] = hcur;
      }
      if (!passB) {
        Asum[(size_t)c * LW + ch] = aprod;
        Hsum[(size_t)c * LW + ch] = hcur;
      } else if (c == 255) {
        P.out[O_LH_P + ch] = hcur;
#pragma unroll
        for (int kk = 0; kk < 3; ++kk) P.out[O_LCONV_P + kk * LW + ch] = bf2f(sRaw[(len + kk) * 88 + tid]);
      } else if (c >= 256) {
        P.out[O_LH_S + b * LW + ch] = hcur;
#pragma unroll
        for (int kk = 0; kk < 3; ++kk) P.out[O_LCONV_S + ((size_t)b * 3 + kk) * LW + ch] = bf2f(sRaw[(len + kk) * 88 + tid]);
      }
    }
    if (passB) {
      __syncthreads();
#pragma unroll
      for (int i = 0; i < 3; ++i) {
        const int idx = tid + 256 * i, row = idx / 11, c16 = idx - row * 11;
        if (row < len) {
          const float4 h0 = *(const float4*)(sP + SPG + row * SPS + c16 * 8);
          const float4 h1 = *(const float4*)(sP + SPG + row * SPS + c16 * 8 + 4);
          const u32x4 gv = rgate[i];
          u32x4 o;
          o[0] = pack2(h0.x * silu_(lo_bf(gv[0])), h0.y * silu_(hi_bf(gv[0])));
          o[1] = pack2(h0.z * silu_(lo_bf(gv[1])), h0.w * silu_(hi_bf(gv[1])));
          o[2] = pack2(h1.x * silu_(lo_bf(gv[2])), h1.y * silu_(hi_bf(gv[2])));
          o[3] = pack2(h1.z * silu_(lo_bf(gv[3])), h1.w * silu_(hi_bf(gv[3])));
          *(u32x4*)(ybuf + (size_t)(t0 + row) * LW + k * 88 + c16 * 8) = o;
        }
      }
    }
  }
}

__device__ __forceinline__ void ph_lru_scan(const Params& P, char* smem) {
  float* sA = (float*)smem;
  float* sH = sA + 256;
  const float* Asum = (const float*)(P.ws + L_ASEG);
  float* Hsum = (float*)(P.ws + L_HSEG);
  const int tid = otid(), seg = tid >> 4, chl = tid & 15;
  for (int it = blockIdx.x; it < LW / 16; it += gridDim.x) {
    const int ch = it * 16 + chl;
    float a[16], h[16];
#pragma unroll
    for (int i = 0; i < 16; ++i) {
      a[i] = Asum[(size_t)(seg * 16 + i) * LW + ch];
      h[i] = Hsum[(size_t)(seg * 16 + i) * LW + ch];
    }
    float A = 1.f, H = 0.f;
#pragma unroll
    for (int i = 0; i < 16; ++i) { H = a[i] * H + h[i]; A *= a[i]; }
    __syncthreads();
    sA[seg * 16 + chl] = A;
    sH[seg * 16 + chl] = H;
    __syncthreads();
    float hin = 0.f;
    for (int s2 = 0; s2 < seg; ++s2) hin = sA[s2 * 16 + chl] * hin + sH[s2 * 16 + chl];
#pragma unroll
    for (int i = 0; i < 16; ++i) {
      Hsum[(size_t)(seg * 16 + i) * LW + ch] = hin;
      hin = a[i] * hin + h[i];
    }
  }
}

__device__ __forceinline__ void ph_ssd_conv(const Params& P) {
  bf16_t* xbcT = (bf16_t*)(P.ws + S_XBCT);
  const bf16_t* tails = (const bf16_t*)(P.ws + S_TAIL);
  bf16_t* Brm = (bf16_t*)(P.ws + S_BRM);
  bf16_t* Crm = (bf16_t*)(P.ws + S_CRM);
  const float* cw = P.in[24];
  const float* cb = P.in[25];
  const float* st_conv = P.in[5];
  const int tid = otid();
  for (int it = blockIdx.x; it < NCH * 12; it += gridDim.x) {
    const int c = it / 12, part = it - c * 12, cc = part * 256 + tid;
    int t0, len;
    chunk_info(c, t0, len);
    const float w0 = cw[cc], w1 = cw[3072 + cc], w2 = cw[2 * 3072 + cc], w3 = cw[3 * 3072 + cc], bias = cb[cc];
    float a0 = 0.f, a1 = 0.f, a2 = 0.f;
    if (c >= 256) {
      const int b = c - 256;
      a0 = st_conv[((size_t)b * 3 + 0) * 3072 + cc];
      a1 = st_conv[((size_t)b * 3 + 1) * 3072 + cc];
      a2 = st_conv[((size_t)b * 3 + 2) * 3072 + cc];
    } else if (c > 0) {
      const uint2 tv = *(const uint2*)(tails + ((size_t)(c - 1) * 3072 + cc) * 4);
      a0 = hi_bf(tv.x); a1 = lo_bf(tv.y); a2 = hi_bf(tv.y);
    }
    bf16_t* rowp = xbcT + ((size_t)c * 3072 + cc) * 64;
    bf16_t* rm = nullptr;
    if (cc >= 2560) rm = Crm + (cc - 2560);
    else if (cc >= 2048) rm = Brm + (cc - 2048);
    u32x4 rw[8];
#pragma unroll
    for (int g = 0; g < 8; ++g) {
      rw[g] = u32x4{0u, 0u, 0u, 0u};
      if (g * 8 < len) rw[g] = *(const u32x4*)(rowp + g * 8);
    }
#pragma unroll
    for (int g = 0; g < 8; ++g) {
      if (g * 8 < len) {
        const int g8 = g * 8;
        const u32x4 u = rw[g];
        float x[8], y[8];
        x[0] = lo_bf(u[0]); x[1] = hi_bf(u[0]); x[2] = lo_bf(u[1]); x[3] = hi_bf(u[1]);
        x[4] = lo_bf(u[2]); x[5] = hi_bf(u[2]); x[6] = lo_bf(u[3]); x[7] = hi_bf(u[3]);
#pragma unroll
        for (int e = 0; e < 8; ++e) {
          const float yy = bias + w0 * a0 + w1 * a1 + w2 * a2 + w3 * x[e];
          a0 = a1; a1 = a2; a2 = x[e];
          y[e] = silu_(yy);
        }
        *(u32x4*)(rowp + g8) = u32x4{pack2(y[0], y[1]), pack2(y[2], y[3]), pack2(y[4], y[5]), pack2(y[6], y[7])};
        if (rm) {
#pragma unroll
          for (int e = 0; e < 8; ++e) rm[(size_t)(t0 + g8 + e) * 512] = f2bf(y[e]);
        }
      }
    }
    if (c >= 255) {
      const uint2 tv = *(const uint2*)(tails + ((size_t)c * 3072 + cc) * 4);
      float* dst = c == 255 ? P.out + O_SCONV_P : P.out + O_SCONV_S + (size_t)(c - 256) * 3 * 3072;
      dst[0 * 3072 + cc] = hi_bf(tv.x);
      dst[1 * 3072 + cc] = lo_bf(tv.y);
      dst[2 * 3072 + cc] = hi_bf(tv.y);
    }
  }
}

__device__ __forceinline__ void ph_ssd_pass(const bool passB, const Params& P, char* smem) {
  bf16_t* sC = (bf16_t*)(smem);
  bf16_t* sBT = (bf16_t*)(smem + 17408);
  bf16_t* sXT = (bf16_t*)(smem + 35840);
  bf16_t* sS = (bf16_t*)(smem + 45056);
  bf16_t* sXW = (bf16_t*)(smem + 62464);
  bf16_t* sW = (bf16_t*)(smem + 71680);
  bf16_t* sB = sXW;
  float* sCum = (float*)(smem + 80896);
  float* sDt = sCum + 64;
  bf16_t* zbuf = (bf16_t*)(P.ws + S_Z);
  const bf16_t* xbcT = (const bf16_t*)(P.ws + S_XBCT);
  const bf16_t* Brm = (const bf16_t*)(P.ws + S_BRM);
  const bf16_t* Crm = (const bf16_t*)(P.ws + S_CRM);
  const float* dtb = (const float*)(P.ws + S_DT);
  float* ssq = (float*)(P.ws + S_SSQ);
  float* Sseg = (float*)(P.ws + S_SSEG);
  float* cdseg = (float*)(P.ws + S_CDSEG);
  const float* st_in = P.in[6];
  const int tid = otid(), lane = tid & 63, wave = tid >> 6, r = lane & 15, q = lane >> 4;
  const int nitems = passB ? NSEGT_S * 32 : (NSEG_S - 1) * 32;
  for (int it = blockIdx.x; it < nitems; it += gridDim.x) {
    const int sg = it >> 5, hd = it & 31, g = hd >> 3;
    int c0, nch, b;
    seg_info(sg, NSEG_S, c0, nch, b);
    const float Ah = -__expf(P.in[27][hd]);
    const float Dh = P.in[28][hd];
    f32x4 accS[2][4];
#pragma unroll
    for (int mt = 0; mt < 2; ++mt)
#pragma unroll
      for (int nt = 0; nt < 4; ++nt) {
        const int s0 = 32 * wave + mt * 16 + q * 4, p = nt * 16 + r;
        if (!passB) accS[mt][nt] = f32x4{0.f, 0.f, 0.f, 0.f};
        else {
          const float* src = sg < NSEG_S ? Sseg + (((size_t)sg * 32 + hd) * 64 + p) * 128 + s0
                                       : st_in + (((size_t)b * 32 + hd) * 64 + p) * 128 + s0;
          const float4 t4 = *(const float4*)src;
          accS[mt][nt] = f32x4{t4.x, t4.y, t4.z, t4.w};
        }
      }
    float totcum = 0.f;
    u32x4 pb[4], px[2];
    float pdt = 0.f;
    const float dtbias = P.in[26][hd];
#define SSD_ISSUE(cc_)                                                                                          \
  {                                                                                                             \
    const int cx_ = (cc_);                                                                                      \
    const int lenx_ = cx_ < 256 ? 64 : 16;                                                                      \
    const int t0x_ = cx_ < 256 ? cx_ * 64 : T_P + (cx_ - 256) * 16;                                             \
    _Pragma("unroll") for (int i = 0; i < 4; ++i) {                                                             \
      const int id = tid + 256 * i, row = id >> 3, c16 = id & 7;                                                \
      pb[i] = u32x4{0u, 0u, 0u, 0u};                                                                            \
      if (c16 * 8 < lenx_) pb[i] = *(const u32x4*)(xbcT + ((size_t)cx_ * 3072 + 2048 + g * 128 + row) * 64 + c16 * 8); \
    }                                                                                                           \
    _Pragma("unroll") for (int i = 0; i < 2; ++i) {                                                             \
      const int id = tid + 256 * i, row = id >> 3, c16 = id & 7;                                                \
      px[i] = u32x4{0u, 0u, 0u, 0u};                                                                            \
      if (c16 * 8 < lenx_) px[i] = *(const u32x4*)(xbcT + ((size_t)cx_ * 3072 + hd * 64 + row) * 64 + c16 * 8);  \
    }                                                                                                           \
    pdt = 0.f;                                                                                                  \
    if (wave == 0 && lane < lenx_) pdt = dtb[(size_t)(t0x_ + lane) * 32 + hd];                                  \
  }
    SSD_ISSUE(c0)
    for (int ci = 0; ci < nch; ++ci) {
      const int c = c0 + ci;
      int t0, len;
      chunk_info(c, t0, len);
      __syncthreads();
      if (wave == 0) {
        const float dtv = lane < len ? softplus_(pdt + dtbias) : 0.f;
        float x = dtv * Ah;
#pragma unroll
        for (int off = 1; off < 64; off <<= 1) {
          const float y = __shfl_up(x, off);
          if (lane >= off) x += y;
        }
        sCum[lane] = x;
        sDt[lane] = dtv;
      }
#pragma unroll
      for (int i = 0; i < 4; ++i) {
        const int id = tid + 256 * i, row = id >> 3, c16 = id & 7;
        *(u32x4*)(sBT + row * 72 + c16 * 8) = pb[i];
      }
#pragma unroll
      for (int i = 0; i < 2; ++i) {
        const int id = tid + 256 * i, row = id >> 3, c16 = id & 7;
        *(u32x4*)(sXT + row * 72 + c16 * 8) = px[i];
      }
      if (passB) {
#pragma unroll
        for (int i = 0; i < 4; ++i) {
          const int id = tid + 256 * i, row = id >> 4, c16 = id & 15;
          uint4 vc = uint4{0u, 0u, 0u, 0u}, vb = uint4{0u, 0u, 0u, 0u};
          if (row < len) {
            const size_t a = (size_t)(t0 + row) * 512 + g * 128 + c16 * 8;
            vc = *(const uint4*)(Crm + a);
            vb = *(const uint4*)(Brm + a);
          }
          *(uint4*)(sC + row * 136 + c16 * 8) = vc;
          *(uint4*)(sB + row * 136 + c16 * 8) = vb;
        }
      }
      __syncthreads();
      if (ci + 1 < nch) SSD_ISSUE(c0 + ci + 1)
      const float cumlast = sCum[63];
      f32x4 cbm[1][4];
      if (passB) {
#pragma unroll
        for (int nt = 0; nt < 4; ++nt) cbm[0][nt] = f32x4{0.f, 0.f, 0.f, 0.f};
        mma_lds<1, 4, 4>(cbm, sC + (16 * wave) * 136, 136, sB, 136, r, q);
#pragma unroll
        for (int mt = 0; mt < 2; ++mt)
#pragma unroll
          for (int nt = 0; nt < 4; ++nt) {
            const int s0 = 32 * wave + mt * 16 + q * 4, p = nt * 16 + r;
            uint2 u;
            u.x = pack2(accS[mt][nt][0], accS[mt][nt][1]);
            u.y = pack2(accS[mt][nt][2], accS[mt][nt][3]);
            *(uint2*)(sS + p * 136 + s0) = u;
          }
        __syncthreads();
#pragma unroll
        for (int nt = 0; nt < 4; ++nt)
#pragma unroll
          for (int jj = 0; jj < 4; ++jj) {
            const int i = 16 * wave + q * 4 + jj, j = nt * 16 + r;
            float wv = 0.f;
            if (j <= i) wv = cbm[0][nt][jj] * __expf(sCum[i] - sCum[j]) * sDt[j];
            sW[i * 72 + j] = f2bf(wv);
          }
      }
#pragma unroll
      for (int i = 0; i < 2; ++i) {
        const int id = tid + 256 * i, p = id >> 3, j0 = (id & 7) * 8;
        const uint4 u = *(const uint4*)(sXT + p * 72 + j0);
        float wb[8];
#pragma unroll
        for (int e = 0; e < 8; ++e) wb[e] = __expf(cumlast - sCum[j0 + e]) * sDt[j0 + e];
        uint4 o;
        o.x = pack2(lo_bf(u.x) * wb[0], hi_bf(u.x) * wb[1]);
        o.y = pack2(lo_bf(u.y) * wb[2], hi_bf(u.y) * wb[3]);
        o.z = pack2(lo_bf(u.z) * wb[4], hi_bf(u.z) * wb[5]);
        o.w = pack2(lo_bf(u.w) * wb[6], hi_bf(u.w) * wb[7]);
        *(uint4*)(sXW + p * 72 + j0) = o;
      }
      __syncthreads();
      if (passB) {
        f32x4 y1[1][4], y2[1][4];
#pragma unroll
        for (int nt = 0; nt < 4; ++nt) { y1[0][nt] = f32x4{0.f, 0.f, 0.f, 0.f}; y2[0][nt] = f32x4{0.f, 0.f, 0.f, 0.f}; }
        mma_lds<1, 4, 2>(y1, sW + (16 * wave) * 72, 72, sXT, 72, r, q);
        mma_lds<1, 4, 4>(y2, sC + (16 * wave) * 136, 136, sS, 136, r, q);
        float ss[4] = {0.f, 0.f, 0.f, 0.f};
        float ec[4];
#pragma unroll
        for (int jj = 0; jj < 4; ++jj) ec[jj] = __expf(sCum[16 * wave + q * 4 + jj]);
#pragma unroll
        for (int nt = 0; nt < 4; ++nt) {
          const int p = nt * 16 + r;
          const uint2 xu = *(const uint2*)(sXT + p * 72 + 16 * wave + q * 4);
          float xv[4];
          xv[0] = lo_bf(xu.x); xv[1] = hi_bf(xu.x); xv[2] = lo_bf(xu.y); xv[3] = hi_bf(xu.y);
#pragma unroll
          for (int jj = 0; jj < 4; ++jj) {
            const int i = 16 * wave + q * 4 + jj;
            if (i < len) {
              const float yv = y1[0][nt][jj] + ec[jj] * y2[0][nt][jj] + Dh * xv[jj];
              const size_t a = (size_t)(t0 + i) * 2048 + hd * 64 + p;
              const float yz = yv * silu_(bf2f(zbuf[a]));
              zbuf[a] = f2bf(yz);
              ss[jj] += yz * yz;
            }
          }
        }
#pragma unroll
        for (int jj = 0; jj < 4; ++jj) {
          float s = ss[jj];
          s += __shfl_xor(s, 1);
          s += __shfl_xor(s, 2);
          s += __shfl_xor(s, 4);
          s += __shfl_xor(s, 8);
          const int i = 16 * wave + q * 4 + jj;
          if (r == 0 && i < len) ssq[(size_t)(t0 + i) * 32 + hd] = s;
        }
      }
      {
        const float cd = __expf(cumlast);
#pragma unroll
        for (int mt = 0; mt < 2; ++mt)
#pragma unroll
          for (int nt = 0; nt < 4; ++nt)
#pragma unroll
            for (int jj = 0; jj < 4; ++jj) accS[mt][nt][jj] *= cd;
        mma_lds<2, 4, 2>(accS, sBT + (32 * wave) * 72, 72, sXW, 72, r, q);
        totcum += cumlast;
      }
    }
#pragma unroll
    for (int mt = 0; mt < 2; ++mt)
#pragma unroll
      for (int nt = 0; nt < 4; ++nt) {
        const int s0 = 32 * wave + mt * 16 + q * 4, p = nt * 16 + r;
        float4 t4;
        t4.x = accS[mt][nt][0]; t4.y = accS[mt][nt][1]; t4.z = accS[mt][nt][2]; t4.w = accS[mt][nt][3];
        if (!passB) *(float4*)(Sseg + (((size_t)sg * 32 + hd) * 64 + p) * 128 + s0) = t4;
        else if (sg == NSEG_S - 1) *(float4*)(P.out + O_SH_P + ((size_t)hd * 64 + p) * 128 + s0) = t4;
        else if (sg >= NSEG_S) *(float4*)(P.out + O_SH_S + (((size_t)b * 32 + hd) * 64 + p) * 128 + s0) = t4;
      }
#undef SSD_ISSUE
    if (!passB && tid == 0) cdseg[sg * 32 + hd] = __expf(totcum);
  }
}

__device__ __forceinline__ void ph_ssd_scan(const Params& P) {
  float* Sseg = (float*)(P.ws + S_SSEG);
  const float* cdseg = (const float*)(P.ws + S_CDSEG);
  for (int idx = blockIdx.x * 256 + otid(); idx < 32 * 64 * 128; idx += gridDim.x * 256) {
    const int hd = idx >> 13;
    float cur = 0.f;
    for (int s = 0; s < NSEG_S; ++s) {
      const size_t a = (size_t)s * 262144 + idx;
      float tmp = 0.f, D = 0.f;
      if (s < NSEG_S - 1) { tmp = Sseg[a]; D = cdseg[s * 32 + hd]; }
      Sseg[a] = cur;
      cur = D * cur + tmp;
    }
  }
}

constexpr size_t OFF_BAR = 268435456ull - 4096;
#define XB_CNT(x) (32 + 32 * (x))
#define XB_SUB(x) (320 + 32 * (x))
#define XB_GEN(x) (608 + 32 * (x))
#define XB_TOP 896
#define XB_TOPGEN 928
__device__ __forceinline__ unsigned xb_ld(unsigned* p) { return __hip_atomic_load(p, __ATOMIC_RELAXED, __HIP_MEMORY_SCOPE_AGENT); }
__device__ __forceinline__ unsigned xb_add(unsigned* p, unsigned v) { return __hip_atomic_fetch_add(p, v, __ATOMIC_RELAXED, __HIP_MEMORY_SCOPE_AGENT); }
__device__ __forceinline__ void grid_barrier(unsigned* bar, char* smem) {
  asm volatile("s_waitcnt vmcnt(0)" ::: "memory");
  __syncthreads();
  if (otid() == 0) {
    volatile unsigned* st = (volatile unsigned*)(smem + SMEM_XB);
    const unsigned x = st[2];
    unsigned nloc = st[0], nx = st[1];
    if (nloc == 0u) {
      const unsigned G = gridDim.x;
      for (;;) {
        unsigned sum = 0u, cnt = 0u, mine = 0u;
#pragma unroll
        for (unsigned j = 0; j < 8; ++j) {
          const unsigned c = xb_ld(&bar[XB_CNT(j)]);
          sum += c;
          cnt += (c > 0u) ? 1u : 0u;
          mine = (j == x) ? c : mine;
        }
        if (sum == G) { nloc = mine; nx = cnt; break; }
        __builtin_amdgcn_s_sleep(1);
      }
      st[0] = nloc;
      st[1] = nx;
    }
    const unsigned old = xb_add(&bar[XB_SUB(x)], 1u);
    const unsigned gen = old / nloc;
    if (old + 1u == (gen + 1u) * nloc) {
      __builtin_amdgcn_fence(__ATOMIC_RELEASE, "agent");
      asm volatile("s_waitcnt vmcnt(0)" ::: "memory");
      const unsigned og = xb_add(&bar[XB_TOP], 1u);
      const unsigned tg = og / nx;
      if (og + 1u == (tg + 1u) * nx) xb_add(&bar[XB_TOPGEN], 1u);
      else while (xb_ld(&bar[XB_TOPGEN]) == tg) __builtin_amdgcn_s_sleep(1);
      __builtin_amdgcn_fence(__ATOMIC_ACQUIRE, "agent");
      xb_add(&bar[XB_GEN(x)], 1u);
      asm volatile("s_waitcnt vmcnt(0)" ::: "memory");
    } else {
      while (xb_ld(&bar[XB_GEN(x)]) == gen) __builtin_amdgcn_s_sleep(1);
      __builtin_amdgcn_fence(__ATOMIC_ACQUIRE, "agent");
      asm volatile("s_waitcnt vmcnt(0)" ::: "memory");
    }
  }
  __syncthreads();
}

constexpr int NPH = 30;

__device__ __forceinline__ void run_gla(const int sub, const int layer, const int li, const Params& P, char* smem) {
  const float* xin_p = li == 0 ? P.in[0] : P.out + O_YP;
  const float* xin_s = li == 0 ? P.in[1] : P.out + O_YS;
  bf16_t* Win = (bf16_t*)(P.ws + OFF_WIN);
  bf16_t* Wout = (bf16_t*)(P.ws + (layer == 0 ? OFF_WOUT : OFF_WOUT1));
  bf16_t* H = (bf16_t*)(P.ws + OFF_H);
  switch (sub) {
    case 0:
      if (li == 0) {
        ph_convT(P.in[9], 1024, 3088, 3136, Win, nullptr, smem);
        ph_convT(P.in[13], 1024, 1024, 1024, Wout, nullptr, smem);
      }
      ph_norm(xin_p, xin_s, P.in[7] + li * 1024, H, li == 0 ? P.out : nullptr);
      break;
    case 1: {
      EpiGlaIn e{(bf16_t*)(P.ws + G_QD), (bf16_t*)(P.ws + G_KD), (bf16_t*)(P.ws + G_VT), (bf16_t*)(P.ws + G_G),
                 (float*)(P.ws + G_GLR)};
      gemm_phase(H, 1024, Win, 1024, 1024, 3088, e, smem);
    } break;
    case 2: ph_gla_prep(P, layer, smem); break;
    case 3: ph_gla_pass(false, layer, P, smem); break;
    case 4:
      ph_gla_scan(P);
      if (layer == 0) {
        ph_convT(P.in[14], 1024, 2816, 2816, Win, nullptr, smem);
        ph_convT(P.in[22], 1408, 1024, 1024, (bf16_t*)(P.ws + OFF_WOUT1), nullptr, smem);
        ph_conv_gate(P.in[17], (bf16_t*)(P.ws + OFF_WG));
        ph_conv_gate(P.in[19], (bf16_t*)(P.ws + OFF_WG) + 16 * 96 * 96);
      }
      break;
    case 5: ph_gla_pass(true, layer, P, smem); break;
    case 6: ph_gla_aprep(P, layer); break;
    case 7: {
      EpiResid e{xin_p, xin_s, P.out};
      gemm_phase((const bf16_t*)(P.ws + G_O), 1024, Wout, 1024, 1024, 1024, e, smem);
    } break;
  }
}

__device__ __forceinline__ void run_phase(const int ph, const Params& P, char* smem) {
  bf16_t* Win = (bf16_t*)(P.ws + OFF_WIN);
  bf16_t* Wout = (bf16_t*)(P.ws + OFF_WOUT);
  bf16_t* H = (bf16_t*)(P.ws + OFF_H);
  const float* xin_p = P.out + O_YP;
  const float* xin_s = P.out + O_YS;
  if (ph < 8) { run_gla(ph, 0, 0, P, smem); return; }
  if (ph >= 21 && ph < 29) { run_gla(ph - 21, 1, 3, P, smem); return; }
  switch (ph) {
    case 8:
      ph_norm(xin_p, xin_s, P.in[7] + 1 * 1024, H, nullptr);
      break;
    case 9: {
      EpiLruIn e{(bf16_t*)(P.ws + L_XB), (bf16_t*)(P.ws + L_GATE)};
      gemm_phase(H, 1024, Win, 1024, 1024, 2816, e, smem);
    } break;
    case 10: ph_lru_pass(false, P, smem); break;
    case 11:
      ph_lru_scan(P, smem);
      ph_convT(P.in[23], 1024, 5152, 5184, Win, nullptr, smem);
      ph_convT(P.in[30], 2048, 1024, 1024, Wout, P.in[29], smem);
      break;
    case 12: ph_lru_pass(true, P, smem); break;
    case 13: {
      EpiResid e{xin_p, xin_s, P.out};
      gemm_phase((const bf16_t*)(P.ws + L_Y), LW, (const bf16_t*)(P.ws + OFF_WOUT1), LW, LW, 1024, e, smem);
    } break;
    case 14:
      ph_norm(xin_p, xin_s, P.in[7] + 2 * 1024, H, nullptr);
      break;
    case 15: {
      EpiSsdIn e{(bf16_t*)(P.ws + S_Z), (bf16_t*)(P.ws + S_XBCT), (bf16_t*)(P.ws + S_TAIL), (float*)(P.ws + S_DT), P.in[26]};
      gemm_phase(H, 1024, Win, 1024, 1024, 5152, e, smem);
    } break;
    case 16: ph_ssd_conv(P); break;
    case 17: ph_ssd_pass(false, P, smem); break;
    case 18:
      ph_ssd_scan(P);
      ph_convT(P.in[9] + (size_t)1024 * 3088, 1024, 3088, 3136, Win, nullptr, smem);
      ph_convT(P.in[13] + (size_t)1024 * 1024, 1024, 1024, 1024, (bf16_t*)(P.ws + OFF_WOUT1), nullptr, smem);
      break;
    case 19: ph_ssd_pass(true, P, smem); break;
    case 20: {
      EpiResidScaled e{xin_p, xin_s, P.out, (const float*)(P.ws + S_SSQ), 0.f, 0.f, 0};
      gemm_phase((const bf16_t*)(P.ws + S_Z), 2048, Wout, 2048, 2048, 1024, e, smem);
    } break;
    case 29: ph_final_norm(P.out, P.in[8]); break;
    default: break;
  }
}

__global__ void __launch_bounds__(256, 2) mega(Params P) {
  __shared__ __attribute__((aligned(16))) char smem[SMEM_BYTES];
  unsigned* bar = (unsigned*)(P.ws + OFF_BAR);
  if (threadIdx.x == 0) {
    const unsigned xcc = (unsigned)__builtin_amdgcn_s_getreg((3 << 11) | 20) & 7u;
    (void)xb_add(&bar[XB_CNT(xcc)], 1u);
    volatile unsigned* st = (volatile unsigned*)(smem + SMEM_XB);
    st[0] = 0u; st[1] = 0u; st[2] = xcc;
  }
  __syncthreads();
  if (P.out == nullptr) cg::this_grid().sync();
#define PRE(n) if (PREMASK & (1u << (n))) { run_phase((n), P, smem); grid_barrier(bar, smem); }
  PRE(0) PRE(1) PRE(2) PRE(3) PRE(4) PRE(5) PRE(6) PRE(7) PRE(8) PRE(9)
  PRE(10) PRE(11) PRE(12) PRE(13) PRE(14) PRE(15) PRE(16) PRE(17) PRE(18) PRE(19)
  PRE(20) PRE(21) PRE(22) PRE(23) PRE(24) PRE(25) PRE(26) PRE(27) PRE(28) PRE(29)
#undef PRE
#define PHASE(n) { if ((n) > 0 || PREMASK) grid_barrier(bar, smem); run_phase((n), P, smem); if (DUPMASK & (1u << (n))) { grid_barrier(bar, smem); run_phase((n), P, smem); } }
  PHASE(0) PHASE(1) PHASE(2) PHASE(3) PHASE(4) PHASE(5) PHASE(6) PHASE(7) PHASE(8) PHASE(9)
  PHASE(10) PHASE(11) PHASE(12) PHASE(13) PHASE(14) PHASE(15) PHASE(16) PHASE(17) PHASE(18) PHASE(19)
  PHASE(20) PHASE(21) PHASE(22) PHASE(23) PHASE(24) PHASE(25) PHASE(26) PHASE(27) PHASE(28) PHASE(29)
#undef PHASE
}

extern "C" void kernel_launch(void* const* d_in, const int* in_sizes, int n_in, void* d_out, int out_size, void* d_ws,
                              size_t ws_size, hipStream_t stream) {
  Params P{};
  for (int i = 0; i < 31; ++i) P.in[i] = (const float*)d_in[i];
  P.out = (float*)d_out;
  P.ws = (char*)d_ws;
  static int grid = 0;
  void* args[] = {&P};
  (void)hipMemsetAsync(P.ws + OFF_BAR, 0, 4096, stream);
  if (!grid) {
    int dev = 0, cus = 0;
    (void)hipGetDevice(&dev);
    (void)hipDeviceGetAttribute(&cus, hipDeviceAttributeMultiprocessorCount, dev);
    grid = cus * 2;
    hipError_t e0 = hipLaunchCooperativeKernel((void*)mega, dim3(grid), dim3(256), args, 0, stream);
    if (e0 != hipSuccess) {
      (void)hipGetLastError();
      grid = cus;
      e0 = hipLaunchCooperativeKernel((void*)mega, dim3(grid), dim3(256), args, 0, stream);
      if (e0 != hipSuccess) fprintf(stderr, "cooperative launch failed: %s (grid %d)\n", hipGetErrorString(e0), grid);
    }
    return;
  }
  hipError_t e = hipLaunchCooperativeKernel((void*)mega, dim3(grid), dim3(256), args, 0, stream);
  if (e != hipSuccess) fprintf(stderr, "cooperative launch failed: %s (grid %d)\n", hipGetErrorString(e), grid);
}
```

```cpp
#include <hip/hip_runtime.h>
#include <hip/hip_cooperative_groups.h>
#include <cstdio>
namespace cg = cooperative_groups;

#ifndef DUPMASK
#define DUPMASK 0u
#endif
#ifndef PREMASK
#define PREMASK 0u
#endif
#ifndef ONE_LAUNCH
#define ONE_LAUNCH 1
#endif

typedef unsigned short bf16_t;
using bf16x8 = __attribute__((ext_vector_type(8))) short;
using f32x4 = __attribute__((ext_vector_type(4))) float;
using u32x4 = __attribute__((ext_vector_type(4))) unsigned;

constexpr int T_P = 16384, T_S = 128, T = 16512;
constexpr int NCH = 264;
constexpr int NSEG_G = 32, NSEGT_G = NSEG_G + 8;
constexpr int NSEG_S = 16, NSEGT_S = NSEG_S + 8;
constexpr int LW = 1408;
constexpr float EPS = 1e-6f;

constexpr size_t O_YP = 0;
constexpr size_t O_YS = O_YP + (size_t)T_P * 1024;
constexpr size_t O_GLA_P = O_YS + (size_t)T_S * 1024;
constexpr size_t O_LCONV_P = O_GLA_P + (size_t)2 * 4 * 128 * 256;
constexpr size_t O_LH_P = O_LCONV_P + 3 * LW;
constexpr size_t O_SCONV_P = O_LH_P + LW;
constexpr size_t O_SH_P = O_SCONV_P + 3 * 3072;
constexpr size_t O_GLA_S = O_SH_P + (size_t)32 * 64 * 128;
constexpr size_t O_LCONV_S = O_GLA_S + (size_t)2 * 8 * 4 * 128 * 256;
constexpr size_t O_LH_S = O_LCONV_S + 8 * 3 * LW;
constexpr size_t O_SCONV_S = O_LH_S + 8 * LW;
constexpr size_t O_SH_S = O_SCONV_S + 8 * 3 * 3072;

constexpr size_t OFF_WIN = 0;
constexpr size_t OFF_WOUT = OFF_WIN + (size_t)5248 * 1024 * 2;
constexpr size_t OFF_WOUT1 = OFF_WOUT + (size_t)1024 * 2048 * 2;
constexpr size_t OFF_WG = OFF_WOUT1 + (size_t)1024 * 2048 * 2;
constexpr size_t OFF_H = OFF_WG + (size_t)2 * 16 * 96 * 96 * 2;
constexpr size_t OFF_BIG = OFF_H + (size_t)T * 1024 * 2;
constexpr size_t G_QD = OFF_BIG;
constexpr size_t G_KD = G_QD + (size_t)T * 512 * 2;
constexpr size_t G_KDT = G_KD + (size_t)T * 512 * 2;
constexpr size_t G_VT = G_KDT + (size_t)NCH * 512 * 64 * 2;
constexpr size_t G_G = G_VT + (size_t)NCH * 1024 * 64 * 2;
constexpr size_t G_O = G_G + (size_t)T * 1024 * 2;
constexpr size_t G_GLR = G_O + (size_t)T * 1024 * 2;
constexpr size_t G_SSQ = G_GLR + (size_t)T * 16 * 4;
constexpr size_t G_DEC = G_SSQ + (size_t)T * 16 * 4;
constexpr size_t G_SSEG = G_DEC + (size_t)NCH * 512 * 4;
constexpr size_t G_DSEG = G_SSEG + (size_t)NSEG_G * 4 * 256 * 128 * 4;
constexpr size_t G_END = G_DSEG + (size_t)NSEG_G * 512 * 4;
constexpr size_t L_XB = OFF_BIG;
constexpr size_t L_GATE = L_XB + (size_t)T * LW * 2;
constexpr size_t L_Y = L_GATE + (size_t)T * LW * 2;
constexpr size_t L_ASEG = L_Y + (size_t)T * LW * 2;
constexpr size_t L_HSEG = L_ASEG + (size_t)NCH * LW * 4;
constexpr size_t L_END = L_HSEG + (size_t)NCH * LW * 4;
constexpr size_t S_Z = OFF_BIG;
constexpr size_t S_XBCT = S_Z + (size_t)T * 2048 * 2;
constexpr size_t S_DT = S_XBCT + (size_t)NCH * 3072 * 64 * 2;
constexpr size_t S_TAIL = S_DT + (size_t)T * 32 * 4;
constexpr size_t S_SSQ = S_TAIL + (size_t)NCH * 3072 * 4 * 2;
constexpr size_t S_SSEG = S_SSQ + (size_t)T * 32 * 4;
constexpr size_t S_CDSEG = S_SSEG + (size_t)NSEG_S * 32 * 64 * 128 * 4;
constexpr size_t S_END = S_CDSEG + 4096;
constexpr size_t S_BRM = OFF_H;
constexpr size_t S_CRM = OFF_H + (size_t)T * 512 * 2;
static_assert(G_END <= 268435456ull - 4096 && L_END <= 268435456ull - 4096 && S_END <= 268435456ull - 4096, "ws overflow");

constexpr int SMEM_BYTES = 81920;
constexpr int SMEM_XB = 81856;

struct Params {
  const float* in[31];
  float* out;
  char* ws;
};

__device__ __forceinline__ int otid() { int t = threadIdx.x; asm volatile("" : "+v"(t)); return t; }
__device__ __forceinline__ bf16_t f2bf(float f) {
  unsigned u = __float_as_uint(f);
  u += 0x7fffu + ((u >> 16) & 1u);
  return (bf16_t)(u >> 16);
}
__device__ __forceinline__ float bf2f(bf16_t b) { return __uint_as_float(((unsigned)b) << 16); }
__device__ __forceinline__ unsigned pack2(float a, float b) { return (unsigned)f2bf(a) | ((unsigned)f2bf(b) << 16); }
__device__ __forceinline__ float lo_bf(unsigned w) { return __uint_as_float(w << 16); }
__device__ __forceinline__ float hi_bf(unsigned w) { return __uint_as_float(w & 0xffff0000u); }
__device__ __forceinline__ float sigmoid_(float x) { return __builtin_amdgcn_rcpf(1.f + __expf(-x)); }
__device__ __forceinline__ float silu_(float x) { return x * __builtin_amdgcn_rcpf(1.f + __expf(-x)); }
__device__ __forceinline__ float softplus_(float x) { return fmaxf(x, 0.f) + log1pf(__expf(-fabsf(x))); }

__device__ __forceinline__ void tok2chunk(int t, int& c, int& j) {
  if (t < T_P) { c = t >> 6; j = t & 63; }
  else { int u = t - T_P; c = 256 + (u >> 4); j = u & 15; }
}
__device__ __forceinline__ void chunk_info(int c, int& t0, int& len) {
  if (c < 256) { t0 = c * 64; len = 64; }
  else { t0 = T_P + (c - 256) * 16; len = 16; }
}
__device__ __forceinline__ void seg_info(int sg, int nseg, int& c0, int& nch, int& b) {
  if (sg < nseg) { const int cps = 256 / nseg; c0 = sg * cps; nch = cps; b = -1; }
  else { c0 = 256 + (sg - nseg); nch = 1; b = sg - nseg; }
}

template <int MT, int NT, int KS>
__device__ __forceinline__ void mma_lds(f32x4 (&acc)[MT][NT], const bf16_t* A, int lda, const bf16_t* B, int ldb, int r, int q) {
#pragma unroll
  for (int ks = 0; ks < KS; ++ks) {
    bf16x8 af[MT], bfr[NT];
#pragma unroll
    for (int mi = 0; mi < MT; ++mi) af[mi] = *(const bf16x8*)(A + (mi * 16 + r) * lda + ks * 32 + q * 8);
#pragma unroll
    for (int ni = 0; ni < NT; ++ni) bfr[ni] = *(const bf16x8*)(B + (ni * 16 + r) * ldb + ks * 32 + q * 8);
#pragma unroll
    for (int mi = 0; mi < MT; ++mi)
#pragma unroll
      for (int ni = 0; ni < NT; ++ni)
        acc[mi][ni] = __builtin_amdgcn_mfma_f32_16x16x32_bf16(af[mi], bfr[ni], acc[mi][ni], 0, 0, 0);
  }
}

__device__ __forceinline__ void ph_convT(const float* __restrict__ src, int K, int N, int Npad, bf16_t* __restrict__ dst,
                         const float* __restrict__ kscale, char* smem) {
  float* tile = (float*)smem;
  const int tid = otid();
  const int ktn = K / 64, ntn = Npad / 64;
  for (int it = blockIdx.x; it < ktn * ntn; it += gridDim.x) {
    const int kt = it / ntn, nt = it - kt * ntn;
    const int k0 = kt * 64, n0 = nt * 64;
    {
      const int nn = tid & 63, n = n0 + nn;
      float v[16];
#pragma unroll
      for (int i = 0; i < 16; ++i) {
        const int kk = (tid >> 6) + 4 * i;
        v[i] = 0.f;
        if (n < N) v[i] = src[(size_t)(k0 + kk) * N + n];
      }
      if (kscale) {
#pragma unroll
        for (int i = 0; i < 16; ++i) v[i] *= kscale[k0 + (tid >> 6) + 4 * i];
      }
      __syncthreads();
#pragma unroll
      for (int i = 0; i < 16; ++i) tile[((tid >> 6) + 4 * i) * 65 + nn] = v[i];
    }
    __syncthreads();
#pragma unroll
    for (int i = 0; i < 2; ++i) {
      const int nn = (tid >> 3) + 32 * i, kk = (tid & 7) * 8;
      uint4 u;
      u.x = pack2(tile[(kk + 0) * 65 + nn], tile[(kk + 1) * 65 + nn]);
      u.y = pack2(tile[(kk + 2) * 65 + nn], tile[(kk + 3) * 65 + nn]);
      u.z = pack2(tile[(kk + 4) * 65 + nn], tile[(kk + 5) * 65 + nn]);
      u.w = pack2(tile[(kk + 6) * 65 + nn], tile[(kk + 7) * 65 + nn]);
      *(uint4*)(dst + (size_t)(n0 + nn) * K + k0 + kk) = u;
    }
  }
}

__device__ __forceinline__ void ph_conv_gate(const float* __restrict__ w, bf16_t* __restrict__ dst) {
  for (int idx = blockIdx.x * 256 + otid(); idx < 16 * 96 * 96; idx += gridDim.x * 256) {
    const int k = idx / 9216, rem = idx - k * 9216, co = rem / 96, ci = rem - co * 96;
    float v = 0.f;
    if (co < 88 && ci < 88) v = w[(k * 88 + ci) * 88 + co];
    dst[idx] = f2bf(v);
  }
}

__device__ __forceinline__ void ph_norm(const float* __restrict__ xp, const float* __restrict__ xs, const float* __restrict__ w,
                        bf16_t* __restrict__ h, float* xcopy) {
  const int lane = otid() & 63, wave = otid() >> 6;
  for (int row = blockIdx.x * 4 + wave; row < T; row += gridDim.x * 4) {
    const float* src = row < T_P ? xp + (size_t)row * 1024 : xs + (size_t)(row - T_P) * 1024;
    float4 v[4];
    float ss = 0.f;
#pragma unroll
    for (int i = 0; i < 4; ++i) {
      v[i] = *(const float4*)(src + i * 256 + lane * 4);
      ss += v[i].x * v[i].x + v[i].y * v[i].y + v[i].z * v[i].z + v[i].w * v[i].w;
    }
#pragma unroll
    for (int off = 32; off >= 1; off >>= 1) ss += __shfl_xor(ss, off);
    const float rs = rsqrtf(ss * (1.f / 1024.f) + EPS);
    if (xcopy != nullptr && row >= T_P) {
#pragma unroll
      for (int i = 0; i < 4; ++i) *(float4*)(xcopy + (size_t)row * 1024 + i * 256 + lane * 4) = v[i];
    }
#pragma unroll
    for (int i = 0; i < 4; ++i) {
      const float4 ww = *(const float4*)(w + i * 256 + lane * 4);
      uint2 o;
      o.x = pack2(v[i].x * rs * ww.x, v[i].y * rs * ww.y);
      o.y = pack2(v[i].z * rs * ww.z, v[i].w * rs * ww.w);
      *(uint2*)(h + (size_t)row * 1024 + i * 256 + lane * 4) = o;
    }
  }
}

__device__ __forceinline__ void ph_final_norm(float* __restrict__ x, const float* __restrict__ w) {
  const int lane = otid() & 63, wave = otid() >> 6;
  for (int row = blockIdx.x * 4 + wave; row < T; row += gridDim.x * 4) {
    float* src = x + (size_t)row * 1024;
    float4 v[4];
    float ss = 0.f;
#pragma unroll
    for (int i = 0; i < 4; ++i) {
      v[i] = *(const float4*)(src + i * 256 + lane * 4);
      ss += v[i].x * v[i].x + v[i].y * v[i].y + v[i].z * v[i].z + v[i].w * v[i].w;
    }
#pragma unroll
    for (int off = 32; off >= 1; off >>= 1) ss += __shfl_xor(ss, off);
    const float rs = rsqrtf(ss * (1.f / 1024.f) + EPS);
#pragma unroll
    for (int i = 0; i < 4; ++i) {
      const float4 ww = *(const float4*)(w + i * 256 + lane * 4);
      float4 o;
      o.x = v[i].x * rs * ww.x; o.y = v[i].y * rs * ww.y; o.z = v[i].z * rs * ww.z; o.w = v[i].w * rs * ww.w;
      *(float4*)(src + i * 256 + lane * 4) = o;
    }
  }
}

#define GLDS16(gp, lp) __builtin_amdgcn_global_load_lds((const unsigned*)(gp), (unsigned*)(lp), 16, 0, 0)
template <class Epi, bool SWP>
__device__ __forceinline__ void gemm_tile(const bf16_t* __restrict__ A, int lda, const bf16_t* __restrict__ Bt, int ldb, int nk,
                                          int tm, int tn, Epi epi, char* smem) {
  const int tid = otid(), lane = tid & 63, wave = tid >> 6;
  const int wm = wave >> 1, wn = wave & 1, r = lane & 15, q = lane >> 4;
  const int srow = tid >> 2, skc = (tid & 3) * 8;
  char* l0 = smem + tid * 16;
  f32x4 acc[32];
#pragma unroll
  for (int i = 0; i < 32; ++i) acc[i] = f32x4{0.f, 0.f, 0.f, 0.f};
  const int a_off = wm * 8192 + r * 64 + q * 16;
  const int b_off = 16384 + wn * 4096 + r * 64 + q * 16;
  const int b_offp = 16384 + wn * 4096 + (8 * (r >> 2) + (r & 3)) * 64 + q * 16;
  const bf16_t* Ag = A + (size_t)(tm * 256 + srow) * lda + skc;
  const bf16_t* Bg = Bt + (size_t)(tn * 128 + srow) * ldb + skc;
  const size_t a64 = (size_t)64 * lda, b64 = (size_t)64 * ldb;
#define G_ISSUE(t_, st_)                                   \
  {                                                        \
    const int ko_ = (t_) * 32;                             \
    char* lb_ = l0 + (st_) * 24576;                        \
    GLDS16(Ag + ko_, lb_);                                 \
    GLDS16(Ag + a64 + ko_, lb_ + 4096);                    \
    GLDS16(Ag + 2 * a64 + ko_, lb_ + 8192);                \
    GLDS16(Ag + 3 * a64 + ko_, lb_ + 12288);               \
    GLDS16(Bg + ko_, lb_ + 16384);                         \
    GLDS16(Bg + b64 + ko_, lb_ + 20480);                   \
  }
#define G_STEP(t_, st_)                                                                                   \
  {                                                                                                       \
    const int tt_ = (t_);                                                                                 \
    if (tt_ + 1 < nk) asm volatile("s_waitcnt vmcnt(6) lgkmcnt(0)\n\ts_barrier" ::: "memory");            \
    else asm volatile("s_waitcnt vmcnt(0) lgkmcnt(0)\n\ts_barrier" ::: "memory");                         \
    if (tt_ + 2 < nk) G_ISSUE(tt_ + 2, ((st_) + 2) % 3)                                                   \
    const char* sb_ = smem + (st_) * 24576;                                                               \
    bf16x8 af_[8], bf_[4];                                                                                \
    _Pragma("unroll") for (int mi = 0; mi < 8; ++mi) af_[mi] = *(const bf16x8*)(sb_ + a_off + mi * 1024);  \
    _Pragma("unroll") for (int ni = 0; ni < 4; ++ni)                                                      \
      bf_[ni] = *(const bf16x8*)(sb_ + (SWP ? b_offp + (ni >> 1) * 2048 + (ni & 1) * 256 : b_off + ni * 1024)); \
    __builtin_amdgcn_s_setprio(1);                                                                        \
    _Pragma("unroll") for (int mi = 0; mi < 8; ++mi)                                                      \
    _Pragma("unroll") for (int ni = 0; ni < 4; ++ni)                                                      \
      acc[mi * 4 + ni] = SWP ? __builtin_amdgcn_mfma_f32_16x16x32_bf16(bf_[ni], af_[mi], acc[mi * 4 + ni], 0, 0, 0) \
                             : __builtin_amdgcn_mfma_f32_16x16x32_bf16(af_[mi], bf_[ni], acc[mi * 4 + ni], 0, 0, 0); \
    __builtin_amdgcn_s_setprio(0);                                                                        \
  }
  asm volatile("s_waitcnt vmcnt(0)" ::: "memory");
  G_ISSUE(0, 0)
  G_ISSUE(1, 1)
  {
    int st = 0;
    for (int t = 0; t < nk; ++t) {
      G_STEP(t, st)
      st = st == 2 ? 0 : st + 1;
    }
  }
#undef G_STEP
#undef G_ISSUE
  epi.begin(tm * 256 + wm * 128, lane);
#pragma unroll
  for (int mi = 0; mi < 8; ++mi)
#pragma unroll
    for (int ni = 0; ni < 4; ++ni) {
      if (SWP) {
        if ((ni & 1) == 0)
          epi.rowvec8(tm * 256 + wm * 128 + mi * 16 + r, tn * 128 + wn * 64 + (ni >> 1) * 32 + q * 8, acc[mi * 4 + ni], acc[mi * 4 + ni + 1]);
      } else epi.colvec(tm * 256 + wm * 128 + mi * 16 + q * 4, tn * 128 + wn * 64 + ni * 16 + r, acc[mi * 4 + ni]);
    }
}

template <class Epi>
__device__ __forceinline__ void gemm_main(const bf16_t* __restrict__ A, int lda, const bf16_t* __restrict__ Bt, int ldb, int K,
                                          int Ntiles, Epi epi, char* smem) {
  const int nk = K / 32;
  const int total = 64 * Ntiles;
  for (int sidx = blockIdx.x; sidx < total; sidx += gridDim.x) {
    const int u = sidx >> 3;
    const int tn = u >> 3, tm = (sidx & 7) * 8 + (u & 7);
    if (epi.swapped_col(tn * 128)) gemm_tile<Epi, true>(A, lda, Bt, ldb, nk, tm, tn, epi, smem);
    else gemm_tile<Epi, false>(A, lda, Bt, ldb, nk, tm, tn, epi, smem);
  }
}

template <class Epi>
__device__ __forceinline__ void gemm_side(const bf16_t* __restrict__ A, int lda, const bf16_t* __restrict__ Bt, int ldb, int K,
                                          int N, int Nfull, Epi epi) {
  const int tid = otid(), lane = tid & 63, wave = tid >> 6, r = lane & 15, q = lane >> 4;
  const int ncg = (N + 31) >> 5, cg_left0 = Nfull >> 5, nleft = ncg - cg_left0;
  constexpr int KS = Epi::KSPLIT;
  const int njobs0 = ncg + nleft * 128, njobs = njobs0 * KS;
  const int Kpart = K / KS;
  for (int jx = blockIdx.x; jx < njobs; jx += gridDim.x) {
    const int ks = KS > 1 ? jx / njobs0 : 0, j = jx - ks * njobs0;
    int row0, cg;
    if (j < ncg) { row0 = T_P; cg = j; }
    else { const int jj = j - ncg, rt = jj / nleft; row0 = rt * 128; cg = cg_left0 + (jj - rt * nleft); }
    const int col0 = cg * 32;
    const bool swp = epi.swapped_col(col0);
    f32x4 acc[4];
#pragma unroll
    for (int i = 0; i < 4; ++i) acc[i] = f32x4{0.f, 0.f, 0.f, 0.f};
    const bf16_t* Ap = A + (size_t)(row0 + 32 * wave + r) * lda + q * 8 + ks * Kpart;
    const bf16_t* Bp = Bt + (size_t)(col0 + r) * ldb + q * 8 + ks * Kpart;
    const size_t a16 = (size_t)16 * lda, b16 = (size_t)16 * ldb;
    if (swp) {
#pragma unroll 4
      for (int k0 = 0; k0 < Kpart; k0 += 32) {
        const bf16x8 a0 = *(const bf16x8*)(Ap + k0), a1 = *(const bf16x8*)(Ap + a16 + k0);
        const bf16x8 b0 = *(const bf16x8*)(Bp + k0), b1 = *(const bf16x8*)(Bp + b16 + k0);
        acc[0] = __builtin_amdgcn_mfma_f32_16x16x32_bf16(b0, a0, acc[0], 0, 0, 0);
        acc[1] = __builtin_amdgcn_mfma_f32_16x16x32_bf16(b1, a0, acc[1], 0, 0, 0);
        acc[2] = __builtin_amdgcn_mfma_f32_16x16x32_bf16(b0, a1, acc[2], 0, 0, 0);
        acc[3] = __builtin_amdgcn_mfma_f32_16x16x32_bf16(b1, a1, acc[3], 0, 0, 0);
      }
    } else {
#pragma unroll 4
      for (int k0 = 0; k0 < Kpart; k0 += 32) {
        const bf16x8 a0 = *(const bf16x8*)(Ap + k0), a1 = *(const bf16x8*)(Ap + a16 + k0);
        const bf16x8 b0 = *(const bf16x8*)(Bp + k0), b1 = *(const bf16x8*)(Bp + b16 + k0);
        acc[0] = __builtin_amdgcn_mfma_f32_16x16x32_bf16(a0, b0, acc[0], 0, 0, 0);
        acc[1] = __builtin_amdgcn_mfma_f32_16x16x32_bf16(a0, b1, acc[1], 0, 0, 0);
        acc[2] = __builtin_amdgcn_mfma_f32_16x16x32_bf16(a1, b0, acc[2], 0, 0, 0);
        acc[3] = __builtin_amdgcn_mfma_f32_16x16x32_bf16(a1, b1, acc[3], 0, 0, 0);
      }
    }
    epi.begin(row0 + 32 * wave, lane);
#pragma unroll
    for (int mi = 0; mi < 2; ++mi)
#pragma unroll
      for (int ni = 0; ni < 2; ++ni) {
        if (KS > 1) epi.rowvec_acc(row0 + 32 * wave + mi * 16 + r, col0 + ni * 16 + q * 4, acc[mi * 2 + ni]);
        else if (swp) epi.rowvec(row0 + 32 * wave + mi * 16 + r, col0 + ni * 16 + q * 4, acc[mi * 2 + ni]);
        else epi(row0 + 32 * wave + mi * 16 + q * 4, col0 + ni * 16 + r, acc[mi * 2 + ni]);
      }
  }
}

template <class Epi>
__device__ __forceinline__ void gemm_phase(const bf16_t* __restrict__ A, int lda, const bf16_t* __restrict__ Bt, int ldb, int K,
                                           int N, Epi epi, char* smem) {
  gemm_main(A, lda, Bt, ldb, K, N >> 7, epi, smem);
  gemm_side(A, lda, Bt, ldb, K, N, (N >> 7) << 7, epi);
}

struct EpiGlaIn {
  static constexpr int KSPLIT = 1;
  __device__ __forceinline__ void rowvec_acc(int, int, f32x4) const {}
  bf16_t *qd, *kd, *vT, *g;
  float* glr;
  __device__ __forceinline__ void begin(int, int) {}
  __device__ __forceinline__ bool swapped_col(int c) const { return c < 1024 || (c >= 2048 && c < 3072); }
  __device__ __forceinline__ void colvec(int row0, int col, f32x4 v) const {
    uint2 u;
    u.x = pack2(v[0], v[1]);
    u.y = pack2(v[2], v[3]);
    *(uint2*)(vT + ((size_t)(row0 >> 6) * 1024 + (col - 1024)) * 64 + (row0 & 63)) = u;
  }
  __device__ __forceinline__ void rowvec8(int row, int col0, f32x4 v, f32x4 w) const {
    const float sc = col0 < 512 ? 0.08838834764831845f : 1.f;
    const u32x4 u = u32x4{pack2(v[0] * sc, v[1] * sc), pack2(v[2] * sc, v[3] * sc), pack2(w[0] * sc, w[1] * sc), pack2(w[2] * sc, w[3] * sc)};
    bf16_t* dst = col0 < 512 ? qd + (size_t)row * 512 + col0
                : col0 < 1024 ? kd + (size_t)row * 512 + (col0 - 512) : g + (size_t)row * 1024 + (col0 - 2048);
    *(u32x4*)dst = u;
  }
  __device__ __forceinline__ void rowvec(int row, int col0, f32x4 v) const {
    uint2 u;
    if (col0 < 512) {
      const float sc = 0.08838834764831845f;
      u.x = pack2(v[0] * sc, v[1] * sc); u.y = pack2(v[2] * sc, v[3] * sc);
      *(uint2*)(qd + (size_t)row * 512 + col0) = u;
    } else if (col0 < 1024) {
      u.x = pack2(v[0], v[1]); u.y = pack2(v[2], v[3]);
      *(uint2*)(kd + (size_t)row * 512 + (col0 - 512)) = u;
    } else {
      u.x = pack2(v[0], v[1]); u.y = pack2(v[2], v[3]);
      *(uint2*)(g + (size_t)row * 1024 + (col0 - 2048)) = u;
    }
  }
  __device__ __forceinline__ void operator()(int row0, int col, f32x4 v) const {
    if (col < 512) {
#pragma unroll
      for (int jj = 0; jj < 4; ++jj) qd[(size_t)(row0 + jj) * 512 + col] = f2bf(v[jj] * 0.08838834764831845f);
    } else if (col < 1024) {
#pragma unroll
      for (int jj = 0; jj < 4; ++jj) kd[(size_t)(row0 + jj) * 512 + (col - 512)] = f2bf(v[jj]);
    } else if (col < 2048) {
      int c, j;
      tok2chunk(row0, c, j);
      uint2 u;
      u.x = pack2(v[0], v[1]);
      u.y = pack2(v[2], v[3]);
      *(uint2*)(vT + ((size_t)c * 1024 + (col - 1024)) * 64 + j) = u;
    } else if (col < 3072) {
#pragma unroll
      for (int jj = 0; jj < 4; ++jj) g[(size_t)(row0 + jj) * 1024 + (col - 2048)] = f2bf(v[jj]);
    } else if (col < 3088) {
#pragma unroll
      for (int jj = 0; jj < 4; ++jj) glr[(size_t)(row0 + jj) * 16 + (col - 3072)] = v[jj];
    }
  }
};

struct EpiLruIn {
  static constexpr int KSPLIT = 1;
  __device__ __forceinline__ void rowvec_acc(int, int, f32x4) const {}
  bf16_t *xb, *gate;
  __device__ __forceinline__ void begin(int, int) {}
  __device__ __forceinline__ bool swapped_col(int) const { return true; }
  __device__ __forceinline__ void colvec(int, int, f32x4) const {}
  __device__ __forceinline__ void rowvec8(int row, int col0, f32x4 v, f32x4 w) const {
    bf16_t* dst = col0 < LW ? xb + col0 : gate + (col0 - LW);
    *(u32x4*)(dst + (size_t)row * LW) = u32x4{pack2(v[0], v[1]), pack2(v[2], v[3]), pack2(w[0], w[1]), pack2(w[2], w[3])};
  }
  __device__ __forceinline__ void rowvec(int row, int col0, f32x4 v) const {
    bf16_t* dst = col0 < LW ? xb + col0 : gate + (col0 - LW);
    uint2 u;
    u.x = pack2(v[0], v[1]); u.y = pack2(v[2], v[3]);
    *(uint2*)(dst + (size_t)row * LW) = u;
  }
  __device__ __forceinline__ void operator()(int row0, int col, f32x4 v) const {
    bf16_t* dst = col < LW ? xb + col : gate + (col - LW);
#pragma unroll
    for (int jj = 0; jj < 4; ++jj) dst[(size_t)(row0 + jj) * LW] = f2bf(v[jj]);
  }
};

struct EpiSsdIn {
  static constexpr int KSPLIT = 1;
  __device__ __forceinline__ void rowvec_acc(int, int, f32x4) const {}
  bf16_t *z, *xbcT, *tails;
  float* dt;
  const float* dt_bias;
  __device__ __forceinline__ void begin(int, int) {}
  __device__ __forceinline__ bool swapped_col(int c) const { return c < 2048; }
  __device__ __forceinline__ void colvec(int row0, int col, f32x4 v) const {
    const int c = row0 >> 6, j = row0 & 63, cc = col - 2048;
    uint2 u;
    u.x = pack2(v[0], v[1]);
    u.y = pack2(v[2], v[3]);
    *(uint2*)(xbcT + ((size_t)c * 3072 + cc) * 64 + j) = u;
    if (j == 60) *(uint2*)(tails + ((size_t)c * 3072 + cc) * 4) = u;
  }
  __device__ __forceinline__ void rowvec8(int row, int col0, f32x4 v, f32x4 w) const {
    *(u32x4*)(z + (size_t)row * 2048 + col0) = u32x4{pack2(v[0], v[1]), pack2(v[2], v[3]), pack2(w[0], w[1]), pack2(w[2], w[3])};
  }
  __device__ __forceinline__ void rowvec(int row, int col0, f32x4 v) const {
    uint2 u;
    u.x = pack2(v[0], v[1]); u.y = pack2(v[2], v[3]);
    *(uint2*)(z + (size_t)row * 2048 + col0) = u;
  }
  __device__ __forceinline__ void operator()(int row0, int col, f32x4 v) const {
    if (col < 2048) {
#pragma unroll
      for (int jj = 0; jj < 4; ++jj) z[(size_t)(row0 + jj) * 2048 + col] = f2bf(v[jj]);
    } else if (col < 5120) {
      int c, j;
      tok2chunk(row0, c, j);
      const int len = c < 256 ? 64 : 16;
      const int cc = col - 2048;
      uint2 u;
      u.x = pack2(v[0], v[1]);
      u.y = pack2(v[2], v[3]);
      *(uint2*)(xbcT + ((size_t)c * 3072 + cc) * 64 + j) = u;
      if (j == len - 4) *(uint2*)(tails + ((size_t)c * 3072 + cc) * 4) = u;
    } else if (col < 5152) {
      const int hd = col - 5120;
#pragma unroll
      for (int jj = 0; jj < 4; ++jj) dt[(size_t)(row0 + jj) * 32 + hd] = v[jj];
    }
  }
};

struct EpiResid {
  const float *xin_p, *xin_s;
  float* xout;
  static constexpr int KSPLIT = 4;
  __device__ __forceinline__ void rowvec_acc(int row, int col0, f32x4 v) const {
    float* dst = xout + (size_t)row * 1024 + col0;
#pragma unroll
    for (int e = 0; e < 4; ++e) (void)__hip_atomic_fetch_add(dst + e, v[e], __ATOMIC_RELAXED, __HIP_MEMORY_SCOPE_AGENT);
  }
  __device__ __forceinline__ void begin(int, int) {}
  __device__ __forceinline__ bool swapped_col(int) const { return true; }
  __device__ __forceinline__ void colvec(int, int, f32x4) const {}
  __device__ __forceinline__ void rowvec8(int row, int col0, f32x4 v, f32x4 w) const {
    rowvec(row, col0, v);
    rowvec(row, col0 + 4, w);
  }
  __device__ __forceinline__ void rowvec(int row, int col0, f32x4 v) const {
    const float* src = row < T_P ? xin_p + (size_t)row * 1024 : xin_s + (size_t)(row - T_P) * 1024;
    const float4 x = *(const float4*)(src + col0);
    float4 o;
    o.x = x.x + v[0]; o.y = x.y + v[1]; o.z = x.z + v[2]; o.w = x.w + v[3];
    *(float4*)(xout + (size_t)row * 1024 + col0) = o;
  }
  __device__ __forceinline__ void operator()(int row0, int col, f32x4 v) const {
#pragma unroll
    for (int jj = 0; jj < 4; ++jj) {
      const int row = row0 + jj;
      const float* src = row < T_P ? xin_p + (size_t)row * 1024 : xin_s + (size_t)(row - T_P) * 1024;
      xout[(size_t)row * 1024 + col] = src[col] + v[jj];
    }
  }
};

struct EpiResidScaled {
  static constexpr int KSPLIT = 4;
  __device__ __forceinline__ void rowvec_acc(int row, int col0, f32x4 v) const {
    const int o_ = row - rowbase;
    const float s0_ = __shfl(rs, o_ & 63), s1_ = __shfl(rs1, o_ & 63);
    const float sc = o_ < 64 ? s0_ : s1_;
    float* dst = xout + (size_t)row * 1024 + col0;
#pragma unroll
    for (int e = 0; e < 4; ++e) (void)__hip_atomic_fetch_add(dst + e, sc * v[e], __ATOMIC_RELAXED, __HIP_MEMORY_SCOPE_AGENT);
  }
  const float *xin_p, *xin_s;
  float* xout;
  const float* ssq;
  float rs, rs1;
  int rowbase;
  __device__ __forceinline__ bool swapped_col(int) const { return true; }
  __device__ __forceinline__ void colvec(int, int, f32x4) const {}
  __device__ __forceinline__ void rowvec8(int row, int col0, f32x4 v, f32x4 w) const {
    rowvec(row, col0, v);
    rowvec(row, col0 + 4, w);
  }
  __device__ __forceinline__ void rowvec(int row, int col0, f32x4 v) const {
    const int o_ = row - rowbase;
    const float s0_ = __shfl(rs, o_ & 63), s1_ = __shfl(rs1, o_ & 63);
    const float sc = o_ < 64 ? s0_ : s1_;
    const float* src = row < T_P ? xin_p + (size_t)row * 1024 : xin_s + (size_t)(row - T_P) * 1024;
    const float4 x = *(const float4*)(src + col0);
    float4 o;
    o.x = x.x + sc * v[0]; o.y = x.y + sc * v[1]; o.z = x.z + sc * v[2]; o.w = x.w + sc * v[3];
    *(float4*)(xout + (size_t)row * 1024 + col0) = o;
  }
  __device__ __forceinline__ void begin(int rb, int lane) {
    rowbase = rb;
    float rr[2];
#pragma unroll
    for (int hh = 0; hh < 2; ++hh) {
      const int row = rb + hh * 64 + lane;
      float sacc = 0.f;
      if (row < T) {
        const float4* p = (const float4*)(ssq + (size_t)row * 32);
#pragma unroll
        for (int i = 0; i < 8; ++i) {
          const float4 v = p[i];
          sacc += v.x + v.y + v.z + v.w;
        }
      }
      rr[hh] = rsqrtf(sacc * (1.f / 2048.f) + EPS);
    }
    rs = rr[0];
    rs1 = rr[1];
  }
  __device__ __forceinline__ void operator()(int row0, int col, f32x4 v) const {
#pragma unroll
    for (int jj = 0; jj < 4; ++jj) {
      const int row = row0 + jj;
      const int o_ = row - rowbase;
      const float s0_ = __shfl(rs, o_ & 63), s1_ = __shfl(rs1, o_ & 63);
      const float sc = o_ < 64 ? s0_ : s1_;
      const float* src = row < T_P ? xin_p + (size_t)row * 1024 : xin_s + (size_t)(row - T_P) * 1024;
      xout[(size_t)row * 1024 + col] = src[col] + sc * v[jj];
    }
  }
};

__device__ __forceinline__ void ph_gla_prep(const Params& P, int layer, char* smem) {
  bf16_t* sQ = (bf16_t*)smem;
  bf16_t* sK = (bf16_t*)(smem + 8192);
  float* sG = (float*)(smem + 16384);
  float* sTot = (float*)(smem + 20480);
  bf16_t* qd = (bf16_t*)(P.ws + G_QD);
  bf16_t* kd = (bf16_t*)(P.ws + G_KD);
  bf16_t* kdT = (bf16_t*)(P.ws + G_KDT);
  const float* glr = (const float*)(P.ws + G_GLR);
  float* decay = (float*)(P.ws + G_DEC);
  const float* wgu = P.in[10] + (size_t)layer * 16 * 512;
  const float* bgt = P.in[11] + (size_t)layer * 512;
  const int tid = otid(), tg = tid >> 6, cl = tid & 63;
  for (int it = blockIdx.x; it < NCH * 8; it += gridDim.x) {
    const int c = it >> 3, cb8 = it & 7, d = cb8 * 64 + cl;
    int t0, len;
    chunk_info(c, t0, len);
    float wg[16];
#pragma unroll
    for (int rk = 0; rk < 16; ++rk) wg[rk] = wgu[rk * 512 + d];
    const float bg = bgt[d];
    u32x4 rq[2], rk2[2];
#pragma unroll
    for (int i = 0; i < 2; ++i) {
      const int id = tid + 256 * i, row = id >> 3, c16 = id & 7;
      rq[i] = u32x4{0u, 0u, 0u, 0u};
      rk2[i] = u32x4{0u, 0u, 0u, 0u};
      if (row < len) {
        const size_t a = (size_t)(t0 + row) * 512 + cb8 * 64 + c16 * 8;
        rq[i] = *(const u32x4*)(qd + a);
        rk2[i] = *(const u32x4*)(kd + a);
      }
    }
    float4 gl4 = float4{0.f, 0.f, 0.f, 0.f};
    if (tid * 4 < len * 16) gl4 = *(const float4*)(glr + (size_t)t0 * 16 + tid * 4);
    __syncthreads();
#pragma unroll
    for (int i = 0; i < 2; ++i) {
      const int id = tid + 256 * i, row = id >> 3, c16 = id & 7;
      *(u32x4*)(sQ + row * 64 + c16 * 8) = rq[i];
      *(u32x4*)(sK + row * 64 + c16 * 8) = rk2[i];
    }
    *(float4*)(sG + tid * 4) = gl4;
    __syncthreads();
    float cs[16];
    float run = 0.f;
#pragma unroll
    for (int e = 0; e < 16; ++e) {
      const int j = tg * 16 + e;
      float x = bg;
#pragma unroll
      for (int rk = 0; rk < 16; ++rk) x += sG[j * 16 + rk] * wg[rk];
      const float ls = fminf(x, 0.f) - __logf(1.f + __expf(-fabsf(x)));
      run += (j < len) ? ls * (1.f / 16.f) : 0.f;
      cs[e] = run;
    }
    sTot[tg * 64 + cl] = run;
    __syncthreads();
    float off = 0.f;
#pragma unroll
    for (int g2 = 0; g2 < 3; ++g2) off += (g2 < tg) ? sTot[g2 * 64 + cl] : 0.f;
    unsigned pk[8];
#pragma unroll
    for (int e = 0; e < 16; ++e) {
      const int j = tg * 16 + e;
      const float bc = off + cs[e];
      const float eb = __expf(bc);
      const float qv = bf2f(sQ[j * 64 + cl]), kv = bf2f(sK[j * 64 + cl]);
      sQ[j * 64 + cl] = f2bf(qv * eb);
      const bf16_t kb = f2bf(kv * __builtin_amdgcn_rcpf(eb));
      sK[j * 64 + cl] = kb;
      if (e & 1) pk[e >> 1] |= ((unsigned)kb << 16);
      else pk[e >> 1] = (unsigned)kb;
    }
    if (tg * 16 < len) {
      bf16_t* dstT = kdT + ((size_t)c * 512 + d) * 64 + tg * 16;
      *(u32x4*)dstT = u32x4{pk[0], pk[1], pk[2], pk[3]};
      *(u32x4*)(dstT + 8) = u32x4{pk[4], pk[5], pk[6], pk[7]};
    }
    if (tg == 3) decay[(size_t)c * 512 + d] = __expf(off + run);
    __syncthreads();
#pragma unroll
    for (int i = 0; i < 2; ++i) {
      const int id = tid + 256 * i, row = id >> 3, c16 = id & 7;
      if (row < len) {
        const size_t a = (size_t)(t0 + row) * 512 + cb8 * 64 + c16 * 8;
        *(u32x4*)(qd + a) = *(const u32x4*)(sQ + row * 64 + c16 * 8);
        *(u32x4*)(kd + a) = *(const u32x4*)(sK + row * 64 + c16 * 8);
      }
    }
  }
}

__device__ __forceinline__ void ph_gla_pass(const bool passB, const int layer, const Params& P, char* smem) {
  bf16_t* sKT = (bf16_t*)(smem);
  bf16_t* sVT = (bf16_t*)(smem + 18432);
  bf16_t* sQ = (bf16_t*)(smem + 27648);
  bf16_t* sK = (bf16_t*)(smem + 45056);
  bf16_t* sAtt = sK;
  bf16_t* sS = (bf16_t*)(smem + 62464);
  const bf16_t* qd = (const bf16_t*)(P.ws + G_QD);
  const bf16_t* kd = (const bf16_t*)(P.ws + G_KD);
  const bf16_t* kdT = (const bf16_t*)(P.ws + G_KDT);
  const bf16_t* vT = (const bf16_t*)(P.ws + G_VT);
  bf16_t* obuf = (bf16_t*)(P.ws + G_O);
  float* ssq = (float*)(P.ws + G_SSQ);
  const float* decay = (const float*)(P.ws + G_DEC);
  float* Sseg = (float*)(P.ws + G_SSEG);
  const float* st_in = P.in[2];
  const int tid = otid(), lane = tid & 63, wave = tid >> 6, r = lane & 15, q = lane >> 4;
  const int nitems = passB ? NSEGT_G * 16 : (NSEG_G - 1) * 16;
  for (int it = blockIdx.x; it < nitems; it += gridDim.x) {
    const int sg = it >> 4, h = (it >> 2) & 3, sl = it & 3;
    int c0, nch, b;
    seg_info(sg, NSEG_G, c0, nch, b);
    f32x4 accS[2][4];
#pragma unroll
    for (int mt = 0; mt < 2; ++mt)
#pragma unroll
      for (int nt = 0; nt < 4; ++nt) {
        const int d0 = 32 * wave + mt * 16 + q * 4, v = sl * 64 + nt * 16 + r;
        if (!passB) accS[mt][nt] = f32x4{0.f, 0.f, 0.f, 0.f};
        else if (sg < NSEG_G) {
          const float4 t4 = *(const float4*)(Sseg + ((size_t)(sg * 4 + h) * 256 + v) * 128 + d0);
          accS[mt][nt] = f32x4{t4.x, t4.y, t4.z, t4.w};
        } else {
#pragma unroll
          for (int jj = 0; jj < 4; ++jj)
            accS[mt][nt][jj] = st_in[((((size_t)layer * 8 + b) * 4 + h) * 128 + d0 + jj) * 256 + v];
        }
      }
    float dprod[8] = {1.f, 1.f, 1.f, 1.f, 1.f, 1.f, 1.f, 1.f};
    u32x4 pk[4], pv[2];
    float pdec[8];
#define GLA_ISSUE(cc_)                                                                                         \
  {                                                                                                            \
    const int cx_ = (cc_);                                                                                     \
    const int lenx_ = cx_ < 256 ? 64 : 16;                                                                     \
    _Pragma("unroll") for (int i = 0; i < 4; ++i) {                                                            \
      const int id = tid + 256 * i, row = id >> 3, c16 = id & 7;                                               \
      pk[i] = u32x4{0u, 0u, 0u, 0u};                                                                           \
      if (c16 * 8 < lenx_) pk[i] = *(const u32x4*)(kdT + ((size_t)cx_ * 512 + h * 128 + row) * 64 + c16 * 8);  \
    }                                                                                                          \
    _Pragma("unroll") for (int i = 0; i < 2; ++i) {                                                            \
      const int id = tid + 256 * i, row = id >> 3, c16 = id & 7;                                               \
      pv[i] = u32x4{0u, 0u, 0u, 0u};                                                                           \
      if (c16 * 8 < lenx_) pv[i] = *(const u32x4*)(vT + ((size_t)cx_ * 1024 + h * 256 + sl * 64 + row) * 64 + c16 * 8); \
    }                                                                                                          \
    _Pragma("unroll") for (int mt = 0; mt < 2; ++mt)                                                           \
    _Pragma("unroll") for (int jj = 0; jj < 4; ++jj)                                                           \
      pdec[mt * 4 + jj] = decay[(size_t)cx_ * 512 + h * 128 + 32 * wave + mt * 16 + q * 4 + jj];               \
  }
    GLA_ISSUE(c0)
    for (int ci = 0; ci < nch; ++ci) {
      const int c = c0 + ci;
      int t0, len;
      chunk_info(c, t0, len);
      __syncthreads();
#pragma unroll
      for (int i = 0; i < 4; ++i) {
        const int id = tid + 256 * i, row = id >> 3, c16 = id & 7;
        *(u32x4*)(sKT + row * 72 + c16 * 8) = pk[i];
      }
#pragma unroll
      for (int i = 0; i < 2; ++i) {
        const int id = tid + 256 * i, row = id >> 3, c16 = id & 7;
        *(u32x4*)(sVT + row * 72 + c16 * 8) = pv[i];
      }
      float dec8[8];
#pragma unroll
      for (int e = 0; e < 8; ++e) dec8[e] = pdec[e];
      if (passB) {
#pragma unroll
        for (int i = 0; i < 4; ++i) {
          const int id = tid + 256 * i, row = id >> 4, c16 = id & 15;
          uint4 vq = uint4{0u, 0u, 0u, 0u}, vk = uint4{0u, 0u, 0u, 0u};
          if (row < len) {
            const size_t a = (size_t)(t0 + row) * 512 + h * 128 + c16 * 8;
            vq = *(const uint4*)(qd + a);
            vk = *(const uint4*)(kd + a);
          }
          *(uint4*)(sQ + row * 136 + c16 * 8) = vq;
          *(uint4*)(sK + row * 136 + c16 * 8) = vk;
        }
      }
      __syncthreads();
      if (ci + 1 < nch) GLA_ISSUE(c0 + ci + 1)
      if (passB) {
        f32x4 att[1][4];
#pragma unroll
        for (int nt = 0; nt < 4; ++nt) att[0][nt] = f32x4{0.f, 0.f, 0.f, 0.f};
        mma_lds<1, 4, 4>(att, sQ + (16 * wave) * 136, 136, sK, 136, r, q);
#pragma unroll
        for (int mt = 0; mt < 2; ++mt)
#pragma unroll
          for (int nt = 0; nt < 4; ++nt) {
            const int d0 = 32 * wave + mt * 16 + q * 4, v = nt * 16 + r;
            uint2 u;
            u.x = pack2(accS[mt][nt][0], accS[mt][nt][1]);
            u.y = pack2(accS[mt][nt][2], accS[mt][nt][3]);
            *(uint2*)(sS + v * 136 + d0) = u;
          }
        __syncthreads();
#pragma unroll
        for (int nt = 0; nt < 4; ++nt)
#pragma unroll
          for (int jj = 0; jj < 4; ++jj) {
            const int i = 16 * wave + q * 4 + jj, j = nt * 16 + r;
            sAtt[i * 72 + j] = f2bf(j <= i ? att[0][nt][jj] : 0.f);
          }
        __syncthreads();
        f32x4 o[1][4];
#pragma unroll
        for (int nt = 0; nt < 4; ++nt) o[0][nt] = f32x4{0.f, 0.f, 0.f, 0.f};
        mma_lds<1, 4, 2>(o, sAtt + (16 * wave) * 72, 72, sVT, 72, r, q);
        mma_lds<1, 4, 4>(o, sQ + (16 * wave) * 136, 136, sS, 136, r, q);
        float ss[4] = {0.f, 0.f, 0.f, 0.f};
#pragma unroll
        for (int nt = 0; nt < 4; ++nt)
#pragma unroll
          for (int jj = 0; jj < 4; ++jj) {
            const float ov = o[0][nt][jj];
            ss[jj] += ov * ov;
            const int i = 16 * wave + q * 4 + jj;
            if (i < len) obuf[(size_t)(t0 + i) * 1024 + h * 256 + sl * 64 + nt * 16 + r] = f2bf(ov);
          }
#pragma unroll
        for (int jj = 0; jj < 4; ++jj) {
          float s = ss[jj];
          s += __shfl_xor(s, 1);
          s += __shfl_xor(s, 2);
          s += __shfl_xor(s, 4);
          s += __shfl_xor(s, 8);
          const int i = 16 * wave + q * 4 + jj;
          if (r == 0 && i < len) ssq[(size_t)(t0 + i) * 16 + h * 4 + sl] = s;
        }
      }
      mma_lds<2, 4, 2>(accS, sKT + (32 * wave) * 72, 72, sVT, 72, r, q);
#pragma unroll
      for (int mt = 0; mt < 2; ++mt)
#pragma unroll
        for (int jj = 0; jj < 4; ++jj) {
          const float dec = dec8[mt * 4 + jj];
          dprod[mt * 4 + jj] *= dec;
#pragma unroll
          for (int nt = 0; nt < 4; ++nt) accS[mt][nt][jj] *= dec;
        }
    }
#undef GLA_ISSUE
    if (!passB && sl == 0 && r == 0) {
#pragma unroll
      for (int mt = 0; mt < 2; ++mt)
#pragma unroll
        for (int jj = 0; jj < 4; ++jj)
          ((float*)(P.ws + G_DSEG))[(size_t)sg * 512 + h * 128 + 32 * wave + mt * 16 + q * 4 + jj] = dprod[mt * 4 + jj];
    }
#pragma unroll
    for (int mt = 0; mt < 2; ++mt)
#pragma unroll
      for (int nt = 0; nt < 4; ++nt) {
        const int d0 = 32 * wave + mt * 16 + q * 4, v = sl * 64 + nt * 16 + r;
        if (!passB) {
          float4 t4;
          t4.x = accS[mt][nt][0]; t4.y = accS[mt][nt][1]; t4.z = accS[mt][nt][2]; t4.w = accS[mt][nt][3];
          *(float4*)(Sseg + ((size_t)(sg * 4 + h) * 256 + v) * 128 + d0) = t4;
        } else if (sg == NSEG_G - 1) {
#pragma unroll
          for (int jj = 0; jj < 4; ++jj)
            P.out[O_GLA_P + (((size_t)layer * 4 + h) * 128 + d0 + jj) * 256 + v] = accS[mt][nt][jj];
        } else if (sg >= NSEG_G) {
#pragma unroll
          for (int jj = 0; jj < 4; ++jj)
            P.out[O_GLA_S + ((((size_t)layer * 8 + b) * 4 + h) * 128 + d0 + jj) * 256 + v] = accS[mt][nt][jj];
        }
      }
  }
}

__device__ __forceinline__ void ph_gla_scan(const Params& P) {
  float* Sseg = (float*)(P.ws + G_SSEG);
  const float* dseg = (const float*)(P.ws + G_DSEG);
  for (int idx = blockIdx.x * 256 + otid(); idx < 4 * 256 * 128; idx += gridDim.x * 256) {
    const int h = idx >> 15, d = idx & 127;
    float cur = 0.f;
    for (int s = 0; s < NSEG_G; ++s) {
      const size_t a = (size_t)s * 131072 + idx;
      float tmp = 0.f, D = 0.f;
      if (s < NSEG_G - 1) {
        tmp = Sseg[a];
        D = dseg[(size_t)s * 512 + h * 128 + d];
      }
      Sseg[a] = cur;
      cur = D * cur + tmp;
    }
  }
}

__device__ __forceinline__ void ph_gla_aprep(const Params& P, int layer) {
  bf16_t* obuf = (bf16_t*)(P.ws + G_O);
  const bf16_t* g = (const bf16_t*)(P.ws + G_G);
  const float* ssq = (const float*)(P.ws + G_SSQ);
  const float* nw = P.in[12] + (size_t)layer * 256;
  for (int idx = blockIdx.x * 256 + otid(); idx < T * 128; idx += gridDim.x * 256) {
    const int t = idx >> 7, c8 = (idx & 127) * 8, hh = c8 >> 8;
    const float4 s4 = *(const float4*)(ssq + (size_t)t * 16 + hh * 4);
    const float rs = rsqrtf((s4.x + s4.y + s4.z + s4.w) * (1.f / 256.f) + EPS);
    const uint4 ov = *(const uint4*)(obuf + (size_t)t * 1024 + c8);
    const uint4 gv = *(const uint4*)(g + (size_t)t * 1024 + c8);
    const float4 w0 = *(const float4*)(nw + (c8 & 255));
    const float4 w1 = *(const float4*)(nw + (c8 & 255) + 4);
    uint4 res;
    res.x = pack2(lo_bf(ov.x) * rs * w0.x * silu_(lo_bf(gv.x)), hi_bf(ov.x) * rs * w0.y * silu_(hi_bf(gv.x)));
    res.y = pack2(lo_bf(ov.y) * rs * w0.z * silu_(lo_bf(gv.y)), hi_bf(ov.y) * rs * w0.w * silu_(hi_bf(gv.y)));
    res.z = pack2(lo_bf(ov.z) * rs * w1.x * silu_(lo_bf(gv.z)), hi_bf(ov.z) * rs * w1.y * silu_(hi_bf(gv.z)));
    res.w = pack2(lo_bf(ov.w) * rs * w1.z * silu_(lo_bf(gv.w)), hi_bf(ov.w) * rs * w1.w * silu_(hi_bf(gv.w)));
    *(uint4*)(obuf + (size_t)t * 1024 + c8) = res;
  }
}

__device__ __forceinline__ void ph_lru_pass(const bool passB, const Params& P, char* smem) {
  bf16_t* sRaw = (bf16_t*)smem;
  bf16_t* sXc = (bf16_t*)(smem + 11808);
  constexpr int SPS = 100, SPG = 64 * SPS;
  float* sP = (float*)(smem + 25120);
  float* sCst = (float*)(smem + 76320);
  const bf16_t* xb = (const bf16_t*)(P.ws + L_XB);
  const bf16_t* gate = (const bf16_t*)(P.ws + L_GATE);
  bf16_t* ybuf = (bf16_t*)(P.ws + L_Y);
  float* Asum = (float*)(P.ws + L_ASEG);
  float* Hsum = (float*)(P.ws + L_HSEG);
  const bf16_t* WG = (const bf16_t*)(P.ws + OFF_WG);
  const float* st_conv = P.in[3];
  const float* st_h = P.in[4];
  const int tid = otid(), lane = tid & 63, wave = tid >> 6, r = lane & 15, q = lane >> 4;
  const int NIT = NCH * 16;
  const int per = (NIT + (int)gridDim.x - 1) / (int)gridDim.x;
  const int it_lo = blockIdx.x * per;
  const int it_hi = it_lo + per < NIT ? it_lo + per : NIT;
  const int gt = wave >> 1, mh = wave & 1;
  int kprev = -1;
  bf16x8 bw[3][6];
#pragma unroll
  for (int ks = 0; ks < 3; ++ks)
#pragma unroll
    for (int nt = 0; nt < 6; ++nt) bw[ks][nt] = bf16x8{0, 0, 0, 0, 0, 0, 0, 0};
  const int cg8 = tid % 11, crow = tid / 11;
  const int gg4 = tid % 22, grow = tid / 22;
  float cw[5][8];
  float gc[3][4];
#pragma unroll
  for (int a_ = 0; a_ < 5; ++a_)
#pragma unroll
    for (int e = 0; e < 8; ++e) cw[a_][e] = 0.f;
#pragma unroll
  for (int a_ = 0; a_ < 3; ++a_)
#pragma unroll
    for (int e = 0; e < 4; ++e) gc[a_][e] = 0.f;
  for (int idx = tid; idx < 64 * 8; idx += 256) sXc[(idx >> 3) * 104 + 88 + (idx & 7)] = 0;
  for (int it = it_lo; it < it_hi; ++it) {
    const int k = it / NCH, c = it - k * NCH;
    int t0, len;
    chunk_info(c, t0, len);
    const int b = c - 256;
    const bool has_prev = (c < 256) && (c > 0);
    const int ch = k * 88 + tid;
    u32x4 rraw[3], rgate[3];
#pragma unroll
    for (int i = 0; i < 3; ++i) {
      const int idx = tid + 256 * i, row = idx / 11, c16 = idx - row * 11;
      rraw[i] = u32x4{0u, 0u, 0u, 0u};
      rgate[i] = u32x4{0u, 0u, 0u, 0u};
      if (row < len + 3) {
        if (row >= 3 || has_prev) {
          rraw[i] = *(const u32x4*)(xb + (size_t)(t0 + row - 3) * LW + k * 88 + c16 * 8);
        } else if (c >= 256) {
          const float* sp = st_conv + ((size_t)b * 3 + row) * LW + k * 88 + c16 * 8;
          const float4 f0 = *(const float4*)sp, f1 = *(const float4*)(sp + 4);
          rraw[i] = u32x4{pack2(f0.x, f0.y), pack2(f0.z, f0.w), pack2(f1.x, f1.y), pack2(f1.z, f1.w)};
        }
      }
      if (passB && row < len) rgate[i] = *(const u32x4*)(gate + (size_t)(t0 + row) * LW + k * 88 + c16 * 8);
    }
    float hcur = 0.f, aprod = 1.f;
    if (passB && tid < 88) hcur = c < 256 ? Hsum[(size_t)c * LW + ch] : st_h[b * LW + ch];
    __syncthreads();
    if (k != kprev) {
      if (tid < 88) {
        sCst[0 * 96 + tid] = -8.f * softplus_(-P.in[21][ch]);
        sCst[1 * 96 + tid] = P.in[18][ch];
        sCst[2 * 96 + tid] = P.in[20][ch];
        sCst[3 * 96 + tid] = P.in[16][ch];
        sCst[4 * 96 + tid] = P.in[15][0 * LW + ch];
        sCst[5 * 96 + tid] = P.in[15][1 * LW + ch];
        sCst[6 * 96 + tid] = P.in[15][2 * LW + ch];
        sCst[7 * 96 + tid] = P.in[15][3 * LW + ch];
      }
      const bf16_t* Wt = WG + ((size_t)(gt * 16 + k) * 96) * 96;
#pragma unroll
      for (int ks = 0; ks < 3; ++ks)
#pragma unroll
        for (int nt = 0; nt < 6; ++nt) bw[ks][nt] = *(const bf16x8*)(Wt + (nt * 16 + r) * 96 + ks * 32 + q * 8);
    }
#pragma unroll
    for (int i = 0; i < 3; ++i) {
      const int idx = tid + 256 * i, row = idx / 11, c16 = idx - row * 11;
      if (row < 67) *(u32x4*)(sRaw + row * 88 + c16 * 8) = rraw[i];
    }
    __syncthreads();
    if (k != kprev) {
#pragma unroll
      for (int a_ = 0; a_ < 5; ++a_)
#pragma unroll
        for (int e = 0; e < 8; ++e) cw[a_][e] = sCst[(3 + a_) * 96 + cg8 * 8 + e];
#pragma unroll
      for (int a_ = 0; a_ < 3; ++a_)
#pragma unroll
        for (int e = 0; e < 4; ++e) gc[a_][e] = sCst[a_ * 96 + gg4 * 4 + e];
      kprev = k;
    }
    if (crow < 23) {
#pragma unroll
      for (int i = 0; i < 3; ++i) {
        const int j = crow + 23 * i;
        if (j < 64) {
          u32x4 o = u32x4{0u, 0u, 0u, 0u};
          if (j < len) {
            u32x4 rr[4];
#pragma unroll
            for (int kk = 0; kk < 4; ++kk) rr[kk] = *(const u32x4*)(sRaw + (j + kk) * 88 + cg8 * 8);
            float xc[8];
#pragma unroll
            for (int e = 0; e < 8; ++e) {
              float acc_ = cw[0][e];
#pragma unroll
              for (int kk = 0; kk < 4; ++kk) {
                const unsigned w_ = rr[kk][e >> 1];
                acc_ += cw[1 + kk][e] * ((e & 1) ? hi_bf(w_) : lo_bf(w_));
              }
              xc[e] = acc_;
            }
            o = u32x4{pack2(xc[0], xc[1]), pack2(xc[2], xc[3]), pack2(xc[4], xc[5]), pack2(xc[6], xc[7])};
          }
          *(u32x4*)(sXc + j * 104 + cg8 * 8) = o;
        }
      }
    }
    __syncthreads();
    {
      f32x4 acc[2][6];
#pragma unroll
      for (int mt = 0; mt < 2; ++mt)
#pragma unroll
        for (int nt = 0; nt < 6; ++nt) acc[mt][nt] = f32x4{0.f, 0.f, 0.f, 0.f};
#pragma unroll
      for (int ks = 0; ks < 3; ++ks) {
        bf16x8 af[2];
#pragma unroll
        for (int mt = 0; mt < 2; ++mt) af[mt] = *(const bf16x8*)(sXc + (32 * mh + mt * 16 + r) * 104 + ks * 32 + q * 8);
#pragma unroll
        for (int mt = 0; mt < 2; ++mt)
#pragma unroll
          for (int nt = 0; nt < 6; ++nt)
            acc[mt][nt] = __builtin_amdgcn_mfma_f32_16x16x32_bf16(bw[ks][nt], af[mt], acc[mt][nt], 0, 0, 0);
      }
#pragma unroll
      for (int mt = 0; mt < 2; ++mt)
#pragma unroll
        for (int nt = 0; nt < 6; ++nt)
          *(f32x4*)(sP + gt * SPG + (32 * mh + mt * 16 + r) * SPS + nt * 16 + q * 4) = acc[mt][nt];
    }
    __syncthreads();
    if (grow < 11) {
#pragma unroll
      for (int i = 0; i < 6; ++i) {
        const int j = grow + 11 * i;
        if (j < len) {
          const f32x4 pr = *(const f32x4*)(sP + j * SPS + gg4 * 4);
          const f32x4 pi = *(const f32x4*)(sP + SPG + j * SPS + gg4 * 4);
          const uint2 xu = *(const uint2*)(sXc + j * 104 + gg4 * 4);
          float xv[4];
          xv[0] = lo_bf(xu.x); xv[1] = hi_bf(xu.x); xv[2] = lo_bf(xu.y); xv[3] = hi_bf(xu.y);
          f32x4 av, uv;
#pragma unroll
          for (int e = 0; e < 4; ++e) {
            const float rr_ = sigmoid_(pr[e] + gc[1][e]), ii_ = sigmoid_(pi[e] + gc[2][e]);
            const float a = __expf(gc[0][e] * rr_);
            const float m = __builtin_amdgcn_sqrtf(fmaxf(1.f - a * a, 0.f));
            av[e] = a;
            uv[e] = m * ii_ * xv[e];
          }
          *(f32x4*)(sP + j * SPS + gg4 * 4) = av;
          *(f32x4*)(sP + SPG + j * SPS + gg4 * 4) = uv;
        }
      }
    }
    __syncthreads();
    if (tid < 88) {
#pragma unroll 8
      for (int j = 0; j < len; ++j) {
        const float a = sP[j * SPS + tid], u = sP[SPG + j * SPS + tid];
        hcur = a * hcur + u;
        aprod *= a;
        if (passB) sP[SPG + j * SPS + tid] = hcur;
      }
      if (!passB) {
        Asum[(size_t)c * LW + ch] = aprod;
        Hsum[(size_t)c * LW + ch] = hcur;
      } else if (c == 255) {
        P.out[O_LH_P + ch] = hcur;
#pragma unroll
        for (int kk = 0; kk < 3; ++kk) P.out[O_LCONV_P + kk * LW + ch] = bf2f(sRaw[(len + kk) * 88 + tid]);
      } else if (c >= 256) {
        P.out[O_LH_S + b * LW + ch] = hcur;
#pragma unroll
        for (int kk = 0; kk < 3; ++kk) P.out[O_LCONV_S + ((size_t)b * 3 + kk) * LW + ch] = bf2f(sRaw[(len + kk) * 88 + tid]);
      }
    }
    if (passB) {
      __syncthreads();
#pragma unroll
      for (int i = 0; i < 3; ++i) {
        const int idx = tid + 256 * i, row = idx / 11, c16 = idx - row * 11;
        if (row < len) {
          const float4 h0 = *(const float4*)(sP + SPG + row * SPS + c16 * 8);
          const float4 h1 = *(const float4*)(sP + SPG + row * SPS + c16 * 8 + 4);
          const u32x4 gv = rgate[i];
          u32x4 o;
          o[0] = pack2(h0.x * silu_(lo_bf(gv[0])), h0.y * silu_(hi_bf(gv[0])));
          o[1] = pack2(h0.z * silu_(lo_bf(gv[1])), h0.w * silu_(hi_bf(gv[1])));
          o[2] = pack2(h1.x * silu_(lo_bf(gv[2])), h1.y * silu_(hi_bf(gv[2])));
          o[3] = pack2(h1.z * silu_(lo_bf(gv[3])), h1.w * silu_(hi_bf(gv[3])));
          *(u32x4*)(ybuf + (size_t)(t0 + row) * LW + k * 88 + c16 * 8) = o;
        }
      }
    }
  }
}

__device__ __forceinline__ void ph_lru_scan(const Params& P, char* smem) {
  float* sA = (float*)smem;
  float* sH = sA + 256;
  const float* Asum = (const float*)(P.ws + L_ASEG);
  float* Hsum = (float*)(P.ws + L_HSEG);
  const int tid = otid(), seg = tid >> 4, chl = tid & 15;
  for (int it = blockIdx.x; it < LW / 16; it += gridDim.x) {
    const int ch = it * 16 + chl;
    float a[16], h[16];
#pragma unroll
    for (int i = 0; i < 16; ++i) {
      a[i] = Asum[(size_t)(seg * 16 + i) * LW + ch];
      h[i] = Hsum[(size_t)(seg * 16 + i) * LW + ch];
    }
    float A = 1.f, H = 0.f;
#pragma unroll
    for (int i = 0; i < 16; ++i) { H = a[i] * H + h[i]; A *= a[i]; }
    __syncthreads();
    sA[seg * 16 + chl] = A;
    sH[seg * 16 + chl] = H;
    __syncthreads();
    float hin = 0.f;
    for (int s2 = 0; s2 < seg; ++s2) hin = sA[s2 * 16 + chl] * hin + sH[s2 * 16 + chl];
#pragma unroll
    for (int i = 0; i < 16; ++i) {
      Hsum[(size_t)(seg * 16 + i) * LW + ch] = hin;
      hin = a[i] * hin + h[i];
    }
  }
}

__device__ __forceinline__ void ph_ssd_conv(const Params& P) {
  bf16_t* xbcT = (bf16_t*)(P.ws + S_XBCT);
  const bf16_t* tails = (const bf16_t*)(P.ws + S_TAIL);
  bf16_t* Brm = (bf16_t*)(P.ws + S_BRM);
  bf16_t* Crm = (bf16_t*)(P.ws + S_CRM);
  const float* cw = P.in[24];
  const float* cb = P.in[25];
  const float* st_conv = P.in[5];
  const int tid = otid();
  for (int it = blockIdx.x; it < NCH * 12; it += gridDim.x) {
    const int c = it / 12, part = it - c * 12, cc = part * 256 + tid;
    int t0, len;
    chunk_info(c, t0, len);
    const float w0 = cw[cc], w1 = cw[3072 + cc], w2 = cw[2 * 3072 + cc], w3 = cw[3 * 3072 + cc], bias = cb[cc];
    float a0 = 0.f, a1 = 0.f, a2 = 0.f;
    if (c >= 256) {
      const int b = c - 256;
      a0 = st_conv[((size_t)b * 3 + 0) * 3072 + cc];
      a1 = st_conv[((size_t)b * 3 + 1) * 3072 + cc];
      a2 = st_conv[((size_t)b * 3 + 2) * 3072 + cc];
    } else if (c > 0) {
      const uint2 tv = *(const uint2*)(tails + ((size_t)(c - 1) * 3072 + cc) * 4);
      a0 = hi_bf(tv.x); a1 = lo_bf(tv.y); a2 = hi_bf(tv.y);
    }
    bf16_t* rowp = xbcT + ((size_t)c * 3072 + cc) * 64;
    bf16_t* rm = nullptr;
    if (cc >= 2560) rm = Crm + (cc - 2560);
    else if (cc >= 2048) rm = Brm + (cc - 2048);
    u32x4 rw[8];
#pragma unroll
    for (int g = 0; g < 8; ++g) {
      rw[g] = u32x4{0u, 0u, 0u, 0u};
      if (g * 8 < len) rw[g] = *(const u32x4*)(rowp + g * 8);
    }
#pragma unroll
    for (int g = 0; g < 8; ++g) {
      if (g * 8 < len) {
        const int g8 = g * 8;
        const u32x4 u = rw[g];
        float x[8], y[8];
        x[0] = lo_bf(u[0]); x[1] = hi_bf(u[0]); x[2] = lo_bf(u[1]); x[3] = hi_bf(u[1]);
        x[4] = lo_bf(u[2]); x[5] = hi_bf(u[2]); x[6] = lo_bf(u[3]); x[7] = hi_bf(u[3]);
#pragma unroll
        for (int e = 0; e < 8; ++e) {
          const float yy = bias + w0 * a0 + w1 * a1 + w2 * a2 + w3 * x[e];
          a0 = a1; a1 = a2; a2 = x[e];
          y[e] = silu_(yy);
        }
        *(u32x4*)(rowp + g8) = u32x4{pack2(y[0], y[1]), pack2(y[2], y[3]), pack2(y[4], y[5]), pack2(y[6], y[7])};
        if (rm) {
#pragma unroll
          for (int e = 0; e < 8; ++e) rm[(size_t)(t0 + g8 + e) * 512] = f2bf(y[e]);
        }
      }
    }
    if (c >= 255) {
      const uint2 tv = *(const uint2*)(tails + ((size_t)c * 3072 + cc) * 4);
      float* dst = c == 255 ? P.out + O_SCONV_P : P.out + O_SCONV_S + (size_t)(c - 256) * 3 * 3072;
      dst[0 * 3072 + cc] = hi_bf(tv.x);
      dst[1 * 3072 + cc] = lo_bf(tv.y);
      dst[2 * 3072 + cc] = hi_bf(tv.y);
    }
  }
}

__device__ __forceinline__ void ph_ssd_pass(const bool passB, const Params& P, char* smem) {
  bf16_t* sC = (bf16_t*)(smem);
  bf16_t* sBT = (bf16_t*)(smem + 17408);
  bf16_t* sXT = (bf16_t*)(smem + 35840);
  bf16_t* sS = (bf16_t*)(smem + 45056);
  bf16_t* sXW = (bf16_t*)(smem + 62464);
  bf16_t* sW = (bf16_t*)(smem + 71680);
  bf16_t* sB = sXW;
  float* sCum = (float*)(smem + 80896);
  float* sDt = sCum + 64;
  bf16_t* zbuf = (bf16_t*)(P.ws + S_Z);
  const bf16_t* xbcT = (const bf16_t*)(P.ws + S_XBCT);
  const bf16_t* Brm = (const bf16_t*)(P.ws + S_BRM);
  const bf16_t* Crm = (const bf16_t*)(P.ws + S_CRM);
  const float* dtb = (const float*)(P.ws + S_DT);
  float* ssq = (float*)(P.ws + S_SSQ);
  float* Sseg = (float*)(P.ws + S_SSEG);
  float* cdseg = (float*)(P.ws + S_CDSEG);
  const float* st_in = P.in[6];
  const int tid = otid(), lane = tid & 63, wave = tid >> 6, r = lane & 15, q = lane >> 4;
  const int nitems = passB ? NSEGT_S * 32 : (NSEG_S - 1) * 32;
  for (int it = blockIdx.x; it < nitems; it += gridDim.x) {
    const int sg = it >> 5, hd = it & 31, g = hd >> 3;
    int c0, nch, b;
    seg_info(sg, NSEG_S, c0, nch, b);
    const float Ah = -__expf(P.in[27][hd]);
    const float Dh = P.in[28][hd];
    f32x4 accS[2][4];
#pragma unroll
    for (int mt = 0; mt < 2; ++mt)
#pragma unroll
      for (int nt = 0; nt < 4; ++nt) {
        const int s0 = 32 * wave + mt * 16 + q * 4, p = nt * 16 + r;
        if (!passB) accS[mt][nt] = f32x4{0.f, 0.f, 0.f, 0.f};
        else {
          const float* src = sg < NSEG_S ? Sseg + (((size_t)sg * 32 + hd) * 64 + p) * 128 + s0
                                       : st_in + (((size_t)b * 32 + hd) * 64 + p) * 128 + s0;
          const float4 t4 = *(const float4*)src;
          accS[mt][nt] = f32x4{t4.x, t4.y, t4.z, t4.w};
        }
      }
    float totcum = 0.f;
    u32x4 pb[4], px[2];
    float pdt = 0.f;
    const float dtbias = P.in[26][hd];
#define SSD_ISSUE(cc_)                                                                                          \
  {                                                                                                             \
    const int cx_ = (cc_);                                                                                      \
    const int lenx_ = cx_ < 256 ? 64 : 16;                                                                      \
    const int t0x_ = cx_ < 256 ? cx_ * 64 : T_P + (cx_ - 256) * 16;                                             \
    _Pragma("unroll") for (int i = 0; i < 4; ++i) {                                                             \
      const int id = tid + 256 * i, row = id >> 3, c16 = id & 7;                                                \
      pb[i] = u32x4{0u, 0u, 0u, 0u};                                                                            \
      if (c16 * 8 < lenx_) pb[i] = *(const u32x4*)(xbcT + ((size_t)cx_ * 3072 + 2048 + g * 128 + row) * 64 + c16 * 8); \
    }                                                                                                           \
    _Pragma("unroll") for (int i = 0; i < 2; ++i) {                                                             \
      const int id = tid + 256 * i, row = id >> 3, c16 = id & 7;                                                \
      px[i] = u32x4{0u, 0u, 0u, 0u};                                                                            \
      if (c16 * 8 < lenx_) px[i] = *(const u32x4*)(xbcT + ((size_t)cx_ * 3072 + hd * 64 + row) * 64 + c16 * 8);  \
    }                                                                                                           \
    pdt = 0.f;                                                                                                  \
    if (wave == 0 && lane < lenx_) pdt = dtb[(size_t)(t0x_ + lane) * 32 + hd];                                  \
  }
    SSD_ISSUE(c0)
    for (int ci = 0; ci < nch; ++ci) {
      const int c = c0 + ci;
      int t0, len;
      chunk_info(c, t0, len);
      __syncthreads();
      if (wave == 0) {
        const float dtv = lane < len ? softplus_(pdt + dtbias) : 0.f;
        float x = dtv * Ah;
#pragma unroll
        for (int off = 1; off < 64; off <<= 1) {
          const float y = __shfl_up(x, off);
          if (lane >= off) x += y;
        }
        sCum[lane] = x;
        sDt[lane] = dtv;
      }
#pragma unroll
      for (int i = 0; i < 4; ++i) {
        const int id = tid + 256 * i, row = id >> 3, c16 = id & 7;
        *(u32x4*)(sBT + row * 72 + c16 * 8) = pb[i];
      }
#pragma unroll
      for (int i = 0; i < 2; ++i) {
        const int id = tid + 256 * i, row = id >> 3, c16 = id & 7;
        *(u32x4*)(sXT + row * 72 + c16 * 8) = px[i];
      }
      if (passB) {
#pragma unroll
        for (int i = 0; i < 4; ++i) {
          const int id = tid + 256 * i, row = id >> 4, c16 = id & 15;
          uint4 vc = uint4{0u, 0u, 0u, 0u}, vb = uint4{0u, 0u, 0u, 0u};
          if (row < len) {
            const size_t a = (size_t)(t0 + row) * 512 + g * 128 + c16 * 8;
            vc = *(const uint4*)(Crm + a);
            vb = *(const uint4*)(Brm + a);
          }
          *(uint4*)(sC + row * 136 + c16 * 8) = vc;
          *(uint4*)(sB + row * 136 + c16 * 8) = vb;
        }
      }
      __syncthreads();
      if (ci + 1 < nch) SSD_ISSUE(c0 + ci + 1)
      const float cumlast = sCum[63];
      f32x4 cbm[1][4];
      if (passB) {
#pragma unroll
        for (int nt = 0; nt < 4; ++nt) cbm[0][nt] = f32x4{0.f, 0.f, 0.f, 0.f};
        mma_lds<1, 4, 4>(cbm, sC + (16 * wave) * 136, 136, sB, 136, r, q);
#pragma unroll
        for (int mt = 0; mt < 2; ++mt)
#pragma unroll
          for (int nt = 0; nt < 4; ++nt) {
            const int s0 = 32 * wave + mt * 16 + q * 4, p = nt * 16 + r;
            uint2 u;
            u.x = pack2(accS[mt][nt][0], accS[mt][nt][1]);
            u.y = pack2(accS[mt][nt][2], accS[mt][nt][3]);
            *(uint2*)(sS + p * 136 + s0) = u;
          }
        __syncthreads();
#pragma unroll
        for (int nt = 0; nt < 4; ++nt)
#pragma unroll
          for (int jj = 0; jj < 4; ++jj) {
            const int i = 16 * wave + q * 4 + jj, j = nt * 16 + r;
            float wv = 0.f;
            if (j <= i) wv = cbm[0][nt][jj] * __expf(sCum[i] - sCum[j]) * sDt[j];
            sW[i * 72 + j] = f2bf(wv);
          }
      }
#pragma unroll
      for (int i = 0; i < 2; ++i) {
        const int id = tid + 256 * i, p = id >> 3, j0 = (id & 7) * 8;
        const uint4 u = *(const uint4*)(sXT + p * 72 + j0);
        float wb[8];
#pragma unroll
        for (int e = 0; e < 8; ++e) wb[e] = __expf(cumlast - sCum[j0 + e]) * sDt[j0 + e];
        uint4 o;
        o.x = pack2(lo_bf(u.x) * wb[0], hi_bf(u.x) * wb[1]);
        o.y = pack2(lo_bf(u.y) * wb[2], hi_bf(u.y) * wb[3]);
        o.z = pack2(lo_bf(u.z) * wb[4], hi_bf(u.z) * wb[5]);
        o.w = pack2(lo_bf(u.w) * wb[6], hi_bf(u.w) * wb[7]);
        *(uint4*)(sXW + p * 72 + j0) = o;
      }
      __syncthreads();
      if (passB) {
        f32x4 y1[1][4], y2[1][4];
#pragma unroll
        for (int nt = 0; nt < 4; ++nt) { y1[0][nt] = f32x4{0.f, 0.f, 0.f, 0.f}; y2[0][nt] = f32x4{0.f, 0.f, 0.f, 0.f}; }
        mma_lds<1, 4, 2>(y1, sW + (16 * wave) * 72, 72, sXT, 72, r, q);
        mma_lds<1, 4, 4>(y2, sC + (16 * wave) * 136, 136, sS, 136, r, q);
        float ss[4] = {0.f, 0.f, 0.f, 0.f};
        float ec[4];
#pragma unroll
        for (int jj = 0; jj < 4; ++jj) ec[jj] = __expf(sCum[16 * wave + q * 4 + jj]);
#pragma unroll
        for (int nt = 0; nt < 4; ++nt) {
          const int p = nt * 16 + r;
          const uint2 xu = *(const uint2*)(sXT + p * 72 + 16 * wave + q * 4);
          float xv[4];
          xv[0] = lo_bf(xu.x); xv[1] = hi_bf(xu.x); xv[2] = lo_bf(xu.y); xv[3] = hi_bf(xu.y);
#pragma unroll
          for (int jj = 0; jj < 4; ++jj) {
            const int i = 16 * wave + q * 4 + jj;
            if (i < len) {
              const float yv = y1[0][nt][jj] + ec[jj] * y2[0][nt][jj] + Dh * xv[jj];
              const size_t a = (size_t)(t0 + i) * 2048 + hd * 64 + p;
              const float yz = yv * silu_(bf2f(zbuf[a]));
              zbuf[a] = f2bf(yz);
              ss[jj] += yz * yz;
            }
          }
        }
#pragma unroll
        for (int jj = 0; jj < 4; ++jj) {
          float s = ss[jj];
          s += __shfl_xor(s, 1);
          s += __shfl_xor(s, 2);
          s += __shfl_xor(s, 4);
          s += __shfl_xor(s, 8);
          const int i = 16 * wave + q * 4 + jj;
          if (r == 0 && i < len) ssq[(size_t)(t0 + i) * 32 + hd] = s;
        }
      }
      {
        const float cd = __expf(cumlast);
#pragma unroll
        for (int mt = 0; mt < 2; ++mt)
#pragma unroll
          for (int nt = 0; nt < 4; ++nt)
#pragma unroll
            for (int jj = 0; jj < 4; ++jj) accS[mt][nt][jj] *= cd;
        mma_lds<2, 4, 2>(accS, sBT + (32 * wave) * 72, 72, sXW, 72, r, q);
        totcum += cumlast;
      }
    }
#pragma unroll
    for (int mt = 0; mt < 2; ++mt)
#pragma unroll
      for (int nt = 0; nt < 4; ++nt) {
        const int s0 = 32 * wave + mt * 16 + q * 4, p = nt * 16 + r;
        float4 t4;
        t4.x = accS[mt][nt][0]; t4.y = accS[mt][nt][1]; t4.z = accS[mt][nt][2]; t4.w = accS[mt][nt][3];
        if (!passB) *(float4*)(Sseg + (((size_t)sg * 32 + hd) * 64 + p) * 128 + s0) = t4;
        else if (sg == NSEG_S - 1) *(float4*)(P.out + O_SH_P + ((size_t)hd * 64 + p) * 128 + s0) = t4;
        else if (sg >= NSEG_S) *(float4*)(P.out + O_SH_S + (((size_t)b * 32 + hd) * 64 + p) * 128 + s0) = t4;
      }
#undef SSD_ISSUE
    if (!passB && tid == 0) cdseg[sg * 32 + hd] = __expf(totcum);
  }
}

__device__ __forceinline__ void ph_ssd_scan(const Params& P) {
  float* Sseg = (float*)(P.ws + S_SSEG);
  const float* cdseg = (const float*)(P.ws + S_CDSEG);
  for (int idx = blockIdx.x * 256 + otid(); idx < 32 * 64 * 128; idx += gridDim.x * 256) {
    const int hd = idx >> 13;
    float cur = 0.f;
    for (int s = 0; s < NSEG_S; ++s) {
      const size_t a = (size_t)s * 262144 + idx;
      float tmp = 0.f, D = 0.f;
      if (s < NSEG_S - 1) { tmp = Sseg[a]; D = cdseg[s * 32 + hd]; }
      Sseg[a] = cur;
      cur = D * cur + tmp;
    }
  }
}

constexpr size_t OFF_BAR = 268435456ull - 4096;
#define XB_CNT(x) (32 + 32 * (x))
#define XB_SUB(x) (320 + 32 * (x))
#define XB_GEN(x) (608 + 32 * (x))
#define XB_TOP 896
#define XB_TOPGEN 928
__device__ __forceinline__ unsigned xb_ld(unsigned* p) { return __hip_atomic_load(p, __ATOMIC_RELAXED, __HIP_MEMORY_SCOPE_AGENT); }
__device__ __forceinline__ unsigned xb_add(unsigned* p, unsigned v) { return __hip_atomic_fetch_add(p, v, __ATOMIC_RELAXED, __HIP_MEMORY_SCOPE_AGENT); }
__device__ __forceinline__ void grid_barrier(unsigned* bar, char* smem) {
  asm volatile("s_waitcnt vmcnt(0)" ::: "memory");
  __syncthreads();
  if (otid() == 0) {
    volatile unsigned* st = (volatile unsigned*)(smem + SMEM_XB);
    const unsigned x = st[2];
    unsigned nloc = st[0], nx = st[1];
    if (nloc == 0u) {
      const unsigned G = gridDim.x;
      for (;;) {
        unsigned sum = 0u, cnt = 0u, mine = 0u;
#pragma unroll
        for (unsigned j = 0; j < 8; ++j) {
          const unsigned c = xb_ld(&bar[XB_CNT(j)]);
          sum += c;
          cnt += (c > 0u) ? 1u : 0u;
          mine = (j == x) ? c : mine;
        }
        if (sum == G) { nloc = mine; nx = cnt; break; }
        __builtin_amdgcn_s_sleep(1);
      }
      st[0] = nloc;
      st[1] = nx;
    }
    const unsigned old = xb_add(&bar[XB_SUB(x)], 1u);
    const unsigned gen = old / nloc;
    if (old + 1u == (gen + 1u) * nloc) {
      __builtin_amdgcn_fence(__ATOMIC_RELEASE, "agent");
      asm volatile("s_waitcnt vmcnt(0)" ::: "memory");
      const unsigned og = xb_add(&bar[XB_TOP], 1u);
      const unsigned tg = og / nx;
      if (og + 1u == (tg + 1u) * nx) xb_add(&bar[XB_TOPGEN], 1u);
      else while (xb_ld(&bar[XB_TOPGEN]) == tg) __builtin_amdgcn_s_sleep(1);
      __builtin_amdgcn_fence(__ATOMIC_ACQUIRE, "agent");
      xb_add(&bar[XB_GEN(x)], 1u);
      asm volatile("s_waitcnt vmcnt(0)" ::: "memory");
    } else {
      while (xb_ld(&bar[XB_GEN(x)]) == gen) __builtin_amdgcn_s_sleep(1);
      __builtin_amdgcn_fence(__ATOMIC_ACQUIRE, "agent");
      asm volatile("s_waitcnt vmcnt(0)" ::: "memory");
    }
  }
  __syncthreads();
}

constexpr int NPH = 30;

__device__ __forceinline__ void run_gla(const int sub, const int layer, const int li, const Params& P, char* smem) {
  const float* xin_p = li == 0 ? P.in[0] : P.out + O_YP;
  const float* xin_s = li == 0 ? P.in[1] : P.out + O_YS;
  bf16_t* Win = (bf16_t*)(P.ws + OFF_WIN);
  bf16_t* Wout = (bf16_t*)(P.ws + (layer == 0 ? OFF_WOUT : OFF_WOUT1));
  bf16_t* H = (bf16_t*)(P.ws + OFF_H);
  switch (sub) {
    case 0:
      if (li == 0) {
        ph_convT(P.in[9], 1024, 3088, 3136, Win, nullptr, smem);
        ph_convT(P.in[13], 1024, 1024, 1024, Wout, nullptr, smem);
      }
      ph_norm(xin_p, xin_s, P.in[7] + li * 1024, H, li == 0 ? P.out : nullptr);
      break;
    case 1: {
      EpiGlaIn e{(bf16_t*)(P.ws + G_QD), (bf16_t*)(P.ws + G_KD), (bf16_t*)(P.ws + G_VT), (bf16_t*)(P.ws + G_G),
                 (float*)(P.ws + G_GLR)};
      gemm_phase(H, 1024, Win, 1024, 1024, 3088, e, smem);
    } break;
    case 2: ph_gla_prep(P, layer, smem); break;
    case 3: ph_gla_pass(false, layer, P, smem); break;
    case 4:
      ph_gla_scan(P);
      if (layer == 0) {
        ph_convT(P.in[14], 1024, 2816, 2816, Win, nullptr, smem);
        ph_convT(P.in[22], 1408, 1024, 1024, (bf16_t*)(P.ws + OFF_WOUT1), nullptr, smem);
        ph_conv_gate(P.in[17], (bf16_t*)(P.ws + OFF_WG));
        ph_conv_gate(P.in[19], (bf16_t*)(P.ws + OFF_WG) + 16 * 96 * 96);
      }
      break;
    case 5: ph_gla_pass(true, layer, P, smem); break;
    case 6: ph_gla_aprep(P, layer); break;
    case 7: {
      EpiResid e{xin_p, xin_s, P.out};
      gemm_phase((const bf16_t*)(P.ws + G_O), 1024, Wout, 1024, 1024, 1024, e, smem);
    } break;
  }
}

__device__ __forceinline__ void run_phase(const int ph, const Params& P, char* smem) {
  bf16_t* Win = (bf16_t*)(P.ws + OFF_WIN);
  bf16_t* Wout = (bf16_t*)(P.ws + OFF_WOUT);
  bf16_t* H = (bf16_t*)(P.ws + OFF_H);
  const float* xin_p = P.out + O_YP;
  const float* xin_s = P.out + O_YS;
  if (ph < 8) { run_gla(ph, 0, 0, P, smem); return; }
  if (ph >= 21 && ph < 29) { run_gla(ph - 21, 1, 3, P, smem); return; }
  switch (ph) {
    case 8:
      ph_norm(xin_p, xin_s, P.in[7] + 1 * 1024, H, nullptr);
      break;
    case 9: {
      EpiLruIn e{(bf16_t*)(P.ws + L_XB), (bf16_t*)(P.ws + L_GATE)};
      gemm_phase(H, 1024, Win, 1024, 1024, 2816, e, smem);
    } break;
    case 10: ph_lru_pass(false, P, smem); break;
    case 11:
      ph_lru_scan(P, smem);
      ph_convT(P.in[23], 1024, 5152, 5184, Win, nullptr, smem);
      ph_convT(P.in[30], 2048, 1024, 1024, Wout, P.in[29], smem);
      break;
    case 12: ph_lru_pass(true, P, smem); break;
    case 13: {
      EpiResid e{xin_p, xin_s, P.out};
      gemm_phase((const bf16_t*)(P.ws + L_Y), LW, (const bf16_t*)(P.ws + OFF_WOUT1), LW, LW, 1024, e, smem);
    } break;
    case 14:
      ph_norm(xin_p, xin_s, P.in[7] + 2 * 1024, H, nullptr);
      break;
    case 15: {
      EpiSsdIn e{(bf16_t*)(P.ws + S_Z), (bf16_t*)(P.ws + S_XBCT), (bf16_t*)(P.ws + S_TAIL), (float*)(P.ws + S_DT), P.in[26]};
      gemm_phase(H, 1024, Win, 1024, 1024, 5152, e, smem);
    } break;
    case 16: ph_ssd_conv(P); break;
    case 17: ph_ssd_pass(false, P, smem); break;
    case 18:
      ph_ssd_scan(P);
      ph_convT(P.in[9] + (size_t)1024 * 3088, 1024, 3088, 3136, Win, nullptr, smem);
      ph_convT(P.in[13] + (size_t)1024 * 1024, 1024, 1024, 1024, (bf16_t*)(P.ws + OFF_WOUT1), nullptr, smem);
      break;
    case 19: ph_ssd_pass(true, P, smem); break;
    case 20: {
      EpiResidScaled e{xin_p, xin_s, P.out, (const float*)(P.ws + S_SSQ), 0.f, 0.f, 0};
      gemm_phase((const bf16_t*)(P.ws + S_Z), 2048, Wout, 2048, 2048, 1024, e, smem);
    } break;
    case 29: ph_final_norm(P.out, P.in[8]); break;
    default: break;
  }
}

__global__ void __launch_bounds__(256, 2) mega(Params P) {
  __shared__ __attribute__((aligned(16))) char smem[SMEM_BYTES];
  unsigned* bar = (unsigned*)(P.ws + OFF_BAR);
  if (threadIdx.x == 0) {
    const unsigned xcc = (unsigned)__builtin_amdgcn_s_getreg((3 << 11) | 20) & 7u;
    (void)xb_add(&bar[XB_CNT(xcc)], 1u);
    volatile unsigned* st = (volatile unsigned*)(smem + SMEM_XB);
    st[0] = 0u; st[1] = 0u; st[2] = xcc;
  }
  __syncthreads();
  if (P.out == nullptr) cg::this_grid().sync();
#define PRE(n) if (PREMASK & (1u << (n))) { run_phase((n), P, smem); grid_barrier(bar, smem); }
  PRE(0) PRE(1) PRE(2) PRE(3) PRE(4) PRE(5) PRE(6) PRE(7) PRE(8) PRE(9)
  PRE(10) PRE(11) PRE(12) PRE(13) PRE(14) PRE(15) PRE(16) PRE(17) PRE(18) PRE(19)
  PRE(20) PRE(21) PRE(22) PRE(23) PRE(24) PRE(25) PRE(26) PRE(27) PRE(28) PRE(29)
#undef PRE
#define PHASE(n) { if ((n) > 0 || PREMASK) grid_barrier(bar, smem); run_phase((n), P, smem); if (DUPMASK & (1u << (n))) { grid_barrier(bar, smem); run_phase((n), P, smem); } }
  PHASE(0) PHASE(1) PHASE(2) PHASE(3) PHASE(4) PHASE(5) PHASE(6) PHASE(7) PHASE(8) PHASE(9)
  PHASE(10) PHASE(11) PHASE(12) PHASE(13) PHASE(14) PHASE(15) PHASE(16) PHASE(17) PHASE(18) PHASE(19)
  PHASE(20) PHASE(21) PHASE(22) PHASE(23) PHASE(24) PHASE(25) PHASE(26) PHASE(27) PHASE(28) PHASE(29)
#undef PHASE
}

extern "C" void kernel_launch(void* const* d_in, const int* in_sizes, int n_in, void* d_out, int out_size, void* d_ws,
                              size_t ws_size, hipStream_t stream) {
  Params P{};
  for (int i = 0; i < 31; ++i) P.in[i] = (const float*)d_in[i];
  P.out = (float*)d_out;
  P.ws = (char*)d_ws;
  static int grid = 0;
  void* args[] = {&P};
  (void)hipMemsetAsync(P.ws + OFF_BAR, 0, 4096, stream);
  if (!grid) {
    int dev = 0, cus = 0;
    (void)hipGetDevice(&dev);
    (void)hipDeviceGetAttribute(&cus, hipDeviceAttributeMultiprocessorCount, dev);
    grid = cus * 2;
    hipError_t e0 = hipLaunchCooperativeKernel((void*)mega, dim3(grid), dim3(256), args, 0, stream);
    if (e0 != hipSuccess) {
      (void)hipGetLastError();
      grid = cus;
      e0 = hipLaunchCooperativeKernel((void*)mega, dim3(grid), dim3(256), args, 0, stream);
      if (e0 != hipSuccess) fprintf(stderr, "cooperative launch failed: %s (grid %d)\n", hipGetErrorString(e0), grid);
    }
    return;
  }
  hipError_t e = hipLaunchCooperativeKernel((void*)mega, dim3(grid), dim3(256), args, 0, stream);
  if (e != hipSuccess) fprintf(stderr, "cooperative launch failed: %s (grid %d)\n", hipGetErrorString(e), grid);
}
```

```cpp
#include <hip/hip_runtime.h>
#include <hip/hip_cooperative_groups.h>
#include <cstdio>
namespace cg = cooperative_groups;

#ifndef DUPMASK
#define DUPMASK 0u
#endif
#ifndef PREMASK
#define PREMASK 0u
#endif
#ifndef ONE_LAUNCH
#define ONE_LAUNCH 1
#endif

typedef unsigned short bf16_t;
using bf16x8 = __attribute__((ext_vector_type(8))) short;
using f32x4 = __attribute__((ext_vector_type(4))) float;
using u32x4 = __attribute__((ext_vector_type(4))) unsigned;

constexpr int T_P = 16384, T_S = 128, T = 16512;
constexpr int NCH = 264;
constexpr int NSEG_G = 32, NSEGT_G = NSEG_G + 8;
constexpr int NSEG_S = 16, NSEGT_S = NSEG_S + 8;
constexpr int LW = 1408;
constexpr float EPS = 1e-6f;

constexpr size_t O_YP = 0;
constexpr size_t O_YS = O_YP + (size_t)T_P * 1024;
constexpr size_t O_GLA_P = O_YS + (size_t)T_S * 1024;
constexpr size_t O_LCONV_P = O_GLA_P + (size_t)2 * 4 * 128 * 256;
constexpr size_t O_LH_P = O_LCONV_P + 3 * LW;
constexpr size_t O_SCONV_P = O_LH_P + LW;
constexpr size_t O_SH_P = O_SCONV_P + 3 * 3072;
constexpr size_t O_GLA_S = O_SH_P + (size_t)32 * 64 * 128;
constexpr size_t O_LCONV_S = O_GLA_S + (size_t)2 * 8 * 4 * 128 * 256;
constexpr size_t O_LH_S = O_LCONV_S + 8 * 3 * LW;
constexpr size_t O_SCONV_S = O_LH_S + 8 * LW;
constexpr size_t O_SH_S = O_SCONV_S + 8 * 3 * 3072;

constexpr size_t OFF_WIN = 0;
constexpr size_t OFF_WOUT = OFF_WIN + (size_t)5248 * 1024 * 2;
constexpr size_t OFF_WOUT1 = OFF_WOUT + (size_t)1024 * 2048 * 2;
constexpr size_t OFF_WG = OFF_WOUT1 + (size_t)1024 * 2048 * 2;
constexpr size_t OFF_H = OFF_WG + (size_t)2 * 16 * 96 * 96 * 2;
constexpr size_t OFF_BIG = OFF_H + (size_t)T * 1024 * 2;
constexpr size_t G_QD = OFF_BIG;
constexpr size_t G_KD = G_QD + (size_t)T * 512 * 2;
constexpr size_t G_KDT = G_KD + (size_t)T * 512 * 2;
constexpr size_t G_VT = G_KDT + (size_t)NCH * 512 * 64 * 2;
constexpr size_t G_G = G_VT + (size_t)NCH * 1024 * 64 * 2;
constexpr size_t G_O = G_G + (size_t)T * 1024 * 2;
constexpr size_t G_GLR = G_O + (size_t)T * 1024 * 2;
constexpr size_t G_SSQ = G_GLR + (size_t)T * 16 * 4;
constexpr size_t G_DEC = G_SSQ + (size_t)T * 16 * 4;
constexpr size_t G_SSEG = G_DEC + (size_t)NCH * 512 * 4;
constexpr size_t G_DSEG = G_SSEG + (size_t)NSEG_G * 4 * 256 * 128 * 4;
constexpr size_t G_END = G_DSEG + (size_t)NSEG_G * 512 * 4;
constexpr size_t L_XB = OFF_BIG;
constexpr size_t L_GATE = L_XB + (size_t)T * LW * 2;
constexpr size_t L_Y = L_GATE + (size_t)T * LW * 2;
constexpr size_t L_ASEG = L_Y + (size_t)T * LW * 2;
constexpr size_t L_HSEG = L_ASEG + (size_t)NCH * LW * 4;
constexpr size_t L_END = L_HSEG + (size_t)NCH * LW * 4;
constexpr size_t S_Z = OFF_BIG;
constexpr size_t S_XBCT = S_Z + (size_t)T * 2048 * 2;
constexpr size_t S_DT = S_XBCT + (size_t)NCH * 3072 * 64 * 2;
constexpr size_t S_TAIL = S_DT + (size_t)T * 32 * 4;
constexpr size_t S_SSQ = S_TAIL + (size_t)NCH * 3072 * 4 * 2;
constexpr size_t S_SSEG = S_SSQ + (size_t)T * 32 * 4;
constexpr size_t S_CDSEG = S_SSEG + (size_t)NSEG_S * 32 * 64 * 128 * 4;
constexpr size_t S_END = S_CDSEG + 4096;
constexpr size_t S_BRM = OFF_H;
constexpr size_t S_CRM = OFF_H + (size_t)T * 512 * 2;
static_assert(G_END <= 268435456ull - 4096 && L_END <= 268435456ull - 4096 && S_END <= 268435456ull - 4096, "ws overflow");

constexpr int SMEM_BYTES = 81920;
constexpr int SMEM_XB = 81856;

struct Params {
  const float* in[31];
  float* out;
  char* ws;
};

__device__ __forceinline__ int otid() { int t = threadIdx.x; asm volatile("" : "+v"(t)); return t; }
__device__ __forceinline__ bf16_t f2bf(float f) {
  unsigned u = __float_as_uint(f);
  u += 0x7fffu + ((u >> 16) & 1u);
  return (bf16_t)(u >> 16);
}
__device__ __forceinline__ float bf2f(bf16_t b) { return __uint_as_float(((unsigned)b) << 16); }
__device__ __forceinline__ unsigned pack2(float a, float b) { return (unsigned)f2bf(a) | ((unsigned)f2bf(b) << 16); }
__device__ __forceinline__ float lo_bf(unsigned w) { return __uint_as_float(w << 16); }
__device__ __forceinline__ float hi_bf(unsigned w) { return __uint_as_float(w & 0xffff0000u); }
__device__ __forceinline__ float sigmoid_(float x) { return __builtin_amdgcn_rcpf(1.f + __expf(-x)); }
__device__ __forceinline__ float silu_(float x) { return x * __builtin_amdgcn_rcpf(1.f + __expf(-x)); }
__device__ __forceinline__ float softplus_(float x) { return fmaxf(x, 0.f) + log1pf(__expf(-fabsf(x))); }

__device__ __forceinline__ void tok2chunk(int t, int& c, int& j) {
  if (t < T_P) { c = t >> 6; j = t & 63; }
  else { int u = t - T_P; c = 256 + (u >> 4); j = u & 15; }
}
__device__ __forceinline__ void chunk_info(int c, int& t0, int& len) {
  if (c < 256) { t0 = c * 64; len = 64; }
  else { t0 = T_P + (c - 256) * 16; len = 16; }
}
__device__ __forceinline__ void seg_info(int sg, int nseg, int& c0, int& nch, int& b) {
  if (sg < nseg) { const int cps = 256 / nseg; c0 = sg * cps; nch = cps; b = -1; }
  else { c0 = 256 + (sg - nseg); nch = 1; b = sg - nseg; }
}

template <int MT, int NT, int KS>
__device__ __forceinline__ void mma_lds(f32x4 (&acc)[MT][NT], const bf16_t* A, int lda, const bf16_t* B, int ldb, int r, int q) {
#pragma unroll
  for (int ks = 0; ks < KS; ++ks) {
    bf16x8 af[MT], bfr[NT];
#pragma unroll
    for (int mi = 0; mi < MT; ++mi) af[mi] = *(const bf16x8*)(A + (mi * 16 + r) * lda + ks * 32 + q * 8);
#pragma unroll
    for (int ni = 0; ni < NT; ++ni) bfr[ni] = *(const bf16x8*)(B + (ni * 16 + r) * ldb + ks * 32 + q * 8);
#pragma unroll
    for (int mi = 0; mi < MT; ++mi)
#pragma unroll
      for (int ni = 0; ni < NT; ++ni)
        acc[mi][ni] = __builtin_amdgcn_mfma_f32_16x16x32_bf16(af[mi], bfr[ni], acc[mi][ni], 0, 0, 0);
  }
}

__device__ __forceinline__ void ph_convT(const float* __restrict__ src, int K, int N, int Npad, bf16_t* __restrict__ dst,
                         const float* __restrict__ kscale, char* smem) {
  float* tile = (float*)smem;
  const int tid = otid();
  const int ktn = K / 64, ntn = Npad / 64;
  for (int it = blockIdx.x; it < ktn * ntn; it += gridDim.x) {
    const int kt = it / ntn, nt = it - kt * ntn;
    const int k0 = kt * 64, n0 = nt * 64;
    {
      const int nn = tid & 63, n = n0 + nn;
      float v[16];
#pragma unroll
      for (int i = 0; i < 16; ++i) {
        const int kk = (tid >> 6) + 4 * i;
        v[i] = 0.f;
        if (n < N) v[i] = src[(size_t)(k0 + kk) * N + n];
      }
      if (kscale) {
#pragma unroll
        for (int i = 0; i < 16; ++i) v[i] *= kscale[k0 + (tid >> 6) + 4 * i];
      }
      __syncthreads();
#pragma unroll
      for (int i = 0; i < 16; ++i) tile[((tid >> 6) + 4 * i) * 65 + nn] = v[i];
    }
    __syncthreads();
#pragma unroll
    for (int i = 0; i < 2; ++i) {
      const int nn = (tid >> 3) + 32 * i, kk = (tid & 7) * 8;
      uint4 u;
      u.x = pack2(tile[(kk + 0) * 65 + nn], tile[(kk + 1) * 65 + nn]);
      u.y = pack2(tile[(kk + 2) * 65 + nn], tile[(kk + 3) * 65 + nn]);
      u.z = pack2(tile[(kk + 4) * 65 + nn], tile[(kk + 5) * 65 + nn]);
      u.w = pack2(tile[(kk + 6) * 65 + nn], tile[(kk + 7) * 65 + nn]);
      *(uint4*)(dst + (size_t)(n0 + nn) * K + k0 + kk) = u;
    }
  }
}

__device__ __forceinline__ void ph_conv_gate(const float* __restrict__ w, bf16_t* __restrict__ dst) {
  for (int idx = blockIdx.x * 256 + otid(); idx < 16 * 96 * 96; idx += gridDim.x * 256) {
    const int k = idx / 9216, rem = idx - k * 9216, co = rem / 96, ci = rem - co * 96;
    float v = 0.f;
    if (co < 88 && ci < 88) v = w[(k * 88 + ci) * 88 + co];
    dst[idx] = f2bf(v);
  }
}

__device__ __forceinline__ void ph_norm(const float* __restrict__ xp, const float* __restrict__ xs, const float* __restrict__ w,
                        bf16_t* __restrict__ h, float* xcopy) {
  const int lane = otid() & 63, wave = otid() >> 6;
  for (int row = blockIdx.x * 4 + wave; row < T; row += gridDim.x * 4) {
    const float* src = row < T_P ? xp + (size_t)row * 1024 : xs + (size_t)(row - T_P) * 1024;
    float4 v[4];
    float ss = 0.f;
#pragma unroll
    for (int i = 0; i < 4; ++i) {
      v[i] = *(const float4*)(src + i * 256 + lane * 4);
      ss += v[i].x * v[i].x + v[i].y * v[i].y + v[i].z * v[i].z + v[i].w * v[i].w;
    }
#pragma unroll
    for (int off = 32; off >= 1; off >>= 1) ss += __shfl_xor(ss, off);
    const float rs = rsqrtf(ss * (1.f / 1024.f) + EPS);
    if (xcopy != nullptr && row >= T_P) {
#pragma unroll
      for (int i = 0; i < 4; ++i) *(float4*)(xcopy + (size_t)row * 1024 + i * 256 + lane * 4) = v[i];
    }
#pragma unroll
    for (int i = 0; i < 4; ++i) {
      const float4 ww = *(const float4*)(w + i * 256 + lane * 4);
      uint2 o;
      o.x = pack2(v[i].x * rs * ww.x, v[i].y * rs * ww.y);
      o.y = pack2(v[i].z * rs * ww.z, v[i].w * rs * ww.w);
      *(uint2*)(h + (size_t)row * 1024 + i * 256 + lane * 4) = o;
    }
  }
}

__device__ __forceinline__ void ph_final_norm(float* __restrict__ x, const float* __restrict__ w) {
  const int lane = otid() & 63, wave = otid() >> 6;
  for (int row = blockIdx.x * 4 + wave; row < T; row += gridDim.x * 4) {
    float* src = x + (size_t)row * 1024;
    float4 v[4];
    float ss = 0.f;
#pragma unroll
    for (int i = 0; i < 4; ++i) {
      v[i] = *(const float4*)(src + i * 256 + lane * 4);
      ss += v[i].x * v[i].x + v[i].y * v[i].y + v[i].z * v[i].z + v[i].w * v[i].w;
    }
#pragma unroll
    for (int off = 32; off >= 1; off >>= 1) ss += __shfl_xor(ss, off);
    const float rs = rsqrtf(ss * (1.f / 1024.f) + EPS);
#pragma unroll
    for (int i = 0; i < 4; ++i) {
      const float4 ww = *(const float4*)(w + i * 256 + lane * 4);
      float4 o;
      o.x = v[i].x * rs * ww.x; o.y = v[i].y * rs * ww.y; o.z = v[i].z * rs * ww.z; o.w = v[i].w * rs * ww.w;
      *(float4*)(src + i * 256 + lane * 4) = o;
    }
  }
}

#define GLDS16(gp, lp) __builtin_amdgcn_global_load_lds((const unsigned*)(gp), (unsigned*)(lp), 16, 0, 0)
template <class Epi, bool SWP>
__device__ __forceinline__ void gemm_tile(const bf16_t* __restrict__ A, int lda, const bf16_t* __restrict__ Bt, int ldb, int nk,
                                          int tm, int tn, Epi epi, char* smem) {
  const int tid = otid(), lane = tid & 63, wave = tid >> 6;
  const int wm = wave >> 1, wn = wave & 1, r = lane & 15, q = lane >> 4;
  const int srow = tid >> 2, skc = (tid & 3) * 8;
  char* l0 = smem + tid * 16;
  f32x4 acc[32];
#pragma unroll
  for (int i = 0; i < 32; ++i) acc[i] = f32x4{0.f, 0.f, 0.f, 0.f};
  const int a_off = wm * 8192 + r * 64 + q * 16;
  const int b_off = 16384 + wn * 4096 + r * 64 + q * 16;
  const int b_offp = 16384 + wn * 4096 + (8 * (r >> 2) + (r & 3)) * 64 + q * 16;
  const bf16_t* Ag = A + (size_t)(tm * 256 + srow) * lda + skc;
  const bf16_t* Bg = Bt + (size_t)(tn * 128 + srow) * ldb + skc;
  const size_t a64 = (size_t)64 * lda, b64 = (size_t)64 * ldb;
#define G_ISSUE(t_, st_)                                   \
  {                                                        \
    const int ko_ = (t_) * 32;                             \
    char* lb_ = l0 + (st_) * 24576;                        \
    GLDS16(Ag + ko_, lb_);                                 \
    GLDS16(Ag + a64 + ko_, lb_ + 4096);                    \
    GLDS16(Ag + 2 * a64 + ko_, lb_ + 8192);                \
    GLDS16(Ag + 3 * a64 + ko_, lb_ + 12288);               \
    GLDS16(Bg + ko_, lb_ + 16384);                         \
    GLDS16(Bg + b64 + ko_, lb_ + 20480);                   \
  }
#define G_STEP(t_, st_)                                                                                   \
  {                                                                                                       \
    const int tt_ = (t_);                                                                                 \
    if (tt_ + 1 < nk) asm volatile("s_waitcnt vmcnt(6) lgkmcnt(0)\n\ts_barrier" ::: "memory");            \
    else asm volatile("s_waitcnt vmcnt(0) lgkmcnt(0)\n\ts_barrier" ::: "memory");                         \
    if (tt_ + 2 < nk) G_ISSUE(tt_ + 2, ((st_) + 2) % 3)                                                   \
    const char* sb_ = smem + (st_) * 24576;                                                               \
    bf16x8 af_[8], bf_[4];                                                                                \
    _Pragma("unroll") for (int mi = 0; mi < 8; ++mi) af_[mi] = *(const bf16x8*)(sb_ + a_off + mi * 1024);  \
    _Pragma("unroll") for (int ni = 0; ni < 4; ++ni)                                                      \
      bf_[ni] = *(const bf16x8*)(sb_ + (SWP ? b_offp + (ni >> 1) * 2048 + (ni & 1) * 256 : b_off + ni * 1024)); \
    __builtin_amdgcn_s_setprio(1);                                                                        \
    _Pragma("unroll") for (int mi = 0; mi < 8; ++mi)                                                      \
    _Pragma("unroll") for (int ni = 0; ni < 4; ++ni)                                                      \
      acc[mi * 4 + ni] = SWP ? __builtin_amdgcn_mfma_f32_16x16x32_bf16(bf_[ni], af_[mi], acc[mi * 4 + ni], 0, 0, 0) \
                             : __builtin_amdgcn_mfma_f32_16x16x32_bf16(af_[mi], bf_[ni], acc[mi * 4 + ni], 0, 0, 0); \
    __builtin_amdgcn_s_setprio(0);                                                                        \
  }
  asm volatile("s_waitcnt vmcnt(0)" ::: "memory");
  G_ISSUE(0, 0)
  G_ISSUE(1, 1)
  {
    int st = 0;
    for (int t = 0; t < nk; ++t) {
      G_STEP(t, st)
      st = st == 2 ? 0 : st + 1;
    }
  }
#undef G_STEP
#undef G_ISSUE
  epi.begin(tm * 256 + wm * 128, lane);
#pragma unroll
  for (int mi = 0; mi < 8; ++mi)
#pragma unroll
    for (int ni = 0; ni < 4; ++ni) {
      if (SWP) {
        if ((ni & 1) == 0)
          epi.rowvec8(tm * 256 + wm * 128 + mi * 16 + r, tn * 128 + wn * 64 + (ni >> 1) * 32 + q * 8, acc[mi * 4 + ni], acc[mi * 4 + ni + 1]);
      } else epi.colvec(tm * 256 + wm * 128 + mi * 16 + q * 4, tn * 128 + wn * 64 + ni * 16 + r, acc[mi * 4 + ni]);
    }
}

template <class Epi>
__device__ __forceinline__ void gemm_main(const bf16_t* __restrict__ A, int lda, const bf16_t* __restrict__ Bt, int ldb, int K,
                                          int Ntiles, Epi epi, char* smem) {
  const int nk = K / 32;
  const int total = 64 * Ntiles;
  for (int sidx = blockIdx.x; sidx < total; sidx += gridDim.x) {
    const int u = sidx >> 3;
    const int tn = u >> 3, tm = (sidx & 7) * 8 + (u & 7);
    if (epi.swapped_col(tn * 128)) gemm_tile<Epi, true>(A, lda, Bt, ldb, nk, tm, tn, epi, smem);
    else gemm_tile<Epi, false>(A, lda, Bt, ldb, nk, tm, tn, epi, smem);
  }
}

template <class Epi>
__device__ __forceinline__ void gemm_side(const bf16_t* __restrict__ A, int lda, const bf16_t* __restrict__ Bt, int ldb, int K,
                                          int N, int Nfull, Epi epi) {
  const int tid = otid(), lane = tid & 63, wave = tid >> 6, r = lane & 15, q = lane >> 4;
  const int ncg = (N + 31) >> 5, cg_left0 = Nfull >> 5, nleft = ncg - cg_left0;
  constexpr int KS = Epi::KSPLIT;
  const int njobs0 = ncg + nleft * 128, njobs = njobs0 * KS;
  const int Kpart = K / KS;
  for (int jx = blockIdx.x; jx < njobs; jx += gridDim.x) {
    const int ks = KS > 1 ? jx / njobs0 : 0, j = jx - ks * njobs0;
    int row0, cg;
    if (j < ncg) { row0 = T_P; cg = j; }
    else { const int jj = j - ncg, rt = jj / nleft; row0 = rt * 128; cg = cg_left0 + (jj - rt * nleft); }
    const int col0 = cg * 32;
    const bool swp = epi.swapped_col(col0);
    f32x4 acc[4];
#pragma unroll
    for (int i = 0; i < 4; ++i) acc[i] = f32x4{0.f, 0.f, 0.f, 0.f};
    const bf16_t* Ap = A + (size_t)(row0 + 32 * wave + r) * lda + q * 8 + ks * Kpart;
    const bf16_t* Bp = Bt + (size_t)(col0 + r) * ldb + q * 8 + ks * Kpart;
    const size_t a16 = (size_t)16 * lda, b16 = (size_t)16 * ldb;
    if (swp) {
#pragma unroll 4
      for (int k0 = 0; k0 < Kpart; k0 += 32) {
        const bf16x8 a0 = *(const bf16x8*)(Ap + k0), a1 = *(const bf16x8*)(Ap + a16 + k0);
        const bf16x8 b0 = *(const bf16x8*)(Bp + k0), b1 = *(const bf16x8*)(Bp + b16 + k0);
        acc[0] = __builtin_amdgcn_mfma_f32_16x16x32_bf16(b0, a0, acc[0], 0, 0, 0);
        acc[1] = __builtin_amdgcn_mfma_f32_16x16x32_bf16(b1, a0, acc[1], 0, 0, 0);
        acc[2] = __builtin_amdgcn_mfma_f32_16x16x32_bf16(b0, a1, acc[2], 0, 0, 0);
        acc[3] = __builtin_amdgcn_mfma_f32_16x16x32_bf16(b1, a1, acc[3], 0, 0, 0);
      }
    } else {
#pragma unroll 4
      for (int k0 = 0; k0 < Kpart; k0 += 32) {
        const bf16x8 a0 = *(const bf16x8*)(Ap + k0), a1 = *(const bf16x8*)(Ap + a16 + k0);
        const bf16x8 b0 = *(const bf16x8*)(Bp + k0), b1 = *(const bf16x8*)(Bp + b16 + k0);
        acc[0] = __builtin_amdgcn_mfma_f32_16x16x32_bf16(a0, b0, acc[0], 0, 0, 0);
        acc[1] = __builtin_amdgcn_mfma_f32_16x16x32_bf16(a0, b1, acc[1], 0, 0, 0);
        acc[2] = __builtin_amdgcn_mfma_f32_16x16x32_bf16(a1, b0, acc[2], 0, 0, 0);
        acc[3] = __builtin_amdgcn_mfma_f32_16x16x32_bf16(a1, b1, acc[3], 0, 0, 0);
      }
    }
    epi.begin(row0 + 32 * wave, lane);
#pragma unroll
    for (int mi = 0; mi < 2; ++mi)
#pragma unroll
      for (int ni = 0; ni < 2; ++ni) {
        if (KS > 1) epi.rowvec_acc(row0 + 32 * wave + mi * 16 + r, col0 + ni * 16 + q * 4, acc[mi * 2 + ni]);
        else if (swp) epi.rowvec(row0 + 32 * wave + mi * 16 + r, col0 + ni * 16 + q * 4, acc[mi * 2 + ni]);
        else epi(row0 + 32 * wave + mi * 16 + q * 4, col0 + ni * 16 + r, acc[mi * 2 + ni]);
      }
  }
}

template <class Epi>
__device__ __forceinline__ void gemm_phase(const bf16_t* __restrict__ A, int lda, const bf16_t* __restrict__ Bt, int ldb, int K,
                                           int N, Epi epi, char* smem) {
  gemm_main(A, lda, Bt, ldb, K, N >> 7, epi, smem);
  gemm_side(A, lda, Bt, ldb, K, N, (N >> 7) << 7, epi);
}

struct EpiGlaIn {
  static constexpr int KSPLIT = 1;
  __device__ __forceinline__ void rowvec_acc(int, int, f32x4) const {}
  bf16_t *qd, *kd, *vT, *g;
  float* glr;
  __device__ __forceinline__ void begin(int, int) {}
  __device__ __forceinline__ bool swapped_col(int c) const { return c < 1024 || (c >= 2048 && c < 3072); }
  __device__ __forceinline__ void colvec(int row0, int col, f32x4 v) const {
    uint2 u;
    u.x = pack2(v[0], v[1]);
    u.y = pack2(v[2], v[3]);
    *(uint2*)(vT + ((size_t)(row0 >> 6) * 1024 + (col - 1024)) * 64 + (row0 & 63)) = u;
  }
  __device__ __forceinline__ void rowvec8(int row, int col0, f32x4 v, f32x4 w) const {
    const float sc = col0 < 512 ? 0.08838834764831845f : 1.f;
    const u32x4 u = u32x4{pack2(v[0] * sc, v[1] * sc), pack2(v[2] * sc, v[3] * sc), pack2(w[0] * sc, w[1] * sc), pack2(w[2] * sc, w[3] * sc)};
    bf16_t* dst = col0 < 512 ? qd + (size_t)row * 512 + col0
                : col0 < 1024 ? kd + (size_t)row * 512 + (col0 - 512) : g + (size_t)row * 1024 + (col0 - 2048);
    *(u32x4*)dst = u;
  }
  __device__ __forceinline__ void rowvec(int row, int col0, f32x4 v) const {
    uint2 u;
    if (col0 < 512) {
      const float sc = 0.08838834764831845f;
      u.x = pack2(v[0] * sc, v[1] * sc); u.y = pack2(v[2] * sc, v[3] * sc);
      *(uint2*)(qd + (size_t)row * 512 + col0) = u;
    } else if (col0 < 1024) {
      u.x = pack2(v[0], v[1]); u.y = pack2(v[2], v[3]);
      *(uint2*)(kd + (size_t)row * 512 + (col0 - 512)) = u;
    } else {
      u.x = pack2(v[0], v[1]); u.y = pack2(v[2], v[3]);
      *(uint2*)(g + (size_t)row * 1024 + (col0 - 2048)) = u;
    }
  }
  __device__ __forceinline__ void operator()(int row0, int col, f32x4 v) const {
    if (col < 512) {
#pragma unroll
      for (int jj = 0; jj < 4; ++jj) qd[(size_t)(row0 + jj) * 512 + col] = f2bf(v[jj] * 0.08838834764831845f);
    } else if (col < 1024) {
#pragma unroll
      for (int jj = 0; jj < 4; ++jj) kd[(size_t)(row0 + jj) * 512 + (col - 512)] = f2bf(v[jj]);
    } else if (col < 2048) {
      int c, j;
      tok2chunk(row0, c, j);
      uint2 u;
      u.x = pack2(v[0], v[1]);
      u.y = pack2(v[2], v[3]);
      *(uint2*)(vT + ((size_t)c * 1024 + (col - 1024)) * 64 + j) = u;
    } else if (col < 3072) {
#pragma unroll
      for (int jj = 0; jj < 4; ++jj) g[(size_t)(row0 + jj) * 1024 + (col - 2048)] = f2bf(v[jj]);
    } else if (col < 3088) {
#pragma unroll
      for (int jj = 0; jj < 4; ++jj) glr[(size_t)(row0 + jj) * 16 + (col - 3072)] = v[jj];
    }
  }
};

struct EpiLruIn {
  static constexpr int KSPLIT = 1;
  __device__ __forceinline__ void rowvec_acc(int, int, f32x4) const {}
  bf16_t *xb, *gate;
  __device__ __forceinline__ void begin(int, int) {}
  __device__ __forceinline__ bool swapped_col(int) const { return true; }
  __device__ __forceinline__ void colvec(int, int, f32x4) const {}
  __device__ __forceinline__ void rowvec8(int row, int col0, f32x4 v, f32x4 w) const {
    bf16_t* dst = col0 < LW ? xb + col0 : gate + (col0 - LW);
    *(u32x4*)(dst + (size_t)row * LW) = u32x4{pack2(v[0], v[1]), pack2(v[2], v[3]), pack2(w[0], w[1]), pack2(w[2], w[3])};
  }
  __device__ __forceinline__ void rowvec(int row, int col0, f32x4 v) const {
    bf16_t* dst = col0 < LW ? xb + col0 : gate + (col0 - LW);
    uint2 u;
    u.x = pack2(v[0], v[1]); u.y = pack2(v[2], v[3]);
    *(uint2*)(dst + (size_t)row * LW) = u;
  }
  __device__ __forceinline__ void operator()(int row0, int col, f32x4 v) const {
    bf16_t* dst = col < LW ? xb + col : gate + (col - LW);
#pragma unroll
    for (int jj = 0; jj < 4; ++jj) dst[(size_t)(row0 + jj) * LW] = f2bf(v[jj]);
  }
};

struct EpiSsdIn {
  static constexpr int KSPLIT = 1;
  __device__ __forceinline__ void rowvec_acc(int, int, f32x4) const {}
  bf16_t *z, *xbcT, *tails;
  float* dt;
  const float* dt_bias;
  __device__ __forceinline__ void begin(int, int) {}
  __device__ __forceinline__ bool swapped_col(int c) const { return c < 2048; }
  __device__ __forceinline__ void colvec(int row0, int col, f32x4 v) const {
    const int c = row0 >> 6, j = row0 & 63, cc = col - 2048;
    uint2 u;
    u.x = pack2(v[0], v[1]);
    u.y = pack2(v[2], v[3]);
    *(uint2*)(xbcT + ((size_t)c * 3072 + cc) * 64 + j) = u;
    if (j == 60) *(uint2*)(tails + ((size_t)c * 3072 + cc) * 4) = u;
  }
  __device__ __forceinline__ void rowvec8(int row, int col0, f32x4 v, f32x4 w) const {
    *(u32x4*)(z + (size_t)row * 2048 + col0) = u32x4{pack2(v[0], v[1]), pack2(v[2], v[3]), pack2(w[0], w[1]), pack2(w[2], w[3])};
  }
  __device__ __forceinline__ void rowvec(int row, int col0, f32x4 v) const {
    uint2 u;
    u.x = pack2(v[0], v[1]); u.y = pack2(v[2], v[3]);
    *(uint2*)(z + (size_t)row * 2048 + col0) = u;
  }
  __device__ __forceinline__ void operator()(int row0, int col, f32x4 v) const {
    if (col < 2048) {
#pragma unroll
      for (int jj = 0; jj < 4; ++jj) z[(size_t)(row0 + jj) * 2048 + col] = f2bf(v[jj]);
    } else if (col < 5120) {
      int c, j;
      tok2chunk(row0, c, j);
      const int len = c < 256 ? 64 : 16;
      const int cc = col - 2048;
      uint2 u;
      u.x = pack2(v[0], v[1]);
      u.y = pack2(v[2], v[3]);
      *(uint2*)(xbcT + ((size_t)c * 3072 + cc) * 64 + j) = u;
      if (j == len - 4) *(uint2*)(tails + ((size_t)c * 3072 + cc) * 4) = u;
    } else if (col < 5152) {
      const int hd = col - 5120;
#pragma unroll
      for (int jj = 0; jj < 4; ++jj) dt[(size_t)(row0 + jj) * 32 + hd] = v[jj];
    }
  }
};

struct EpiResid {
  const float *xin_p, *xin_s;
  float* xout;
  static constexpr int KSPLIT = 4;
  __device__ __forceinline__ void rowvec_acc(int row, int col0, f32x4 v) const {
    float* dst = xout + (size_t)row * 1024 + col0;
#pragma unroll
    for (int e = 0; e < 4; ++e) (void)__hip_atomic_fetch_add(dst + e, v[e], __ATOMIC_RELAXED, __HIP_MEMORY_SCOPE_AGENT);
  }
  __device__ __forceinline__ void begin(int, int) {}
  __device__ __forceinline__ bool swapped_col(int) const { return true; }
  __device__ __forceinline__ void colvec(int, int, f32x4) const {}
  __device__ __forceinline__ void rowvec8(int row, int col0, f32x4 v, f32x4 w) const {
    rowvec(row, col0, v);
    rowvec(row, col0 + 4, w);
  }
  __device__ __forceinline__ void rowvec(int row, int col0, f32x4 v) const {
    const float* src = row < T_P ? xin_p + (size_t)row * 1024 : xin_s + (size_t)(row - T_P) * 1024;
    const float4 x = *(const float4*)(src + col0);
    float4 o;
    o.x = x.x + v[0]; o.y = x.y + v[1]; o.z = x.z + v[2]; o.w = x.w + v[3];
    *(float4*)(xout + (size_t)row * 1024 + col0) = o;
  }
  __device__ __forceinline__ void operator()(int row0, int col, f32x4 v) const {
#pragma unroll
    for (int jj = 0; jj < 4; ++jj) {
      const int row = row0 + jj;
      const float* src = row < T_P ? xin_p + (size_t)row * 1024 : xin_s + (size_t)(row - T_P) * 1024;
      xout[(size_t)row * 1024 + col] = src[col] + v[jj];
    }
  }
};

struct EpiResidScaled {
  static constexpr int KSPLIT = 4;
  __device__ __forceinline__ void rowvec_acc(int row, int col0, f32x4 v) const {
    const int o_ = row - rowbase;
    const float s0_ = __shfl(rs, o_ & 63), s1_ = __shfl(rs1, o_ & 63);
    const float sc = o_ < 64 ? s0_ : s1_;
    float* dst = xout + (size_t)row * 1024 + col0;
#pragma unroll
    for (int e = 0; e < 4; ++e) (void)__hip_atomic_fetch_add(dst + e, sc * v[e], __ATOMIC_RELAXED, __HIP_MEMORY_SCOPE_AGENT);
  }
  const float *xin_p, *xin_s;
  float* xout;
  const float* ssq;
  float rs, rs1;
  int rowbase;
  __device__ __forceinline__ bool swapped_col(int) const { return true; }
  __device__ __forceinline__ void colvec(int, int, f32x4) const {}
  __device__ __forceinline__ void rowvec8(int row, int col0, f32x4 v, f32x4 w) const {
    rowvec(row, col0, v);
    rowvec(row, col0 + 4, w);
  }
  __device__ __forceinline__ void rowvec(int row, int col0, f32x4 v) const {
    const int o_ = row - rowbase;
    const float s0_ = __shfl(rs, o_ & 63), s1_ = __shfl(rs1, o_ & 63);
    const float sc = o_ < 64 ? s0_ : s1_;
    const float* src = row < T_P ? xin_p + (size_t)row * 1024 : xin_s + (size_t)(row - T_P) * 1024;
    const float4 x = *(const float4*)(src + col0);
    float4 o;
    o.x = x.x + sc * v[0]; o.y = x.y + sc * v[1]; o.z = x.z + sc * v[2]; o.w = x.w + sc * v[3];
    *(float4*)(xout + (size_t)row * 1024 + col0) = o;
  }
  __device__ __forceinline__ void begin(int rb, int lane) {
    rowbase = rb;
    float rr[2];
#pragma unroll
    for (int hh = 0; hh < 2; ++hh) {
      const int row = rb + hh * 64 + lane;
      float sacc = 0.f;
      if (row < T) {
        const float4* p = (const float4*)(ssq + (size_t)row * 32);
#pragma unroll
        for (int i = 0; i < 8; ++i) {
          const float4 v = p[i];
          sacc += v.x + v.y + v.z + v.w;
        }
      }
      rr[hh] = rsqrtf(sacc * (1.f / 2048.f) + EPS);
    }
    rs = rr[0];
    rs1 = rr[1];
  }
  __device__ __forceinline__ void operator()(int row0, int col, f32x4 v) const {
#pragma unroll
    for (int jj = 0; jj < 4; ++jj) {
      const int row = row0 + jj;
      const int o_ = row - rowbase;
      const float s0_ = __shfl(rs, o_ & 63), s1_ = __shfl(rs1, o_ & 63);
      const float sc = o_ < 64 ? s0_ : s1_;
      const float* src = row < T_P ? xin_p + (size_t)row * 1024 : xin_s + (size_t)(row - T_P) * 1024;
      xout[(size_t)row * 1024 + col] = src[col] + sc * v[jj];
    }
  }
};

__device__ __forceinline__ void ph_gla_prep(const Params& P, int layer, char* smem) {
  bf16_t* sQ = (bf16_t*)smem;
  bf16_t* sK = (bf16_t*)(smem + 8192);
  float* sG = (float*)(smem + 16384);
  float* sTot = (float*)(smem + 20480);
  bf16_t* qd = (bf16_t*)(P.ws + G_QD);
  bf16_t* kd = (bf16_t*)(P.ws + G_KD);
  bf16_t* kdT = (bf16_t*)(P.ws + G_KDT);
  const float* glr = (const float*)(P.ws + G_GLR);
  float* decay = (float*)(P.ws + G_DEC);
  const float* wgu = P.in[10] + (size_t)layer * 16 * 512;
  const float* bgt = P.in[11] + (size_t)layer * 512;
  const int tid = otid(), tg = tid >> 6, cl = tid & 63;
  for (int it = blockIdx.x; it < NCH * 8; it += gridDim.x) {
    const int c = it >> 3, cb8 = it & 7, d = cb8 * 64 + cl;
    int t0, len;
    chunk_info(c, t0, len);
    float wg[16];
#pragma unroll
    for (int rk = 0; rk < 16; ++rk) wg[rk] = wgu[rk * 512 + d];
    const float bg = bgt[d];
    u32x4 rq[2], rk2[2];
#pragma unroll
    for (int i = 0; i < 2; ++i) {
      const int id = tid + 256 * i, row = id >> 3, c16 = id & 7;
      rq[i] = u32x4{0u, 0u, 0u, 0u};
      rk2[i] = u32x4{0u, 0u, 0u, 0u};
      if (row < len) {
        const size_t a = (size_t)(t0 + row) * 512 + cb8 * 64 + c16 * 8;
        rq[i] = *(const u32x4*)(qd + a);
        rk2[i] = *(const u32x4*)(kd + a);
      }
    }
    float4 gl4 = float4{0.f, 0.f, 0.f, 0.f};
    if (tid * 4 < len * 16) gl4 = *(const float4*)(glr + (size_t)t0 * 16 + tid * 4);
    __syncthreads();
#pragma unroll
    for (int i = 0; i < 2; ++i) {
      const int id = tid + 256 * i, row = id >> 3, c16 = id & 7;
      *(u32x4*)(sQ + row * 64 + c16 * 8) = rq[i];
      *(u32x4*)(sK + row * 64 + c16 * 8) = rk2[i];
    }
    *(float4*)(sG + tid * 4) = gl4;
    __syncthreads();
    float cs[16];
    float run = 0.f;
#pragma unroll
    for (int e = 0; e < 16; ++e) {
      const int j = tg * 16 + e;
      float x = bg;
#pragma unroll
      for (int rk = 0; rk < 16; ++rk) x += sG[j * 16 + rk] * wg[rk];
      const float ls = fminf(x, 0.f) - __logf(1.f + __expf(-fabsf(x)));
      run += (j < len) ? ls * (1.f / 16.f) : 0.f;
      cs[e] = run;
    }
    sTot[tg * 64 + cl] = run;
    __syncthreads();
    float off = 0.f;
#pragma unroll
    for (int g2 = 0; g2 < 3; ++g2) off += (g2 < tg) ? sTot[g2 * 64 + cl] : 0.f;
    unsigned pk[8];
#pragma unroll
    for (int e = 0; e < 16; ++e) {
      const int j = tg * 16 + e;
      const float bc = off + cs[e];
      const float eb = __expf(bc);
      const float qv = bf2f(sQ[j * 64 + cl]), kv = bf2f(sK[j * 64 + cl]);
      sQ[j * 64 + cl] = f2bf(qv * eb);
      const bf16_t kb = f2bf(kv * __builtin_amdgcn_rcpf(eb));
      sK[j * 64 + cl] = kb;
      if (e & 1) pk[e >> 1] |= ((unsigned)kb << 16);
      else pk[e >> 1] = (unsigned)kb;
    }
    if (tg * 16 < len) {
      bf16_t* dstT = kdT + ((size_t)c * 512 + d) * 64 + tg * 16;
      *(u32x4*)dstT = u32x4{pk[0], pk[1], pk[2], pk[3]};
      *(u32x4*)(dstT + 8) = u32x4{pk[4], pk[5], pk[6], pk[7]};
    }
    if (tg == 3) decay[(size_t)c * 512 + d] = __expf(off + run);
    __syncthreads();
#pragma unroll
    for (int i = 0; i < 2; ++i) {
      const int id = tid + 256 * i, row = id >> 3, c16 = id & 7;
      if (row < len) {
        const size_t a = (size_t)(t0 + row) * 512 + cb8 * 64 + c16 * 8;
        *(u32x4*)(qd + a) = *(const u32x4*)(sQ + row * 64 + c16 * 8);
        *(u32x4*)(kd + a) = *(const u32x4*)(sK + row * 64 + c16 * 8);
      }
    }
  }
}

__device__ __forceinline__ void ph_gla_pass(const bool passB, const int layer, const Params& P, char* smem) {
  bf16_t* sKT = (bf16_t*)(smem);
  bf16_t* sVT = (bf16_t*)(smem + 18432);
  bf16_t* sQ = (bf16_t*)(smem + 27648);
  bf16_t* sK = (bf16_t*)(smem + 45056);
  bf16_t* sAtt = sK;
  bf16_t* sS = (bf16_t*)(smem + 62464);
  const bf16_t* qd = (const bf16_t*)(P.ws + G_QD);
  const bf16_t* kd = (const bf16_t*)(P.ws + G_KD);
  const bf16_t* kdT = (const bf16_t*)(P.ws + G_KDT);
  const bf16_t* vT = (const bf16_t*)(P.ws + G_VT);
  bf16_t* obuf = (bf16_t*)(P.ws + G_O);
  float* ssq = (float*)(P.ws + G_SSQ);
  const float* decay = (const float*)(P.ws + G_DEC);
  float* Sseg = (float*)(P.ws + G_SSEG);
  const float* st_in = P.in[2];
  const int tid = otid(), lane = tid & 63, wave = tid >> 6, r = lane & 15, q = lane >> 4;
  const int nitems = passB ? NSEGT_G * 16 : (NSEG_G - 1) * 16;
  for (int it = blockIdx.x; it < nitems; it += gridDim.x) {
    const int sg = it >> 4, h = (it >> 2) & 3, sl = it & 3;
    int c0, nch, b;
    seg_info(sg, NSEG_G, c0, nch, b);
    f32x4 accS[2][4];
#pragma unroll
    for (int mt = 0; mt < 2; ++mt)
#pragma unroll
      for (int nt = 0; nt < 4; ++nt) {
        const int d0 = 32 * wave + mt * 16 + q * 4, v = sl * 64 + nt * 16 + r;
        if (!passB) accS[mt][nt] = f32x4{0.f, 0.f, 0.f, 0.f};
        else if (sg < NSEG_G) {
          const float4 t4 = *(const float4*)(Sseg + ((size_t)(sg * 4 + h) * 256 + v) * 128 + d0);
          accS[mt][nt] = f32x4{t4.x, t4.y, t4.z, t4.w};
        } else {
#pragma unroll
          for (int jj = 0; jj < 4; ++jj)
            accS[mt][nt][jj] = st_in[((((size_t)layer * 8 + b) * 4 + h) * 128 + d0 + jj) * 256 + v];
        }
      }
    float dprod[8] = {1.f, 1.f, 1.f, 1.f, 1.f, 1.f, 1.f, 1.f};
    u32x4 pk[4], pv[2];
    float pdec[8];
#define GLA_ISSUE(cc_)                                                                                         \
  {                                                                                                            \
    const int cx_ = (cc_);                                                                                     \
    const int lenx_ = cx_ < 256 ? 64 : 16;                                                                     \
    _Pragma("unroll") for (int i = 0; i < 4; ++i) {                                                            \
      const int id = tid + 256 * i, row = id >> 3, c16 = id & 7;                                               \
      pk[i] = u32x4{0u, 0u, 0u, 0u};                                                                           \
      if (c16 * 8 < lenx_) pk[i] = *(const u32x4*)(kdT + ((size_t)cx_ * 512 + h * 128 + row) * 64 + c16 * 8);  \
    }                                                                                                          \
    _Pragma("unroll") for (int i = 0; i < 2; ++i) {                                                            \
      const int id = tid + 256 * i, row = id >> 3, c16 = id & 7;                                               \
      pv[i] = u32x4{0u, 0u, 0u, 0u};                                                                           \
      if (c16 * 8 < lenx_) pv[i] = *(const u32x4*)(vT + ((size_t)cx_ * 1024 + h * 256 + sl * 64 + row) * 64 + c16 * 8); \
    }                                                                                                          \
    _Pragma("unroll") for (int mt = 0; mt < 2; ++mt)                                                           \
    _Pragma("unroll") for (int jj = 0; jj < 4; ++jj)                                                           \
      pdec[mt * 4 + jj] = decay[(size_t)cx_ * 512 + h * 128 + 32 * wave + mt * 16 + q * 4 + jj];               \
  }
    GLA_ISSUE(c0)
    for (int ci = 0; ci < nch; ++ci) {
      const int c = c0 + ci;
      int t0, len;
      chunk_info(c, t0, len);
      __syncthreads();
#pragma unroll
      for (int i = 0; i < 4; ++i) {
        const int id = tid + 256 * i, row = id >> 3, c16 = id & 7;
        *(u32x4*)(sKT + row * 72 + c16 * 8) = pk[i];
      }
#pragma unroll
      for (int i = 0; i < 2; ++i) {
        const int id = tid + 256 * i, row = id >> 3, c16 = id & 7;
        *(u32x4*)(sVT + row * 72 + c16 * 8) = pv[i];
      }
      float dec8[8];
#pragma unroll
      for (int e = 0; e < 8; ++e) dec8[e] = pdec[e];
      if (passB) {
#pragma unroll
        for (int i = 0; i < 4; ++i) {
          const int id = tid + 256 * i, row = id >> 4, c16 = id & 15;
          uint4 vq = uint4{0u, 0u, 0u, 0u}, vk = uint4{0u, 0u, 0u, 0u};
          if (row < len) {
            const size_t a = (size_t)(t0 + row) * 512 + h * 128 + c16 * 8;
            vq = *(const uint4*)(qd + a);
            vk = *(const uint4*)(kd + a);
          }
          *(uint4*)(sQ + row * 136 + c16 * 8) = vq;
          *(uint4*)(sK + row * 136 + c16 * 8) = vk;
        }
      }
      __syncthreads();
      if (ci + 1 < nch) GLA_ISSUE(c0 + ci + 1)
      if (passB) {
        f32x4 att[1][4];
#pragma unroll
        for (int nt = 0; nt < 4; ++nt) att[0][nt] = f32x4{0.f, 0.f, 0.f, 0.f};
        mma_lds<1, 4, 4>(att, sQ + (16 * wave) * 136, 136, sK, 136, r, q);
#pragma unroll
        for (int mt = 0; mt < 2; ++mt)
#pragma unroll
          for (int nt = 0; nt < 4; ++nt) {
            const int d0 = 32 * wave + mt * 16 + q * 4, v = nt * 16 + r;
            uint2 u;
            u.x = pack2(accS[mt][nt][0], accS[mt][nt][1]);
            u.y = pack2(accS[mt][nt][2], accS[mt][nt][3]);
            *(uint2*)(sS + v * 136 + d0) = u;
          }
        __syncthreads();
#pragma unroll
        for (int nt = 0; nt < 4; ++nt)
#pragma unroll
          for (int jj = 0; jj < 4; ++jj) {
            const int i = 16 * wave + q * 4 + jj, j = nt * 16 + r;
            sAtt[i * 72 + j] = f2bf(j <= i ? att[0][nt][jj] : 0.f);
          }
        __syncthreads();
        f32x4 o[1][4];
#pragma unroll
        for (int nt = 0; nt < 4; ++nt) o[0][nt] = f32x4{0.f, 0.f, 0.f, 0.f};
        mma_lds<1, 4, 2>(o, sAtt + (16 * wave) * 72, 72, sVT, 72, r, q);
        mma_lds<1, 4, 4>(o, sQ + (16 * wave) * 136, 136, sS, 136, r, q);
        float ss[4] = {0.f, 0.f, 0.f, 0.f};
#pragma unroll
        for (int nt = 0; nt < 4; ++nt)
#pragma unroll
          for (int jj = 0; jj < 4; ++jj) {
            const float ov = o[0][nt][jj];
            ss[jj] += ov * ov;
            const int i = 16 * wave + q * 4 + jj;
            if (i < len) obuf[(size_t)(t0 + i) * 1024 + h * 256 + sl * 64 + nt * 16 + r] = f2bf(ov);
          }
#pragma unroll
        for (int jj = 0; jj < 4; ++jj) {
          float s = ss[jj];
          s += __shfl_xor(s, 1);
          s += __shfl_xor(s, 2);
          s += __shfl_xor(s, 4);
          s += __shfl_xor(s, 8);
          const int i = 16 * wave + q * 4 + jj;
          if (r == 0 && i < len) ssq[(size_t)(t0 + i) * 16 + h * 4 + sl] = s;
        }
      }
      mma_lds<2, 4, 2>(accS, sKT + (32 * wave) * 72, 72, sVT, 72, r, q);
#pragma unroll
      for (int mt = 0; mt < 2; ++mt)
#pragma unroll
        for (int jj = 0; jj < 4; ++jj) {
          const float dec = dec8[mt * 4 + jj];
          dprod[mt * 4 + jj] *= dec;
#pragma unroll
          for (int nt = 0; nt < 4; ++nt) accS[mt][nt][jj] *= dec;
        }
    }
#undef GLA_ISSUE
    if (!passB && sl == 0 && r == 0) {
#pragma unroll
      for (int mt = 0; mt < 2; ++mt)
#pragma unroll
        for (int jj = 0; jj < 4; ++jj)
          ((float*)(P.ws + G_DSEG))[(size_t)sg * 512 + h * 128 + 32 * wave + mt * 16 + q * 4 + jj] = dprod[mt * 4 + jj];
    }
#pragma unroll
    for (int mt = 0; mt < 2; ++mt)
#pragma unroll
      for (int nt = 0; nt < 4; ++nt) {
        const int d0 = 32 * wave + mt * 16 + q * 4, v = sl * 64 + nt * 16 + r;
        if (!passB) {
          float4 t4;
          t4.x = accS[mt][nt][0]; t4.y = accS[mt][nt][1]; t4.z = accS[mt][nt][2]; t4.w = accS[mt][nt][3];
          *(float4*)(Sseg + ((size_t)(sg * 4 + h) * 256 + v) * 128 + d0) = t4;
        } else if (sg == NSEG_G - 1) {
#pragma unroll
          for (int jj = 0; jj < 4; ++jj)
            P.out[O_GLA_P + (((size_t)layer * 4 + h) * 128 + d0 + jj) * 256 + v] = accS[mt][nt][jj];
        } else if (sg >= NSEG_G) {
#pragma unroll
          for (int jj = 0; jj < 4; ++jj)
            P.out[O_GLA_S + ((((size_t)layer * 8 + b) * 4 + h) * 128 + d0 + jj) * 256 + v] = accS[mt][nt][jj];
        }
      }
  }
}

__device__ __forceinline__ void ph_gla_scan(const Params& P) {
  float* Sseg = (float*)(P.ws + G_SSEG);
  const float* dseg = (const float*)(P.ws + G_DSEG);
  for (int idx = blockIdx.x * 256 + otid(); idx < 4 * 256 * 128; idx += gridDim.x * 256) {
    const int h = idx >> 15, d = idx & 127;
    float tv[NSEG_G - 1], dv[NSEG_G - 1];
#pragma unroll
    for (int s2 = 0; s2 < NSEG_G - 1; ++s2) {
      tv[s2] = Sseg[(size_t)s2 * 131072 + idx];
      dv[s2] = dseg[(size_t)s2 * 512 + h * 128 + d];
    }
    float cur = 0.f;
#pragma unroll
    for (int s2 = 0; s2 < NSEG_G; ++s2) {
      Sseg[(size_t)s2 * 131072 + idx] = cur;
      if (s2 < NSEG_G - 1) cur = dv[s2] * cur + tv[s2];
    }
  }
}

__device__ __forceinline__ void ph_gla_aprep(const Params& P, int layer) {
  bf16_t* obuf = (bf16_t*)(P.ws + G_O);
  const bf16_t* g = (const bf16_t*)(P.ws + G_G);
  const float* ssq = (const float*)(P.ws + G_SSQ);
  const float* nw = P.in[12] + (size_t)layer * 256;
  for (int idx = blockIdx.x * 256 + otid(); idx < T * 128; idx += gridDim.x * 256) {
    const int t = idx >> 7, c8 = (idx & 127) * 8, hh = c8 >> 8;
    const float4 s4 = *(const float4*)(ssq + (size_t)t * 16 + hh * 4);
    const float rs = rsqrtf((s4.x + s4.y + s4.z + s4.w) * (1.f / 256.f) + EPS);
    const uint4 ov = *(const uint4*)(obuf + (size_t)t * 1024 + c8);
    const uint4 gv = *(const uint4*)(g + (size_t)t * 1024 + c8);
    const float4 w0 = *(const float4*)(nw + (c8 & 255));
    const float4 w1 = *(const float4*)(nw + (c8 & 255) + 4);
    uint4 res;
    res.x = pack2(lo_bf(ov.x) * rs * w0.x * silu_(lo_bf(gv.x)), hi_bf(ov.x) * rs * w0.y * silu_(hi_bf(gv.x)));
    res.y = pack2(lo_bf(ov.y) * rs * w0.z * silu_(lo_bf(gv.y)), hi_bf(ov.y) * rs * w0.w * silu_(hi_bf(gv.y)));
    res.z = pack2(lo_bf(ov.z) * rs * w1.x * silu_(lo_bf(gv.z)), hi_bf(ov.z) * rs * w1.y * silu_(hi_bf(gv.z)));
    res.w = pack2(lo_bf(ov.w) * rs * w1.z * silu_(lo_bf(gv.w)), hi_bf(ov.w) * rs * w1.w * silu_(hi_bf(gv.w)));
    *(uint4*)(obuf + (size_t)t * 1024 + c8) = res;
  }
}

__device__ __forceinline__ void ph_lru_pass(const bool passB, const Params& P, char* smem) {
  bf16_t* sRaw = (bf16_t*)smem;
  bf16_t* sXc = (bf16_t*)(smem + 11808);
  constexpr int SPS = 100, SPG = 64 * SPS;
  float* sP = (float*)(smem + 25120);
  float* sCst = (float*)(smem + 76320);
  const bf16_t* xb = (const bf16_t*)(P.ws + L_XB);
  const bf16_t* gate = (const bf16_t*)(P.ws + L_GATE);
  bf16_t* ybuf = (bf16_t*)(P.ws + L_Y);
  float* Asum = (float*)(P.ws + L_ASEG);
  float* Hsum = (float*)(P.ws + L_HSEG);
  const bf16_t* WG = (const bf16_t*)(P.ws + OFF_WG);
  const float* st_conv = P.in[3];
  const float* st_h = P.in[4];
  const int tid = otid(), lane = tid & 63, wave = tid >> 6, r = lane & 15, q = lane >> 4;
  const int NIT = NCH * 16;
  const int per = (NIT + (int)gridDim.x - 1) / (int)gridDim.x;
  const int it_lo = blockIdx.x * per;
  const int it_hi = it_lo + per < NIT ? it_lo + per : NIT;
  const int gt = wave >> 1, mh = wave & 1;
  int kprev = -1;
  bf16x8 bw[3][6];
#pragma unroll
  for (int ks = 0; ks < 3; ++ks)
#pragma unroll
    for (int nt = 0; nt < 6; ++nt) bw[ks][nt] = bf16x8{0, 0, 0, 0, 0, 0, 0, 0};
  const int cg8 = tid % 11, crow = tid / 11;
  const int gg4 = tid % 22, grow = tid / 22;
  float cw[5][8];
  float gc[3][4];
#pragma unroll
  for (int a_ = 0; a_ < 5; ++a_)
#pragma unroll
    for (int e = 0; e < 8; ++e) cw[a_][e] = 0.f;
#pragma unroll
  for (int a_ = 0; a_ < 3; ++a_)
#pragma unroll
    for (int e = 0; e < 4; ++e) gc[a_][e] = 0.f;
  for (int idx = tid; idx < 64 * 8; idx += 256) sXc[(idx >> 3) * 104 + 88 + (idx & 7)] = 0;
  for (int it = it_lo; it < it_hi; ++it) {
    const int k = it / NCH, c = it - k * NCH;
    int t0, len;
    chunk_info(c, t0, len);
    const int b = c - 256;
    const bool has_prev = (c < 256) && (c > 0);
    const int ch = k * 88 + tid;
    u32x4 rraw[3], rgate[3];
#pragma unroll
    for (int i = 0; i < 3; ++i) {
      const int idx = tid + 256 * i, row = idx / 11, c16 = idx - row * 11;
      rraw[i] = u32x4{0u, 0u, 0u, 0u};
      rgate[i] = u32x4{0u, 0u, 0u, 0u};
      if (row < len + 3) {
        if (row >= 3 || has_prev) {
          rraw[i] = *(const u32x4*)(xb + (size_t)(t0 + row - 3) * LW + k * 88 + c16 * 8);
        } else if (c >= 256) {
          const float* sp = st_conv + ((size_t)b * 3 + row) * LW + k * 88 + c16 * 8;
          const float4 f0 = *(const float4*)sp, f1 = *(const float4*)(sp + 4);
          rraw[i] = u32x4{pack2(f0.x, f0.y), pack2(f0.z, f0.w), pack2(f1.x, f1.y), pack2(f1.z, f1.w)};
        }
      }
      if (passB && row < len) rgate[i] = *(const u32x4*)(gate + (size_t)(t0 + row) * LW + k * 88 + c16 * 8);
    }
    float hcur = 0.f, aprod = 1.f;
    if (passB && tid < 88) hcur = c < 256 ? Hsum[(size_t)c * LW + ch] : st_h[b * LW + ch];
    __syncthreads();
    if (k != kprev) {
      if (tid < 88) {
        sCst[0 * 96 + tid] = -8.f * softplus_(-P.in[21][ch]);
        sCst[1 * 96 + tid] = P.in[18][ch];
        sCst[2 * 96 + tid] = P.in[20][ch];
        sCst[3 * 96 + tid] = P.in[16][ch];
        sCst[4 * 96 + tid] = P.in[15][0 * LW + ch];
        sCst[5 * 96 + tid] = P.in[15][1 * LW + ch];
        sCst[6 * 96 + tid] = P.in[15][2 * LW + ch];
        sCst[7 * 96 + tid] = P.in[15][3 * LW + ch];
      }
      const bf16_t* Wt = WG + ((size_t)(gt * 16 + k) * 96) * 96;
#pragma unroll
      for (int ks = 0; ks < 3; ++ks)
#pragma unroll
        for (int nt = 0; nt < 6; ++nt) bw[ks][nt] = *(const bf16x8*)(Wt + (nt * 16 + r) * 96 + ks * 32 + q * 8);
    }
#pragma unroll
    for (int i = 0; i < 3; ++i) {
      const int idx = tid + 256 * i, row = idx / 11, c16 = idx - row * 11;
      if (row < 67) *(u32x4*)(sRaw + row * 88 + c16 * 8) = rraw[i];
    }
    __syncthreads();
    if (k != kprev) {
#pragma unroll
      for (int a_ = 0; a_ < 5; ++a_)
#pragma unroll
        for (int e = 0; e < 8; ++e) cw[a_][e] = sCst[(3 + a_) * 96 + cg8 * 8 + e];
#pragma unroll
      for (int a_ = 0; a_ < 3; ++a_)
#pragma unroll
        for (int e = 0; e < 4; ++e) gc[a_][e] = sCst[a_ * 96 + gg4 * 4 + e];
      kprev = k;
    }
    if (crow < 23) {
#pragma unroll
      for (int i = 0; i < 3; ++i) {
        const int j = crow + 23 * i;
        if (j < 64) {
          u32x4 o = u32x4{0u, 0u, 0u, 0u};
          if (j < len) {
            u32x4 rr[4];
#pragma unroll
            for (int kk = 0; kk < 4; ++kk) rr[kk] = *(const u32x4*)(sRaw + (j + kk) * 88 + cg8 * 8);
            float xc[8];
#pragma unroll
            for (int e = 0; e < 8; ++e) {
              float acc_ = cw[0][e];
#pragma unroll
              for (int kk = 0; kk < 4; ++kk) {
                const unsigned w_ = rr[kk][e >> 1];
                acc_ += cw[1 + kk][e] * ((e & 1) ? hi_bf(w_) : lo_bf(w_));
              }
              xc[e] = acc_;
            }
            o = u32x4{pack2(xc[0], xc[1]), pack2(xc[2], xc[3]), pack2(xc[4], xc[5]), pack2(xc[6], xc[7])};
          }
          *(u32x4*)(sXc + j * 104 + cg8 * 8) = o;
        }
      }
    }
    __syncthreads();
    {
      f32x4 acc[2][6];
#pragma unroll
      for (int mt = 0; mt < 2; ++mt)
#pragma unroll
        for (int nt = 0; nt < 6; ++nt) acc[mt][nt] = f32x4{0.f, 0.f, 0.f, 0.f};
#pragma unroll
      for (int ks = 0; ks < 3; ++ks) {
        bf16x8 af[2];
#pragma unroll
        for (int mt = 0; mt < 2; ++mt) af[mt] = *(const bf16x8*)(sXc + (32 * mh + mt * 16 + r) * 104 + ks * 32 + q * 8);
#pragma unroll
        for (int mt = 0; mt < 2; ++mt)
#pragma unroll
          for (int nt = 0; nt < 6; ++nt)
            acc[mt][nt] = __builtin_amdgcn_mfma_f32_16x16x32_bf16(bw[ks][nt], af[mt], acc[mt][nt], 0, 0, 0);
      }
#pragma unroll
      for (int mt = 0; mt < 2; ++mt)
#pragma unroll
        for (int nt = 0; nt < 6; ++nt)
          *(f32x4*)(sP + gt * SPG + (32 * mh + mt * 16 + r) * SPS + nt * 16 + q * 4) = acc[mt][nt];
    }
    __syncthreads();
    if (grow < 11) {
#pragma unroll
      for (int i = 0; i < 6; ++i) {
        const int j = grow + 11 * i;
        if (j < len) {
          const f32x4 pr = *(const f32x4*)(sP + j * SPS + gg4 * 4);
          const f32x4 pi = *(const f32x4*)(sP + SPG + j * SPS + gg4 * 4);
          const uint2 xu = *(const uint2*)(sXc + j * 104 + gg4 * 4);
          float xv[4];
          xv[0] = lo_bf(xu.x); xv[1] = hi_bf(xu.x); xv[2] = lo_bf(xu.y); xv[3] = hi_bf(xu.y);
          f32x4 av, uv;
#pragma unroll
          for (int e = 0; e < 4; ++e) {
            const float rr_ = sigmoid_(pr[e] + gc[1][e]), ii_ = sigmoid_(pi[e] + gc[2][e]);
            const float a = __expf(gc[0][e] * rr_);
            const float m = __builtin_amdgcn_sqrtf(fmaxf(1.f - a * a, 0.f));
            av[e] = a;
            uv[e] = m * ii_ * xv[e];
          }
          *(f32x4*)(sP + j * SPS + gg4 * 4) = av;
          *(f32x4*)(sP + SPG + j * SPS + gg4 * 4) = uv;
        }
      }
    }
    __syncthreads();
    if (tid < 88) {
#pragma unroll 8
      for (int j = 0; j < len; ++j) {
        const float a = sP[j * SPS + tid], u = sP[SPG + j * SPS + tid];
        hcur = a * hcur + u;
        aprod *= a;
        if (passB) sP[SPG + j * SPS + tid] = hcur;
      }
      if (!passB) {
        Asum[(size_t)c * LW + ch] = aprod;
        Hsum[(size_t)c * LW + ch] = hcur;
      } else if (c == 255) {
        P.out[O_LH_P + ch] = hcur;
#pragma unroll
        for (int kk = 0; kk < 3; ++kk) P.out[O_LCONV_P + kk * LW + ch] = bf2f(sRaw[(len + kk) * 88 + tid]);
      } else if (c >= 256) {
        P.out[O_LH_S + b * LW + ch] = hcur;
#pragma unroll
        for (int kk = 0; kk < 3; ++kk) P.out[O_LCONV_S + ((size_t)b * 3 + kk) * LW + ch] = bf2f(sRaw[(len + kk) * 88 + tid]);
      }
    }
    if (passB) {
      __syncthreads();
#pragma unroll
      for (int i = 0; i < 3; ++i) {
        const int idx = tid + 256 * i, row = idx / 11, c16 = idx - row * 11;
        if (row < len) {
          const float4 h0 = *(const float4*)(sP + SPG + row * SPS + c16 * 8);
          const float4 h1 = *(const float4*)(sP + SPG + row * SPS + c16 * 8 + 4);
          const u32x4 gv = rgate[i];
          u32x4 o;
          o[0] = pack2(h0.x * silu_(lo_bf(gv[0])), h0.y * silu_(hi_bf(gv[0])));
          o[1] = pack2(h0.z * silu_(lo_bf(gv[1])), h0.w * silu_(hi_bf(gv[1])));
          o[2] = pack2(h1.x * silu_(lo_bf(gv[2])), h1.y * silu_(hi_bf(gv[2])));
          o[3] = pack2(h1.z * silu_(lo_bf(gv[3])), h1.w * silu_(hi_bf(gv[3])));
          *(u32x4*)(ybuf + (size_t)(t0 + row) * LW + k * 88 + c16 * 8) = o;
        }
      }
    }
  }
}

__device__ __forceinline__ void ph_lru_scan(const Params& P, char* smem) {
  float* sA = (float*)smem;
  float* sH = sA + 256;
  const float* Asum = (const float*)(P.ws + L_ASEG);
  float* Hsum = (float*)(P.ws + L_HSEG);
  const int tid = otid(), seg = tid >> 4, chl = tid & 15;
  for (int it = blockIdx.x; it < LW / 16; it += gridDim.x) {
    const int ch = it * 16 + chl;
    float a[16], h[16];
#pragma unroll
    for (int i = 0; i < 16; ++i) {
      a[i] = Asum[(size_t)(seg * 16 + i) * LW + ch];
      h[i] = Hsum[(size_t)(seg * 16 + i) * LW + ch];
    }
    float A = 1.f, H = 0.f;
#pragma unroll
    for (int i = 0; i < 16; ++i) { H = a[i] * H + h[i]; A *= a[i]; }
    __syncthreads();
    sA[seg * 16 + chl] = A;
    sH[seg * 16 + chl] = H;
    __syncthreads();
    float hin = 0.f;
    for (int s2 = 0; s2 < seg; ++s2) hin = sA[s2 * 16 + chl] * hin + sH[s2 * 16 + chl];
#pragma unroll
    for (int i = 0; i < 16; ++i) {
      Hsum[(size_t)(seg * 16 + i) * LW + ch] = hin;
      hin = a[i] * hin + h[i];
    }
  }
}

__device__ __forceinline__ void ph_ssd_conv(const Params& P) {
  bf16_t* xbcT = (bf16_t*)(P.ws + S_XBCT);
  const bf16_t* tails = (const bf16_t*)(P.ws + S_TAIL);
  bf16_t* Brm = (bf16_t*)(P.ws + S_BRM);
  bf16_t* Crm = (bf16_t*)(P.ws + S_CRM);
  const float* cw = P.in[24];
  const float* cb = P.in[25];
  const float* st_conv = P.in[5];
  const int tid = otid();
  for (int it = blockIdx.x; it < NCH * 12; it += gridDim.x) {
    const int c = it / 12, part = it - c * 12, cc = part * 256 + tid;
    int t0, len;
    chunk_info(c, t0, len);
    const float w0 = cw[cc], w1 = cw[3072 + cc], w2 = cw[2 * 3072 + cc], w3 = cw[3 * 3072 + cc], bias = cb[cc];
    float a0 = 0.f, a1 = 0.f, a2 = 0.f;
    if (c >= 256) {
      const int b = c - 256;
      a0 = st_conv[((size_t)b * 3 + 0) * 3072 + cc];
      a1 = st_conv[((size_t)b * 3 + 1) * 3072 + cc];
      a2 = st_conv[((size_t)b * 3 + 2) * 3072 + cc];
    } else if (c > 0) {
      const uint2 tv = *(const uint2*)(tails + ((size_t)(c - 1) * 3072 + cc) * 4);
      a0 = hi_bf(tv.x); a1 = lo_bf(tv.y); a2 = hi_bf(tv.y);
    }
    bf16_t* rowp = xbcT + ((size_t)c * 3072 + cc) * 64;
    bf16_t* rm = nullptr;
    if (cc >= 2560) rm = Crm + (cc - 2560);
    else if (cc >= 2048) rm = Brm + (cc - 2048);
    u32x4 rw[8];
#pragma unroll
    for (int g = 0; g < 8; ++g) {
      rw[g] = u32x4{0u, 0u, 0u, 0u};
      if (g * 8 < len) rw[g] = *(const u32x4*)(rowp + g * 8);
    }
#pragma unroll
    for (int g = 0; g < 8; ++g) {
      if (g * 8 < len) {
        const int g8 = g * 8;
        const u32x4 u = rw[g];
        float x[8], y[8];
        x[0] = lo_bf(u[0]); x[1] = hi_bf(u[0]); x[2] = lo_bf(u[1]); x[3] = hi_bf(u[1]);
        x[4] = lo_bf(u[2]); x[5] = hi_bf(u[2]); x[6] = lo_bf(u[3]); x[7] = hi_bf(u[3]);
#pragma unroll
        for (int e = 0; e < 8; ++e) {
          const float yy = bias + w0 * a0 + w1 * a1 + w2 * a2 + w3 * x[e];
          a0 = a1; a1 = a2; a2 = x[e];
          y[e] = silu_(yy);
        }
        *(u32x4*)(rowp + g8) = u32x4{pack2(y[0], y[1]), pack2(y[2], y[3]), pack2(y[4], y[5]), pack2(y[6], y[7])};
        if (rm) {
#pragma unroll
          for (int e = 0; e < 8; ++e) rm[(size_t)(t0 + g8 + e) * 512] = f2bf(y[e]);
        }
      }
    }
    if (c >= 255) {
      const uint2 tv = *(const uint2*)(tails + ((size_t)c * 3072 + cc) * 4);
      float* dst = c == 255 ? P.out + O_SCONV_P : P.out + O_SCONV_S + (size_t)(c - 256) * 3 * 3072;
      dst[0 * 3072 + cc] = hi_bf(tv.x);
      dst[1 * 3072 + cc] = lo_bf(tv.y);
      dst[2 * 3072 + cc] = hi_bf(tv.y);
    }
  }
}

__device__ __forceinline__ void ph_ssd_pass(const bool passB, const Params& P, char* smem) {
  bf16_t* sC = (bf16_t*)(smem);
  bf16_t* sBT = (bf16_t*)(smem + 17408);
  bf16_t* sXT = (bf16_t*)(smem + 35840);
  bf16_t* sS = (bf16_t*)(smem + 45056);
  bf16_t* sXW = (bf16_t*)(smem + 62464);
  bf16_t* sW = (bf16_t*)(smem + 71680);
  bf16_t* sB = sXW;
  float* sCum = (float*)(smem + 80896);
  float* sDt = sCum + 64;
  bf16_t* zbuf = (bf16_t*)(P.ws + S_Z);
  const bf16_t* xbcT = (const bf16_t*)(P.ws + S_XBCT);
  const bf16_t* Brm = (const bf16_t*)(P.ws + S_BRM);
  const bf16_t* Crm = (const bf16_t*)(P.ws + S_CRM);
  const float* dtb = (const float*)(P.ws + S_DT);
  float* ssq = (float*)(P.ws + S_SSQ);
  float* Sseg = (float*)(P.ws + S_SSEG);
  float* cdseg = (float*)(P.ws + S_CDSEG);
  const float* st_in = P.in[6];
  const int tid = otid(), lane = tid & 63, wave = tid >> 6, r = lane & 15, q = lane >> 4;
  const int nitems = passB ? NSEGT_S * 32 : (NSEG_S - 1) * 32;
  for (int it = blockIdx.x; it < nitems; it += gridDim.x) {
    const int sg = it >> 5, hd = it & 31, g = hd >> 3;
    int c0, nch, b;
    seg_info(sg, NSEG_S, c0, nch, b);
    const float Ah = -__expf(P.in[27][hd]);
    const float Dh = P.in[28][hd];
    f32x4 accS[2][4];
#pragma unroll
    for (int mt = 0; mt < 2; ++mt)
#pragma unroll
      for (int nt = 0; nt < 4; ++nt) {
        const int s0 = 32 * wave + mt * 16 + q * 4, p = nt * 16 + r;
        if (!passB) accS[mt][nt] = f32x4{0.f, 0.f, 0.f, 0.f};
        else {
          const float* src = sg < NSEG_S ? Sseg + (((size_t)sg * 32 + hd) * 64 + p) * 128 + s0
                                       : st_in + (((size_t)b * 32 + hd) * 64 + p) * 128 + s0;
          const float4 t4 = *(const float4*)src;
          accS[mt][nt] = f32x4{t4.x, t4.y, t4.z, t4.w};
        }
      }
    float totcum = 0.f;
    u32x4 pb[4], px[2];
    float pdt = 0.f;
    const float dtbias = P.in[26][hd];
#define SSD_ISSUE(cc_)                                                                                          \
  {                                                                                                             \
    const int cx_ = (cc_);                                                                                      \
    const int lenx_ = cx_ < 256 ? 64 : 16;                                                                      \
    const int t0x_ = cx_ < 256 ? cx_ * 64 : T_P + (cx_ - 256) * 16;                                             \
    _Pragma("unroll") for (int i = 0; i < 4; ++i) {                                                             \
      const int id = tid + 256 * i, row = id >> 3, c16 = id & 7;                                                \
      pb[i] = u32x4{0u, 0u, 0u, 0u};                                                                            \
      if (c16 * 8 < lenx_) pb[i] = *(const u32x4*)(xbcT + ((size_t)cx_ * 3072 + 2048 + g * 128 + row) * 64 + c16 * 8); \
    }                                                                                                           \
    _Pragma("unroll") for (int i = 0; i < 2; ++i) {                                                             \
      const int id = tid + 256 * i, row = id >> 3, c16 = id & 7;                                                \
      px[i] = u32x4{0u, 0u, 0u, 0u};                                                                            \
      if (c16 * 8 < lenx_) px[i] = *(const u32x4*)(xbcT + ((size_t)cx_ * 3072 + hd * 64 + row) * 64 + c16 * 8);  \
    }                                                                                                           \
    pdt = 0.f;                                                                                                  \
    if (wave == 0 && lane < lenx_) pdt = dtb[(size_t)(t0x_ + lane) * 32 + hd];                                  \
  }
    SSD_ISSUE(c0)
    for (int ci = 0; ci < nch; ++ci) {
      const int c = c0 + ci;
      int t0, len;
      chunk_info(c, t0, len);
      __syncthreads();
      if (wave == 0) {
        const float dtv = lane < len ? softplus_(pdt + dtbias) : 0.f;
        float x = dtv * Ah;
#pragma unroll
        for (int off = 1; off < 64; off <<= 1) {
          const float y = __shfl_up(x, off);
          if (lane >= off) x += y;
        }
        sCum[lane] = x;
        sDt[lane] = dtv;
      }
#pragma unroll
      for (int i = 0; i < 4; ++i) {
        const int id = tid + 256 * i, row = id >> 3, c16 = id & 7;
        *(u32x4*)(sBT + row * 72 + c16 * 8) = pb[i];
      }
#pragma unroll
      for (int i = 0; i < 2; ++i) {
        const int id = tid + 256 * i, row = id >> 3, c16 = id & 7;
        *(u32x4*)(sXT + row * 72 + c16 * 8) = px[i];
      }
      if (passB) {
#pragma unroll
        for (int i = 0; i < 4; ++i) {
          const int id = tid + 256 * i, row = id >> 4, c16 = id & 15;
          uint4 vc = uint4{0u, 0u, 0u, 0u}, vb = uint4{0u, 0u, 0u, 0u};
          if (row < len) {
            const size_t a = (size_t)(t0 + row) * 512 + g * 128 + c16 * 8;
            vc = *(const uint4*)(Crm + a);
            vb = *(const uint4*)(Brm + a);
          }
          *(uint4*)(sC + row * 136 + c16 * 8) = vc;
          *(uint4*)(sB + row * 136 + c16 * 8) = vb;
        }
      }
      __syncthreads();
      if (ci + 1 < nch) SSD_ISSUE(c0 + ci + 1)
      const float cumlast = sCum[63];
      f32x4 cbm[1][4];
      if (passB) {
#pragma unroll
        for (int nt = 0; nt < 4; ++nt) cbm[0][nt] = f32x4{0.f, 0.f, 0.f, 0.f};
        mma_lds<1, 4, 4>(cbm, sC + (16 * wave) * 136, 136, sB, 136, r, q);
#pragma unroll
        for (int mt = 0; mt < 2; ++mt)
#pragma unroll
          for (int nt = 0; nt < 4; ++nt) {
            const int s0 = 32 * wave + mt * 16 + q * 4, p = nt * 16 + r;
            uint2 u;
            u.x = pack2(accS[mt][nt][0], accS[mt][nt][1]);
            u.y = pack2(accS[mt][nt][2], accS[mt][nt][3]);
            *(uint2*)(sS + p * 136 + s0) = u;
          }
        __syncthreads();
#pragma unroll
        for (int nt = 0; nt < 4; ++nt)
#pragma unroll
          for (int jj = 0; jj < 4; ++jj) {
            const int i = 16 * wave + q * 4 + jj, j = nt * 16 + r;
            float wv = 0.f;
            if (j <= i) wv = cbm[0][nt][jj] * __expf(sCum[i] - sCum[j]) * sDt[j];
            sW[i * 72 + j] = f2bf(wv);
          }
      }
#pragma unroll
      for (int i = 0; i < 2; ++i) {
        const int id = tid + 256 * i, p = id >> 3, j0 = (id & 7) * 8;
        const uint4 u = *(const uint4*)(sXT + p * 72 + j0);
        float wb[8];
#pragma unroll
        for (int e = 0; e < 8; ++e) wb[e] = __expf(cumlast - sCum[j0 + e]) * sDt[j0 + e];
        uint4 o;
        o.x = pack2(lo_bf(u.x) * wb[0], hi_bf(u.x) * wb[1]);
        o.y = pack2(lo_bf(u.y) * wb[2], hi_bf(u.y) * wb[3]);
        o.z = pack2(lo_bf(u.z) * wb[4], hi_bf(u.z) * wb[5]);
        o.w = pack2(lo_bf(u.w) * wb[6], hi_bf(u.w) * wb[7]);
        *(uint4*)(sXW + p * 72 + j0) = o;
      }
      __syncthreads();
      if (passB) {
        f32x4 y1[1][4], y2[1][4];
#pragma unroll
        for (int nt = 0; nt < 4; ++nt) { y1[0][nt] = f32x4{0.f, 0.f, 0.f, 0.f}; y2[0][nt] = f32x4{0.f, 0.f, 0.f, 0.f}; }
        mma_lds<1, 4, 2>(y1, sW + (16 * wave) * 72, 72, sXT, 72, r, q);
        mma_lds<1, 4, 4>(y2, sC + (16 * wave) * 136, 136, sS, 136, r, q);
        float ss[4] = {0.f, 0.f, 0.f, 0.f};
        float ec[4];
#pragma unroll
        for (int jj = 0; jj < 4; ++jj) ec[jj] = __expf(sCum[16 * wave + q * 4 + jj]);
#pragma unroll
        for (int nt = 0; nt < 4; ++nt) {
          const int p = nt * 16 + r;
          const uint2 xu = *(const uint2*)(sXT + p * 72 + 16 * wave + q * 4);
          float xv[4];
          xv[0] = lo_bf(xu.x); xv[1] = hi_bf(xu.x); xv[2] = lo_bf(xu.y); xv[3] = hi_bf(xu.y);
#pragma unroll
          for (int jj = 0; jj < 4; ++jj) {
            const int i = 16 * wave + q * 4 + jj;
            if (i < len) {
              const float yv = y1[0][nt][jj] + ec[jj] * y2[0][nt][jj] + Dh * xv[jj];
              const size_t a = (size_t)(t0 + i) * 2048 + hd * 64 + p;
              const float yz = yv * silu_(bf2f(zbuf[a]));
              zbuf[a] = f2bf(yz);
              ss[jj] += yz * yz;
            }
          }
        }
#pragma unroll
        for (int jj = 0; jj < 4; ++jj) {
          float s = ss[jj];
          s += __shfl_xor(s, 1);
          s += __shfl_xor(s, 2);
          s += __shfl_xor(s, 4);
          s += __shfl_xor(s, 8);
          const int i = 16 * wave + q * 4 + jj;
          if (r == 0 && i < len) ssq[(size_t)(t0 + i) * 32 + hd] = s;
        }
      }
      {
        const float cd = __expf(cumlast);
#pragma unroll
        for (int mt = 0; mt < 2; ++mt)
#pragma unroll
          for (int nt = 0; nt < 4; ++nt)
#pragma unroll
            for (int jj = 0; jj < 4; ++jj) accS[mt][nt][jj] *= cd;
        mma_lds<2, 4, 2>(accS, sBT + (32 * wave) * 72, 72, sXW, 72, r, q);
        totcum += cumlast;
      }
    }
#pragma unroll
    for (int mt = 0; mt < 2; ++mt)
#pragma unroll
      for (int nt = 0; nt < 4; ++nt) {
        const int s0 = 32 * wave + mt * 16 + q * 4, p = nt * 16 + r;
        float4 t4;
        t4.x = accS[mt][nt][0]; t4.y = accS[mt][nt][1]; t4.z = accS[mt][nt][2]; t4.w = accS[mt][nt][3];
        if (!passB) *(float4*)(Sseg + (((size_t)sg * 32 + hd) * 64 + p) * 128 + s0) = t4;
        else if (sg == NSEG_S - 1) *(float4*)(P.out + O_SH_P + ((size_t)hd * 64 + p) * 128 + s0) = t4;
        else if (sg >= NSEG_S) *(float4*)(P.out + O_SH_S + (((size_t)b * 32 + hd) * 64 + p) * 128 + s0) = t4;
      }
#undef SSD_ISSUE
    if (!passB && tid == 0) cdseg[sg * 32 + hd] = __expf(totcum);
  }
}

__device__ __forceinline__ void ph_ssd_scan(const Params& P) {
  float* Sseg = (float*)(P.ws + S_SSEG);
  const float* cdseg = (const float*)(P.ws + S_CDSEG);
  for (int idx = blockIdx.x * 256 + otid(); idx < 32 * 64 * 128; idx += gridDim.x * 256) {
    const int hd = idx >> 13;
    float tv[NSEG_S - 1], dv[NSEG_S - 1];
#pragma unroll
    for (int s2 = 0; s2 < NSEG_S - 1; ++s2) {
      tv[s2] = Sseg[(size_t)s2 * 262144 + idx];
      dv[s2] = cdseg[s2 * 32 + hd];
    }
    float cur = 0.f;
#pragma unroll
    for (int s2 = 0; s2 < NSEG_S; ++s2) {
      Sseg[(size_t)s2 * 262144 + idx] = cur;
      if (s2 < NSEG_S - 1) cur = dv[s2] * cur + tv[s2];
    }
  }
}

constexpr size_t OFF_BAR = 268435456ull - 4096;
#define XB_CNT(x) (32 + 32 * (x))
#define XB_SUB(x) (320 + 32 * (x))
#define XB_GEN(x) (608 + 32 * (x))
#define XB_TOP 896
#define XB_TOPGEN 928
__device__ __forceinline__ unsigned xb_ld(unsigned* p) { return __hip_atomic_load(p, __ATOMIC_RELAXED, __HIP_MEMORY_SCOPE_AGENT); }
__device__ __forceinline__ unsigned xb_add(unsigned* p, unsigned v) { return __hip_atomic_fetch_add(p, v, __ATOMIC_RELAXED, __HIP_MEMORY_SCOPE_AGENT); }
__device__ __forceinline__ void grid_barrier(unsigned* bar, char* smem) {
  asm volatile("s_waitcnt vmcnt(0)" ::: "memory");
  __syncthreads();
  if (otid() == 0) {
    volatile unsigned* st = (volatile unsigned*)(smem + SMEM_XB);
    const unsigned x = st[2];
    unsigned nloc = st[0], nx = st[1];
    if (nloc == 0u) {
      const unsigned G = gridDim.x;
      for (;;) {
        unsigned sum = 0u, cnt = 0u, mine = 0u;
#pragma unroll
        for (unsigned j = 0; j < 8; ++j) {
          const unsigned c = xb_ld(&bar[XB_CNT(j)]);
          sum += c;
          cnt += (c > 0u) ? 1u : 0u;
          mine = (j == x) ? c : mine;
        }
        if (sum == G) { nloc = mine; nx = cnt; break; }
        __builtin_amdgcn_s_sleep(1);
      }
      st[0] = nloc;
      st[1] = nx;
    }
    const unsigned old = xb_add(&bar[XB_SUB(x)], 1u);
    const unsigned gen = old / nloc;
    if (old + 1u == (gen + 1u) * nloc) {
      __builtin_amdgcn_fence(__ATOMIC_RELEASE, "agent");
      asm volatile("s_waitcnt vmcnt(0)" ::: "memory");
      const unsigned og = xb_add(&bar[XB_TOP], 1u);
      const unsigned tg = og / nx;
      if (og + 1u == (tg + 1u) * nx) xb_add(&bar[XB_TOPGEN], 1u);
      else while (xb_ld(&bar[XB_TOPGEN]) == tg) __builtin_amdgcn_s_sleep(1);
      __builtin_amdgcn_fence(__ATOMIC_ACQUIRE, "agent");
      xb_add(&bar[XB_GEN(x)], 1u);
      asm volatile("s_waitcnt vmcnt(0)" ::: "memory");
    } else {
      while (xb_ld(&bar[XB_GEN(x)]) == gen) __builtin_amdgcn_s_sleep(1);
      __builtin_amdgcn_fence(__ATOMIC_ACQUIRE, "agent");
      asm volatile("s_waitcnt vmcnt(0)" ::: "memory");
    }
  }
  __syncthreads();
}

constexpr int NPH = 30;

__device__ __forceinline__ void run_gla(const int sub, const int layer, const int li, const Params& P, char* smem) {
  const float* xin_p = li == 0 ? P.in[0] : P.out + O_YP;
  const float* xin_s = li == 0 ? P.in[1] : P.out + O_YS;
  bf16_t* Win = (bf16_t*)(P.ws + OFF_WIN);
  bf16_t* Wout = (bf16_t*)(P.ws + (layer == 0 ? OFF_WOUT : OFF_WOUT1));
  bf16_t* H = (bf16_t*)(P.ws + OFF_H);
  switch (sub) {
    case 0:
      if (li == 0) {
        ph_convT(P.in[9], 1024, 3088, 3136, Win, nullptr, smem);
        ph_convT(P.in[13], 1024, 1024, 1024, Wout, nullptr, smem);
      }
      ph_norm(xin_p, xin_s, P.in[7] + li * 1024, H, li == 0 ? P.out : nullptr);
      break;
    case 1: {
      EpiGlaIn e{(bf16_t*)(P.ws + G_QD), (bf16_t*)(P.ws + G_KD), (bf16_t*)(P.ws + G_VT), (bf16_t*)(P.ws + G_G),
                 (float*)(P.ws + G_GLR)};
      gemm_phase(H, 1024, Win, 1024, 1024, 3088, e, smem);
    } break;
    case 2: ph_gla_prep(P, layer, smem); break;
    case 3: ph_gla_pass(false, layer, P, smem); break;
    case 4:
      ph_gla_scan(P);
      if (layer == 0) {
        ph_convT(P.in[14], 1024, 2816, 2816, Win, nullptr, smem);
        ph_convT(P.in[22], 1408, 1024, 1024, (bf16_t*)(P.ws + OFF_WOUT1), nullptr, smem);
        ph_conv_gate(P.in[17], (bf16_t*)(P.ws + OFF_WG));
        ph_conv_gate(P.in[19], (bf16_t*)(P.ws + OFF_WG) + 16 * 96 * 96);
      }
      break;
    case 5: ph_gla_pass(true, layer, P, smem); break;
    case 6: ph_gla_aprep(P, layer); break;
    case 7: {
      EpiResid e{xin_p, xin_s, P.out};
      gemm_phase((const bf16_t*)(P.ws + G_O), 1024, Wout, 1024, 1024, 1024, e, smem);
    } break;
  }
}

__device__ __forceinline__ void run_phase(const int ph, const Params& P, char* smem) {
  bf16_t* Win = (bf16_t*)(P.ws + OFF_WIN);
  bf16_t* Wout = (bf16_t*)(P.ws + OFF_WOUT);
  bf16_t* H = (bf16_t*)(P.ws + OFF_H);
  const float* xin_p = P.out + O_YP;
  const float* xin_s = P.out + O_YS;
  if (ph < 8) { run_gla(ph, 0, 0, P, smem); return; }
  if (ph >= 21 && ph < 29) { run_gla(ph - 21, 1, 3, P, smem); return; }
  switch (ph) {
    case 8:
      ph_norm(xin_p, xin_s, P.in[7] + 1 * 1024, H, nullptr);
      break;
    case 9: {
      EpiLruIn e{(bf16_t*)(P.ws + L_XB), (bf16_t*)(P.ws + L_GATE)};
      gemm_phase(H, 1024, Win, 1024, 1024, 2816, e, smem);
    } break;
    case 10: ph_lru_pass(false, P, smem); break;
    case 11:
      ph_lru_scan(P, smem);
      ph_convT(P.in[23], 1024, 5152, 5184, Win, nullptr, smem);
      ph_convT(P.in[30], 2048, 1024, 1024, Wout, P.in[29], smem);
      break;
    case 12: ph_lru_pass(true, P, smem); break;
    case 13: {
      EpiResid e{xin_p, xin_s, P.out};
      gemm_phase((const bf16_t*)(P.ws + L_Y), LW, (const bf16_t*)(P.ws + OFF_WOUT1), LW, LW, 1024, e, smem);
    } break;
    case 14:
      ph_norm(xin_p, xin_s, P.in[7] + 2 * 1024, H, nullptr);
      break;
    case 15: {
      EpiSsdIn e{(bf16_t*)(P.ws + S_Z), (bf16_t*)(P.ws + S_XBCT), (bf16_t*)(P.ws + S_TAIL), (float*)(P.ws + S_DT), P.in[26]};
      gemm_phase(H, 1024, Win, 1024, 1024, 5152, e, smem);
    } break;
    case 16: ph_ssd_conv(P); break;
    case 17: ph_ssd_pass(false, P, smem); break;
    case 18:
      ph_ssd_scan(P);
      ph_convT(P.in[9] + (size_t)1024 * 3088, 1024, 3088, 3136, Win, nullptr, smem);
      ph_convT(P.in[13] + (size_t)1024 * 1024, 1024, 1024, 1024, (bf16_t*)(P.ws + OFF_WOUT1), nullptr, smem);
      break;
    case 19: ph_ssd_pass(true, P, smem); break;
    case 20: {
      EpiResidScaled e{xin_p, xin_s, P.out, (const float*)(P.ws + S_SSQ), 0.f, 0.f, 0};
      gemm_phase((const bf16_t*)(P.ws + S_Z), 2048, Wout, 2048, 2048, 1024, e, smem);
    } break;
    case 29: ph_final_norm(P.out, P.in[8]); break;
    default: break;
  }
}

__global__ void __launch_bounds__(256, 2) mega(Params P) {
  __shared__ __attribute__((aligned(16))) char smem[SMEM_BYTES];
  unsigned* bar = (unsigned*)(P.ws + OFF_BAR);
  if (threadIdx.x == 0) {
    const unsigned xcc = (unsigned)__builtin_amdgcn_s_getreg((3 << 11) | 20) & 7u;
    (void)xb_add(&bar[XB_CNT(xcc)], 1u);
    volatile unsigned* st = (volatile unsigned*)(smem + SMEM_XB);
    st[0] = 0u; st[1] = 0u; st[2] = xcc;
  }
  __syncthreads();
  if (P.out == nullptr) cg::this_grid().sync();
#define PRE(n) if (PREMASK & (1u << (n))) { run_phase((n), P, smem); grid_barrier(bar, smem); }
  PRE(0) PRE(1) PRE(2) PRE(3) PRE(4) PRE(5) PRE(6) PRE(7) PRE(8) PRE(9)
  PRE(10) PRE(11) PRE(12) PRE(13) PRE(14) PRE(15) PRE(16) PRE(17) PRE(18) PRE(19)
  PRE(20) PRE(21) PRE(22) PRE(23) PRE(24) PRE(25) PRE(26) PRE(27) PRE(28) PRE(29)
#undef PRE
#define PHASE(n) { if ((n) > 0 || PREMASK) grid_barrier(bar, smem); run_phase((n), P, smem); if (DUPMASK & (1u << (n))) { grid_barrier(bar, smem); run_phase((n), P, smem); } }
  PHASE(0) PHASE(1) PHASE(2) PHASE(3) PHASE(4) PHASE(5) PHASE(6) PHASE(7) PHASE(8) PHASE(9)
  PHASE(10) PHASE(11) PHASE(12) PHASE(13) PHASE(14) PHASE(15) PHASE(16) PHASE(17) PHASE(18) PHASE(19)
  PHASE(20) PHASE(21) PHASE(22) PHASE(23) PHASE(24) PHASE(25) PHASE(26) PHASE(27) PHASE(28) PHASE(29)
#undef PHASE
}

extern "C" void kernel_launch(void* const* d_in, const int* in_sizes, int n_in, void* d_out, int out_size, void* d_ws,
                              size_t ws_size, hipStream_t stream) {
  Params P{};
  for (int i = 0; i < 31; ++i) P.in[i] = (const float*)d_in[i];
  P.out = (float*)d_out;
  P.ws = (char*)d_ws;
  static int grid = 0;
  void* args[] = {&P};
  (void)hipMemsetAsync(P.ws + OFF_BAR, 0, 4096, stream);
  if (!grid) {
    int dev = 0, cus = 0;
    (void)hipGetDevice(&dev);
    (void)hipDeviceGetAttribute(&cus, hipDeviceAttributeMultiprocessorCount, dev);
    grid = cus * 2;
    hipError_t e0 = hipLaunchCooperativeKernel((void*)mega, dim3(grid), dim3(256), args, 0, stream);
    if (e0 != hipSuccess) {
      (void)hipGetLastError();
      grid = cus;
      e0 = hipLaunchCooperativeKernel((void*)mega, dim3(grid), dim3(256), args, 0, stream);
      if (e0 != hipSuccess) fprintf(stderr, "cooperative launch failed: %s (grid %d)\n", hipGetErrorString(e0), grid);
    }
    return;
  }
  hipError_t e = hipLaunchCooperativeKernel((void*)mega, dim3(grid), dim3(256), args, 0, stream);
  if (e != hipSuccess) fprintf(stderr, "cooperative launch failed: %s (grid %d)\n", hipGetErrorString(e), grid);
}
```

```cpp
#include <hip/hip_runtime.h>
#include <hip/hip_cooperative_groups.h>
#include <cstdio>
namespace cg = cooperative_groups;

#ifndef DUPMASK
#define DUPMASK 0u
#endif
#ifndef PREMASK
#define PREMASK 0u
#endif
#ifndef ONE_LAUNCH
#define ONE_LAUNCH 1
#endif

typedef unsigned short bf16_t;
using bf16x8 = __attribute__((ext_vector_type(8))) short;
using f32x4 = __attribute__((ext_vector_type(4))) float;
using u32x4 = __attribute__((ext_vector_type(4))) unsigned;

constexpr int T_P = 16384, T_S = 128, T = 16512;
constexpr int NCH = 264;
constexpr int NSEG_G = 32, NSEGT_G = NSEG_G + 8;
constexpr int NSEG_S = 16, NSEGT_S = NSEG_S + 8;
constexpr int LW = 1408;
constexpr float EPS = 1e-6f;

constexpr size_t O_YP = 0;
constexpr size_t O_YS = O_YP + (size_t)T_P * 1024;
constexpr size_t O_GLA_P = O_YS + (size_t)T_S * 1024;
constexpr size_t O_LCONV_P = O_GLA_P + (size_t)2 * 4 * 128 * 256;
constexpr size_t O_LH_P = O_LCONV_P + 3 * LW;
constexpr size_t O_SCONV_P = O_LH_P + LW;
constexpr size_t O_SH_P = O_SCONV_P + 3 * 3072;
constexpr size_t O_GLA_S = O_SH_P + (size_t)32 * 64 * 128;
constexpr size_t O_LCONV_S = O_GLA_S + (size_t)2 * 8 * 4 * 128 * 256;
constexpr size_t O_LH_S = O_LCONV_S + 8 * 3 * LW;
constexpr size_t O_SCONV_S = O_LH_S + 8 * LW;
constexpr size_t O_SH_S = O_SCONV_S + 8 * 3 * 3072;

constexpr size_t OFF_WIN = 0;
constexpr size_t OFF_WOUT = OFF_WIN + (size_t)5248 * 1024 * 2;
constexpr size_t OFF_WOUT1 = OFF_WOUT + (size_t)1024 * 2048 * 2;
constexpr size_t OFF_WG = OFF_WOUT1 + (size_t)1024 * 2048 * 2;
constexpr size_t OFF_H = OFF_WG + (size_t)2 * 16 * 96 * 96 * 2;
constexpr size_t OFF_BIG = OFF_H + (size_t)T * 1024 * 2;
constexpr size_t G_QD = OFF_BIG;
constexpr size_t G_KD = G_QD + (size_t)T * 512 * 2;
constexpr size_t G_KDT = G_KD + (size_t)T * 512 * 2;
constexpr size_t G_VT = G_KDT + (size_t)NCH * 512 * 64 * 2;
constexpr size_t G_G = G_VT + (size_t)NCH * 1024 * 64 * 2;
constexpr size_t G_O = G_G + (size_t)T * 1024 * 2;
constexpr size_t G_GLR = G_O + (size_t)T * 1024 * 2;
constexpr size_t G_SSQ = G_GLR + (size_t)T * 16 * 4;
constexpr size_t G_DEC = G_SSQ + (size_t)T * 16 * 4;
constexpr size_t G_SSEG = G_DEC + (size_t)NCH * 512 * 4;
constexpr size_t G_DSEG = G_SSEG + (size_t)NSEG_G * 4 * 256 * 128 * 4;
constexpr size_t G_END = G_DSEG + (size_t)NSEG_G * 512 * 4;
constexpr size_t L_XB = OFF_BIG;
constexpr size_t L_GATE = L_XB + (size_t)T * LW * 2;
constexpr size_t L_Y = L_GATE + (size_t)T * LW * 2;
constexpr size_t L_ASEG = L_Y + (size_t)T * LW * 2;
constexpr size_t L_HSEG = L_ASEG + (size_t)NCH * LW * 4;
constexpr size_t L_END = L_HSEG + (size_t)NCH * LW * 4;
constexpr size_t S_Z = OFF_BIG;
constexpr size_t S_XBCT = S_Z + (size_t)T * 2048 * 2;
constexpr size_t S_DT = S_XBCT + (size_t)NCH * 3072 * 64 * 2;
constexpr size_t S_TAIL = S_DT + (size_t)T * 32 * 4;
constexpr size_t S_SSQ = S_TAIL + (size_t)NCH * 3072 * 4 * 2;
constexpr size_t S_SSEG = S_SSQ + (size_t)T * 32 * 4;
constexpr size_t S_CDSEG = S_SSEG + (size_t)NSEG_S * 32 * 64 * 128 * 4;
constexpr size_t S_END = S_CDSEG + 4096;
constexpr size_t S_BRM = OFF_H;
constexpr size_t S_CRM = OFF_H + (size_t)T * 512 * 2;
static_assert(G_END <= 268435456ull - 4096 && L_END <= 268435456ull - 4096 && S_END <= 268435456ull - 4096, "ws overflow");

constexpr int SMEM_BYTES = 81920;
constexpr int SMEM_XB = 81856;

struct Params {
  const float* in[31];
  float* out;
  char* ws;
};

__device__ __forceinline__ int otid() { int t = threadIdx.x; asm volatile("" : "+v"(t)); return t; }
__device__ __forceinline__ bf16_t f2bf(float f) {
  unsigned u = __float_as_uint(f);
  u += 0x7fffu + ((u >> 16) & 1u);
  return (bf16_t)(u >> 16);
}
__device__ __forceinline__ float bf2f(bf16_t b) { return __uint_as_float(((unsigned)b) << 16); }
__device__ __forceinline__ unsigned pack2(float a, float b) { return (unsigned)f2bf(a) | ((unsigned)f2bf(b) << 16); }
__device__ __forceinline__ float lo_bf(unsigned w) { return __uint_as_float(w << 16); }
__device__ __forceinline__ float hi_bf(unsigned w) { return __uint_as_float(w & 0xffff0000u); }
__device__ __forceinline__ float sigmoid_(float x) { return __builtin_amdgcn_rcpf(1.f + __expf(-x)); }
__device__ __forceinline__ float silu_(float x) { return x * __builtin_amdgcn_rcpf(1.f + __expf(-x)); }
__device__ __forceinline__ float softplus_(float x) { return fmaxf(x, 0.f) + log1pf(__expf(-fabsf(x))); }

__device__ __forceinline__ void tok2chunk(int t, int& c, int& j) {
  if (t < T_P) { c = t >> 6; j = t & 63; }
  else { int u = t - T_P; c = 256 + (u >> 4); j = u & 15; }
}
__device__ __forceinline__ void chunk_info(int c, int& t0, int& len) {
  if (c < 256) { t0 = c * 64; len = 64; }
  else { t0 = T_P + (c - 256) * 16; len = 16; }
}
__device__ __forceinline__ void seg_info(int sg, int nseg, int& c0, int& nch, int& b) {
  if (sg < nseg) { const int cps = 256 / nseg; c0 = sg * cps; nch = cps; b = -1; }
  else { c0 = 256 + (sg - nseg); nch = 1; b = sg - nseg; }
}

template <int MT, int NT, int KS>
__device__ __forceinline__ void mma_lds(f32x4 (&acc)[MT][NT], const bf16_t* A, int lda, const bf16_t* B, int ldb, int r, int q) {
#pragma unroll
  for (int ks = 0; ks < KS; ++ks) {
    bf16x8 af[MT], bfr[NT];
#pragma unroll
    for (int mi = 0; mi < MT; ++mi) af[mi] = *(const bf16x8*)(A + (mi * 16 + r) * lda + ks * 32 + q * 8);
#pragma unroll
    for (int ni = 0; ni < NT; ++ni) bfr[ni] = *(const bf16x8*)(B + (ni * 16 + r) * ldb + ks * 32 + q * 8);
#pragma unroll
    for (int mi = 0; mi < MT; ++mi)
#pragma unroll
      for (int ni = 0; ni < NT; ++ni)
        acc[mi][ni] = __builtin_amdgcn_mfma_f32_16x16x32_bf16(af[mi], bfr[ni], acc[mi][ni], 0, 0, 0);
  }
}

__device__ __forceinline__ void ph_convT(const float* __restrict__ src, int K, int N, int Npad, bf16_t* __restrict__ dst,
                         const float* __restrict__ kscale, char* smem) {
  float* tile = (float*)smem;
  const int tid = otid();
  const int ktn = K / 64, ntn = Npad / 64;
  for (int it = blockIdx.x; it < ktn * ntn; it += gridDim.x) {
    const int kt = it / ntn, nt = it - kt * ntn;
    const int k0 = kt * 64, n0 = nt * 64;
    {
      const int nn = tid & 63, n = n0 + nn;
      float v[16];
#pragma unroll
      for (int i = 0; i < 16; ++i) {
        const int kk = (tid >> 6) + 4 * i;
        v[i] = 0.f;
        if (n < N) v[i] = src[(size_t)(k0 + kk) * N + n];
      }
      if (kscale) {
#pragma unroll
        for (int i = 0; i < 16; ++i) v[i] *= kscale[k0 + (tid >> 6) + 4 * i];
      }
      __syncthreads();
#pragma unroll
      for (int i = 0; i < 16; ++i) tile[((tid >> 6) + 4 * i) * 65 + nn] = v[i];
    }
    __syncthreads();
#pragma unroll
    for (int i = 0; i < 2; ++i) {
      const int nn = (tid >> 3) + 32 * i, kk = (tid & 7) * 8;
      uint4 u;
      u.x = pack2(tile[(kk + 0) * 65 + nn], tile[(kk + 1) * 65 + nn]);
      u.y = pack2(tile[(kk + 2) * 65 + nn], tile[(kk + 3) * 65 + nn]);
      u.z = pack2(tile[(kk + 4) * 65 + nn], tile[(kk + 5) * 65 + nn]);
      u.w = pack2(tile[(kk + 6) * 65 + nn], tile[(kk + 7) * 65 + nn]);
      *(uint4*)(dst + (size_t)(n0 + nn) * K + k0 + kk) = u;
    }
  }
}

__device__ __forceinline__ void ph_conv_gate(const float* __restrict__ w, bf16_t* __restrict__ dst) {
  for (int idx = blockIdx.x * 256 + otid(); idx < 16 * 96 * 96; idx += gridDim.x * 256) {
    const int k = idx / 9216, rem = idx - k * 9216, co = rem / 96, ci = rem - co * 96;
    float v = 0.f;
    if (co < 88 && ci < 88) v = w[(k * 88 + ci) * 88 + co];
    dst[idx] = f2bf(v);
  }
}

__device__ __forceinline__ void ph_norm(const float* __restrict__ xp, const float* __restrict__ xs, const float* __restrict__ w,
                        bf16_t* __restrict__ h, float* xcopy) {
  const int lane = otid() & 63, wave = otid() >> 6;
  for (int row = blockIdx.x * 4 + wave; row < T; row += gridDim.x * 4) {
    const float* src = row < T_P ? xp + (size_t)row * 1024 : xs + (size_t)(row - T_P) * 1024;
    float4 v[4];
    float ss = 0.f;
#pragma unroll
    for (int i = 0; i < 4; ++i) {
      v[i] = *(const float4*)(src + i * 256 + lane * 4);
      ss += v[i].x * v[i].x + v[i].y * v[i].y + v[i].z * v[i].z + v[i].w * v[i].w;
    }
#pragma unroll
    for (int off = 32; off >= 1; off >>= 1) ss += __shfl_xor(ss, off);
    const float rs = rsqrtf(ss * (1.f / 1024.f) + EPS);
    if (xcopy != nullptr && row >= T_P) {
#pragma unroll
      for (int i = 0; i < 4; ++i) *(float4*)(xcopy + (size_t)row * 1024 + i * 256 + lane * 4) = v[i];
    }
#pragma unroll
    for (int i = 0; i < 4; ++i) {
      const float4 ww = *(const float4*)(w + i * 256 + lane * 4);
      uint2 o;
      o.x = pack2(v[i].x * rs * ww.x, v[i].y * rs * ww.y);
      o.y = pack2(v[i].z * rs * ww.z, v[i].w * rs * ww.w);
      *(uint2*)(h + (size_t)row * 1024 + i * 256 + lane * 4) = o;
    }
  }
}

__device__ __forceinline__ void ph_final_norm(float* __restrict__ x, const float* __restrict__ w) {
  const int lane = otid() & 63, wave = otid() >> 6;
  for (int row = blockIdx.x * 4 + wave; row < T; row += gridDim.x * 4) {
    float* src = x + (size_t)row * 1024;
    float4 v[4];
    float ss = 0.f;
#pragma unroll
    for (int i = 0; i < 4; ++i) {
      v[i] = *(const float4*)(src + i * 256 + lane * 4);
      ss += v[i].x * v[i].x + v[i].y * v[i].y + v[i].z * v[i].z + v[i].w * v[i].w;
    }
#pragma unroll
    for (int off = 32; off >= 1; off >>= 1) ss += __shfl_xor(ss, off);
    const float rs = rsqrtf(ss * (1.f / 1024.f) + EPS);
#pragma unroll
    for (int i = 0; i < 4; ++i) {
      const float4 ww = *(const float4*)(w + i * 256 + lane * 4);
      float4 o;
      o.x = v[i].x * rs * ww.x; o.y = v[i].y * rs * ww.y; o.z = v[i].z * rs * ww.z; o.w = v[i].w * rs * ww.w;
      *(float4*)(src + i * 256 + lane * 4) = o;
    }
  }
}

#define GLDS16(gp, lp) __builtin_amdgcn_global_load_lds((const unsigned*)(gp), (unsigned*)(lp), 16, 0, 0)
template <class Epi, bool SWP>
__device__ __forceinline__ void gemm_tile(const bf16_t* __restrict__ A, int lda, const bf16_t* __restrict__ Bt, int ldb, int nk,
                                          int tm, int tn, Epi epi, char* smem) {
  const int tid = otid(), lane = tid & 63, wave = tid >> 6;
  const int wm = wave >> 1, wn = wave & 1, r = lane & 15, q = lane >> 4;
  const int srow = tid >> 2, skc = (tid & 3) * 8;
  char* l0 = smem + tid * 16;
  f32x4 acc[32];
#pragma unroll
  for (int i = 0; i < 32; ++i) acc[i] = f32x4{0.f, 0.f, 0.f, 0.f};
  const int a_off = wm * 8192 + r * 64 + q * 16;
  const int b_off = 16384 + wn * 4096 + r * 64 + q * 16;
  const int b_offp = 16384 + wn * 4096 + (8 * (r >> 2) + (r & 3)) * 64 + q * 16;
  const bf16_t* Ag = A + (size_t)(tm * 256 + srow) * lda + skc;
  const bf16_t* Bg = Bt + (size_t)(tn * 128 + srow) * ldb + skc;
  const size_t a64 = (size_t)64 * lda, b64 = (size_t)64 * ldb;
#define G_ISSUE(t_, st_)                                   \
  {                                                        \
    const int ko_ = (t_) * 32;                             \
    char* lb_ = l0 + (st_) * 24576;                        \
    GLDS16(Ag + ko_, lb_);                                 \
    GLDS16(Ag + a64 + ko_, lb_ + 4096);                    \
    GLDS16(Ag + 2 * a64 + ko_, lb_ + 8192);                \
    GLDS16(Ag + 3 * a64 + ko_, lb_ + 12288);               \
    GLDS16(Bg + ko_, lb_ + 16384);                         \
    GLDS16(Bg + b64 + ko_, lb_ + 20480);                   \
  }
#define G_STEP(t_, st_)                                                                                   \
  {                                                                                                       \
    const int tt_ = (t_);                                                                                 \
    if (tt_ + 1 < nk) asm volatile("s_waitcnt vmcnt(6) lgkmcnt(0)\n\ts_barrier" ::: "memory");            \
    else asm volatile("s_waitcnt vmcnt(0) lgkmcnt(0)\n\ts_barrier" ::: "memory");                         \
    if (tt_ + 2 < nk) G_ISSUE(tt_ + 2, ((st_) + 2) % 3)                                                   \
    const char* sb_ = smem + (st_) * 24576;                                                               \
    bf16x8 af_[8], bf_[4];                                                                                \
    _Pragma("unroll") for (int mi = 0; mi < 8; ++mi) af_[mi] = *(const bf16x8*)(sb_ + a_off + mi * 1024);  \
    _Pragma("unroll") for (int ni = 0; ni < 4; ++ni)                                                      \
      bf_[ni] = *(const bf16x8*)(sb_ + (SWP ? b_offp + (ni >> 1) * 2048 + (ni & 1) * 256 : b_off + ni * 1024)); \
    __builtin_amdgcn_s_setprio(1);                                                                        \
    _Pragma("unroll") for (int mi = 0; mi < 8; ++mi)                                                      \
    _Pragma("unroll") for (int ni = 0; ni < 4; ++ni)                                                      \
      acc[mi * 4 + ni] = SWP ? __builtin_amdgcn_mfma_f32_16x16x32_bf16(bf_[ni], af_[mi], acc[mi * 4 + ni], 0, 0, 0) \
                             : __builtin_amdgcn_mfma_f32_16x16x32_bf16(af_[mi], bf_[ni], acc[mi * 4 + ni], 0, 0, 0); \
    __builtin_amdgcn_s_setprio(0);                                                                        \
  }
  asm volatile("s_waitcnt vmcnt(0)" ::: "memory");
  G_ISSUE(0, 0)
  G_ISSUE(1, 1)
  {
    int st = 0;
    for (int t = 0; t < nk; ++t) {
      G_STEP(t, st)
      st = st == 2 ? 0 : st + 1;
    }
  }
#undef G_STEP
#undef G_ISSUE
  epi.begin(tm * 256 + wm * 128, lane);
#pragma unroll
  for (int mi = 0; mi < 8; ++mi)
#pragma unroll
    for (int ni = 0; ni < 4; ++ni) {
      if (SWP) {
        if ((ni & 1) == 0)
          epi.rowvec8(tm * 256 + wm * 128 + mi * 16 + r, tn * 128 + wn * 64 + (ni >> 1) * 32 + q * 8, acc[mi * 4 + ni], acc[mi * 4 + ni + 1]);
      } else epi.colvec(tm * 256 + wm * 128 + mi * 16 + q * 4, tn * 128 + wn * 64 + ni * 16 + r, acc[mi * 4 + ni]);
    }
}

template <class Epi>
__device__ __forceinline__ void gemm_main(const bf16_t* __restrict__ A, int lda, const bf16_t* __restrict__ Bt, int ldb, int K,
                                          int Ntiles, Epi epi, char* smem) {
  const int nk = K / 32;
  const int total = 64 * Ntiles;
  for (int sidx = blockIdx.x; sidx < total; sidx += gridDim.x) {
    const int u = sidx >> 3;
    const int tn = u >> 3, tm = (sidx & 7) * 8 + (u & 7);
    if (epi.swapped_col(tn * 128)) gemm_tile<Epi, true>(A, lda, Bt, ldb, nk, tm, tn, epi, smem);
    else gemm_tile<Epi, false>(A, lda, Bt, ldb, nk, tm, tn, epi, smem);
  }
}

template <class Epi>
__device__ __forceinline__ void gemm_side(const bf16_t* __restrict__ A, int lda, const bf16_t* __restrict__ Bt, int ldb, int K,
                                          int N, int Nfull, Epi epi) {
  const int tid = otid(), lane = tid & 63, wave = tid >> 6, r = lane & 15, q = lane >> 4;
  const int ncg = (N + 31) >> 5, cg_left0 = Nfull >> 5, nleft = ncg - cg_left0;
  constexpr int KS = Epi::KSPLIT;
  const int njobs0 = ncg + nleft * 128, njobs = njobs0 * KS;
  const int Kpart = K / KS;
  for (int jx = blockIdx.x; jx < njobs; jx += gridDim.x) {
    const int ks = KS > 1 ? jx / njobs0 : 0, j = jx - ks * njobs0;
    int row0, cg;
    if (j < ncg) { row0 = T_P; cg = j; }
    else { const int jj = j - ncg, rt = jj / nleft; row0 = rt * 128; cg = cg_left0 + (jj - rt * nleft); }
    const int col0 = cg * 32;
    const bool swp = epi.swapped_col(col0);
    f32x4 acc[4];
#pragma unroll
    for (int i = 0; i < 4; ++i) acc[i] = f32x4{0.f, 0.f, 0.f, 0.f};
    const bf16_t* Ap = A + (size_t)(row0 + 32 * wave + r) * lda + q * 8 + ks * Kpart;
    const bf16_t* Bp = Bt + (size_t)(col0 + r) * ldb + q * 8 + ks * Kpart;
    const size_t a16 = (size_t)16 * lda, b16 = (size_t)16 * ldb;
    if (swp) {
#pragma unroll 4
      for (int k0 = 0; k0 < Kpart; k0 += 32) {
        const bf16x8 a0 = *(const bf16x8*)(Ap + k0), a1 = *(const bf16x8*)(Ap + a16 + k0);
        const bf16x8 b0 = *(const bf16x8*)(Bp + k0), b1 = *(const bf16x8*)(Bp + b16 + k0);
        acc[0] = __builtin_amdgcn_mfma_f32_16x16x32_bf16(b0, a0, acc[0], 0, 0, 0);
        acc[1] = __builtin_amdgcn_mfma_f32_16x16x32_bf16(b1, a0, acc[1], 0, 0, 0);
        acc[2] = __builtin_amdgcn_mfma_f32_16x16x32_bf16(b0, a1, acc[2], 0, 0, 0);
        acc[3] = __builtin_amdgcn_mfma_f32_16x16x32_bf16(b1, a1, acc[3], 0, 0, 0);
      }
    } else {
#pragma unroll 4
      for (int k0 = 0; k0 < Kpart; k0 += 32) {
        const bf16x8 a0 = *(const bf16x8*)(Ap + k0), a1 = *(const bf16x8*)(Ap + a16 + k0);
        const bf16x8 b0 = *(const bf16x8*)(Bp + k0), b1 = *(const bf16x8*)(Bp + b16 + k0);
        acc[0] = __builtin_amdgcn_mfma_f32_16x16x32_bf16(a0, b0, acc[0], 0, 0, 0);
        acc[1] = __builtin_amdgcn_mfma_f32_16x16x32_bf16(a0, b1, acc[1], 0, 0, 0);
        acc[2] = __builtin_amdgcn_mfma_f32_16x16x32_bf16(a1, b0, acc[2], 0, 0, 0);
        acc[3] = __builtin_amdgcn_mfma_f32_16x16x32_bf16(a1, b1, acc[3], 0, 0, 0);
      }
    }
    epi.begin(row0 + 32 * wave, lane);
#pragma unroll
    for (int mi = 0; mi < 2; ++mi)
#pragma unroll
      for (int ni = 0; ni < 2; ++ni) {
        if (KS > 1) epi.rowvec_acc(row0 + 32 * wave + mi * 16 + r, col0 + ni * 16 + q * 4, acc[mi * 2 + ni]);
        else if (swp) epi.rowvec(row0 + 32 * wave + mi * 16 + r, col0 + ni * 16 + q * 4, acc[mi * 2 + ni]);
        else epi(row0 + 32 * wave + mi * 16 + q * 4, col0 + ni * 16 + r, acc[mi * 2 + ni]);
      }
  }
}

template <class Epi>
__device__ __forceinline__ void gemm_phase(const bf16_t* __restrict__ A, int lda, const bf16_t* __restrict__ Bt, int ldb, int K,
                                           int N, Epi epi, char* smem) {
  gemm_main(A, lda, Bt, ldb, K, N >> 7, epi, smem);
  gemm_side(A, lda, Bt, ldb, K, N, (N >> 7) << 7, epi);
}

struct EpiGlaIn {
  static constexpr int KSPLIT = 1;
  __device__ __forceinline__ void rowvec_acc(int, int, f32x4) const {}
  bf16_t *qd, *kd, *vT, *g;
  float* glr;
  __device__ __forceinline__ void begin(int, int) {}
  __device__ __forceinline__ bool swapped_col(int c) const { return c < 1024 || (c >= 2048 && c < 3072); }
  __device__ __forceinline__ void colvec(int row0, int col, f32x4 v) const {
    uint2 u;
    u.x = pack2(v[0], v[1]);
    u.y = pack2(v[2], v[3]);
    *(uint2*)(vT + ((size_t)(row0 >> 6) * 1024 + (col - 1024)) * 64 + (row0 & 63)) = u;
  }
  __device__ __forceinline__ void rowvec8(int row, int col0, f32x4 v, f32x4 w) const {
    const float sc = col0 < 512 ? 0.08838834764831845f : 1.f;
    const u32x4 u = u32x4{pack2(v[0] * sc, v[1] * sc), pack2(v[2] * sc, v[3] * sc), pack2(w[0] * sc, w[1] * sc), pack2(w[2] * sc, w[3] * sc)};
    bf16_t* dst = col0 < 512 ? qd + (size_t)row * 512 + col0
                : col0 < 1024 ? kd + (size_t)row * 512 + (col0 - 512) : g + (size_t)row * 1024 + (col0 - 2048);
    *(u32x4*)dst = u;
  }
  __device__ __forceinline__ void rowvec(int row, int col0, f32x4 v) const {
    uint2 u;
    if (col0 < 512) {
      const float sc = 0.08838834764831845f;
      u.x = pack2(v[0] * sc, v[1] * sc); u.y = pack2(v[2] * sc, v[3] * sc);
      *(uint2*)(qd + (size_t)row * 512 + col0) = u;
    } else if (col0 < 1024) {
      u.x = pack2(v[0], v[1]); u.y = pack2(v[2], v[3]);
      *(uint2*)(kd + (size_t)row * 512 + (col0 - 512)) = u;
    } else {
      u.x = pack2(v[0], v[1]); u.y = pack2(v[2], v[3]);
      *(uint2*)(g + (size_t)row * 1024 + (col0 - 2048)) = u;
    }
  }
  __device__ __forceinline__ void operator()(int row0, int col, f32x4 v) const {
    if (col < 512) {
#pragma unroll
      for (int jj = 0; jj < 4; ++jj) qd[(size_t)(row0 + jj) * 512 + col] = f2bf(v[jj] * 0.08838834764831845f);
    } else if (col < 1024) {
#pragma unroll
      for (int jj = 0; jj < 4; ++jj) kd[(size_t)(row0 + jj) * 512 + (col - 512)] = f2bf(v[jj]);
    } else if (col < 2048) {
      int c, j;
      tok2chunk(row0, c, j);
      uint2 u;
      u.x = pack2(v[0], v[1]);
      u.y = pack2(v[2], v[3]);
      *(uint2*)(vT + ((size_t)c * 1024 + (col - 1024)) * 64 + j) = u;
    } else if (col < 3072) {
#pragma unroll
      for (int jj = 0; jj < 4; ++jj) g[(size_t)(row0 + jj) * 1024 + (col - 2048)] = f2bf(v[jj]);
    } else if (col < 3088) {
#pragma unroll
      for (int jj = 0; jj < 4; ++jj) glr[(size_t)(row0 + jj) * 16 + (col - 3072)] = v[jj];
    }
  }
};

struct EpiLruIn {
  static constexpr int KSPLIT = 1;
  __device__ __forceinline__ void rowvec_acc(int, int, f32x4) const {}
  bf16_t *xb, *gate;
  __device__ __forceinline__ void begin(int, int) {}
  __device__ __forceinline__ bool swapped_col(int) const { return true; }
  __device__ __forceinline__ void colvec(int, int, f32x4) const {}
  __device__ __forceinline__ void rowvec8(int row, int col0, f32x4 v, f32x4 w) const {
    bf16_t* dst = col0 < LW ? xb + col0 : gate + (col0 - LW);
    *(u32x4*)(dst + (size_t)row * LW) = u32x4{pack2(v[0], v[1]), pack2(v[2], v[3]), pack2(w[0], w[1]), pack2(w[2], w[3])};
  }
  __device__ __forceinline__ void rowvec(int row, int col0, f32x4 v) const {
    bf16_t* dst = col0 < LW ? xb + col0 : gate + (col0 - LW);
    uint2 u;
    u.x = pack2(v[0], v[1]); u.y = pack2(v[2], v[3]);
    *(uint2*)(dst + (size_t)row * LW) = u;
  }
  __device__ __forceinline__ void operator()(int row0, int col, f32x4 v) const {
    bf16_t* dst = col < LW ? xb + col : gate + (col - LW);
#pragma unroll
    for (int jj = 0; jj < 4; ++jj) dst[(size_t)(row0 + jj) * LW] = f2bf(v[jj]);
  }
};

struct EpiSsdIn {
  static constexpr int KSPLIT = 1;
  __device__ __forceinline__ void rowvec_acc(int, int, f32x4) const {}
  bf16_t *z, *xbcT, *tails;
  float* dt;
  const float* dt_bias;
  __device__ __forceinline__ void begin(int, int) {}
  __device__ __forceinline__ bool swapped_col(int c) const { return c < 2048; }
  __device__ __forceinline__ void colvec(int row0, int col, f32x4 v) const {
    const int c = row0 >> 6, j = row0 & 63, cc = col - 2048;
    uint2 u;
    u.x = pack2(v[0], v[1]);
    u.y = pack2(v[2], v[3]);
    *(uint2*)(xbcT + ((size_t)c * 3072 + cc) * 64 + j) = u;
    if (j == 60) *(uint2*)(tails + ((size_t)c * 3072 + cc) * 4) = u;
  }
  __device__ __forceinline__ void rowvec8(int row, int col0, f32x4 v, f32x4 w) const {
    *(u32x4*)(z + (size_t)row * 2048 + col0) = u32x4{pack2(v[0], v[1]), pack2(v[2], v[3]), pack2(w[0], w[1]), pack2(w[2], w[3])};
  }
  __device__ __forceinline__ void rowvec(int row, int col0, f32x4 v) const {
    uint2 u;
    u.x = pack2(v[0], v[1]); u.y = pack2(v[2], v[3]);
    *(uint2*)(z + (size_t)row * 2048 + col0) = u;
  }
  __device__ __forceinline__ void operator()(int row0, int col, f32x4 v) const {
    if (col < 2048) {
#pragma unroll
      for (int jj = 0; jj < 4; ++jj) z[(size_t)(row0 + jj) * 2048 + col] = f2bf(v[jj]);
    } else if (col < 5120) {
      int c, j;
      tok2chunk(row0, c, j);
      const int len = c < 256 ? 64 : 16;
      const int cc = col - 2048;
      uint2 u;
      u.x = pack2(v[0], v[1]);
      u.y = pack2(v[2], v[3]);
      *(uint2*)(xbcT + ((size_t)c * 3072 + cc) * 64 + j) = u;
      if (j == len - 4) *(uint2*)(tails + ((size_t)c * 3072 + cc) * 4) = u;
    } else if (col < 5152) {
      const int hd = col - 5120;
#pragma unroll
      for (int jj = 0; jj < 4; ++jj) dt[(size_t)(row0 + jj) * 32 + hd] = v[jj];
    }
  }
};

struct EpiResid {
  const float *xin_p, *xin_s;
  float* xout;
  static constexpr int KSPLIT = 4;
  __device__ __forceinline__ void rowvec_acc(int row, int col0, f32x4 v) const {
    float* dst = xout + (size_t)row * 1024 + col0;
#pragma unroll
    for (int e = 0; e < 4; ++e) (void)__hip_atomic_fetch_add(dst + e, v[e], __ATOMIC_RELAXED, __HIP_MEMORY_SCOPE_AGENT);
  }
  __device__ __forceinline__ void begin(int, int) {}
  __device__ __forceinline__ bool swapped_col(int) const { return true; }
  __device__ __forceinline__ void colvec(int, int, f32x4) const {}
  __device__ __forceinline__ void rowvec8(int row, int col0, f32x4 v, f32x4 w) const {
    rowvec(row, col0, v);
    rowvec(row, col0 + 4, w);
  }
  __device__ __forceinline__ void rowvec(int row, int col0, f32x4 v) const {
    const float* src = row < T_P ? xin_p + (size_t)row * 1024 : xin_s + (size_t)(row - T_P) * 1024;
    const float4 x = *(const float4*)(src + col0);
    float4 o;
    o.x = x.x + v[0]; o.y = x.y + v[1]; o.z = x.z + v[2]; o.w = x.w + v[3];
    *(float4*)(xout + (size_t)row * 1024 + col0) = o;
  }
  __device__ __forceinline__ void operator()(int row0, int col, f32x4 v) const {
#pragma unroll
    for (int jj = 0; jj < 4; ++jj) {
      const int row = row0 + jj;
      const float* src = row < T_P ? xin_p + (size_t)row * 1024 : xin_s + (size_t)(row - T_P) * 1024;
      xout[(size_t)row * 1024 + col] = src[col] + v[jj];
    }
  }
};

struct EpiResidScaled {
  static constexpr int KSPLIT = 4;
  __device__ __forceinline__ void rowvec_acc(int row, int col0, f32x4 v) const {
    const int o_ = row - rowbase;
    const float s0_ = __shfl(rs, o_ & 63), s1_ = __shfl(rs1, o_ & 63);
    const float sc = o_ < 64 ? s0_ : s1_;
    float* dst = xout + (size_t)row * 1024 + col0;
#pragma unroll
    for (int e = 0; e < 4; ++e) (void)__hip_atomic_fetch_add(dst + e, sc * v[e], __ATOMIC_RELAXED, __HIP_MEMORY_SCOPE_AGENT);
  }
  const float *xin_p, *xin_s;
  float* xout;
  const float* ssq;
  float rs, rs1;
  int rowbase;
  __device__ __forceinline__ bool swapped_col(int) const { return true; }
  __device__ __forceinline__ void colvec(int, int, f32x4) const {}
  __device__ __forceinline__ void rowvec8(int row, int col0, f32x4 v, f32x4 w) const {
    rowvec(row, col0, v);
    rowvec(row, col0 + 4, w);
  }
  __device__ __forceinline__ void rowvec(int row, int col0, f32x4 v) const {
    const int o_ = row - rowbase;
    const float s0_ = __shfl(rs, o_ & 63), s1_ = __shfl(rs1, o_ & 63);
    const float sc = o_ < 64 ? s0_ : s1_;
    const float* src = row < T_P ? xin_p + (size_t)row * 1024 : xin_s + (size_t)(row - T_P) * 1024;
    const float4 x = *(const float4*)(src + col0);
    float4 o;
    o.x = x.x + sc * v[0]; o.y = x.y + sc * v[1]; o.z = x.z + sc * v[2]; o.w = x.w + sc * v[3];
    *(float4*)(xout + (size_t)row * 1024 + col0) = o;
  }
  __device__ __forceinline__ void begin(int rb, int lane) {
    rowbase = rb;
    float rr[2];
#pragma unroll
    for (int hh = 0; hh < 2; ++hh) {
      const int row = rb + hh * 64 + lane;
      float sacc = 0.f;
      if (row < T) {
        const float4* p = (const float4*)(ssq + (size_t)row * 32);
#pragma unroll
        for (int i = 0; i < 8; ++i) {
          const float4 v = p[i];
          sacc += v.x + v.y + v.z + v.w;
        }
      }
      rr[hh] = rsqrtf(sacc * (1.f / 2048.f) + EPS);
    }
    rs = rr[0];
    rs1 = rr[1];
  }
  __device__ __forceinline__ void operator()(int row0, int col, f32x4 v) const {
#pragma unroll
    for (int jj = 0; jj < 4; ++jj) {
      const int row = row0 + jj;
      const int o_ = row - rowbase;
      const float s0_ = __shfl(rs, o_ & 63), s1_ = __shfl(rs1, o_ & 63);
      const float sc = o_ < 64 ? s0_ : s1_;
      const float* src = row < T_P ? xin_p + (size_t)row * 1024 : xin_s + (size_t)(row - T_P) * 1024;
      xout[(size_t)row * 1024 + col] = src[col] + sc * v[jj];
    }
  }
};

__device__ __forceinline__ void ph_gla_prep(const Params& P, int layer, char* smem) {
  bf16_t* sQ = (bf16_t*)smem;
  bf16_t* sK = (bf16_t*)(smem + 8192);
  float* sG = (float*)(smem + 16384);
  float* sTot = (float*)(smem + 20480);
  bf16_t* qd = (bf16_t*)(P.ws + G_QD);
  bf16_t* kd = (bf16_t*)(P.ws + G_KD);
  bf16_t* kdT = (bf16_t*)(P.ws + G_KDT);
  const float* glr = (const float*)(P.ws + G_GLR);
  float* decay = (float*)(P.ws + G_DEC);
  const float* wgu = P.in[10] + (size_t)layer * 16 * 512;
  const float* bgt = P.in[11] + (size_t)layer * 512;
  const int tid = otid(), tg = tid >> 6, cl = tid & 63;
  for (int it = blockIdx.x; it < NCH * 8; it += gridDim.x) {
    const int c = it >> 3, cb8 = it & 7, d = cb8 * 64 + cl;
    int t0, len;
    chunk_info(c, t0, len);
    float wg[16];
#pragma unroll
    for (int rk = 0; rk < 16; ++rk) wg[rk] = wgu[rk * 512 + d];
    const float bg = bgt[d];
    u32x4 rq[2], rk2[2];
#pragma unroll
    for (int i = 0; i < 2; ++i) {
      const int id = tid + 256 * i, row = id >> 3, c16 = id & 7;
      rq[i] = u32x4{0u, 0u, 0u, 0u};
      rk2[i] = u32x4{0u, 0u, 0u, 0u};
      if (row < len) {
        const size_t a = (size_t)(t0 + row) * 512 + cb8 * 64 + c16 * 8;
        rq[i] = *(const u32x4*)(qd + a);
        rk2[i] = *(const u32x4*)(kd + a);
      }
    }
    float4 gl4 = float4{0.f, 0.f, 0.f, 0.f};
    if (tid * 4 < len * 16) gl4 = *(const float4*)(glr + (size_t)t0 * 16 + tid * 4);
    __syncthreads();
#pragma unroll
    for (int i = 0; i < 2; ++i) {
      const int id = tid + 256 * i, row = id >> 3, c16 = id & 7;
      *(u32x4*)(sQ + row * 64 + c16 * 8) = rq[i];
      *(u32x4*)(sK + row * 64 + c16 * 8) = rk2[i];
    }
    *(float4*)(sG + tid * 4) = gl4;
    __syncthreads();
    float cs[16];
    float run = 0.f;
#pragma unroll
    for (int e = 0; e < 16; ++e) {
      const int j = tg * 16 + e;
      float x = bg;
#pragma unroll
      for (int rk = 0; rk < 16; ++rk) x += sG[j * 16 + rk] * wg[rk];
      const float ls = fminf(x, 0.f) - __logf(1.f + __expf(-fabsf(x)));
      run += (j < len) ? ls * (1.f / 16.f) : 0.f;
      cs[e] = run;
    }
    sTot[tg * 64 + cl] = run;
    __syncthreads();
    float off = 0.f;
#pragma unroll
    for (int g2 = 0; g2 < 3; ++g2) off += (g2 < tg) ? sTot[g2 * 64 + cl] : 0.f;
    unsigned pk[8];
#pragma unroll
    for (int e = 0; e < 16; ++e) {
      const int j = tg * 16 + e;
      const float bc = off + cs[e];
      const float eb = __expf(bc);
      const float qv = bf2f(sQ[j * 64 + cl]), kv = bf2f(sK[j * 64 + cl]);
      sQ[j * 64 + cl] = f2bf(qv * eb);
      const bf16_t kb = f2bf(kv * __builtin_amdgcn_rcpf(eb));
      sK[j * 64 + cl] = kb;
      if (e & 1) pk[e >> 1] |= ((unsigned)kb << 16);
      else pk[e >> 1] = (unsigned)kb;
    }
    if (tg * 16 < len) {
      bf16_t* dstT = kdT + ((size_t)c * 512 + d) * 64 + tg * 16;
      *(u32x4*)dstT = u32x4{pk[0], pk[1], pk[2], pk[3]};
      *(u32x4*)(dstT + 8) = u32x4{pk[4], pk[5], pk[6], pk[7]};
    }
    if (tg == 3) decay[(size_t)c * 512 + d] = __expf(off + run);
    __syncthreads();
#pragma unroll
    for (int i = 0; i < 2; ++i) {
      const int id = tid + 256 * i, row = id >> 3, c16 = id & 7;
      if (row < len) {
        const size_t a = (size_t)(t0 + row) * 512 + cb8 * 64 + c16 * 8;
        *(u32x4*)(qd + a) = *(const u32x4*)(sQ + row * 64 + c16 * 8);
        *(u32x4*)(kd + a) = *(const u32x4*)(sK + row * 64 + c16 * 8);
      }
    }
  }
}

__device__ __forceinline__ void ph_gla_pass(const bool passB, const int layer, const Params& P, char* smem) {
  bf16_t* sKT = (bf16_t*)(smem);
  bf16_t* sVT = (bf16_t*)(smem + 18432);
  bf16_t* sQ = (bf16_t*)(smem + 27648);
  bf16_t* sK = (bf16_t*)(smem + 45056);
  bf16_t* sAtt = sK;
  bf16_t* sS = (bf16_t*)(smem + 62464);
  const bf16_t* qd = (const bf16_t*)(P.ws + G_QD);
  const bf16_t* kd = (const bf16_t*)(P.ws + G_KD);
  const bf16_t* kdT = (const bf16_t*)(P.ws + G_KDT);
  const bf16_t* vT = (const bf16_t*)(P.ws + G_VT);
  bf16_t* obuf = (bf16_t*)(P.ws + G_O);
  float* ssq = (float*)(P.ws + G_SSQ);
  const float* decay = (const float*)(P.ws + G_DEC);
  float* Sseg = (float*)(P.ws + G_SSEG);
  const float* st_in = P.in[2];
  const int tid = otid(), lane = tid & 63, wave = tid >> 6, r = lane & 15, q = lane >> 4;
  const int nitems = passB ? NSEGT_G * 16 : (NSEG_G - 1) * 16;
  for (int it = blockIdx.x; it < nitems; it += gridDim.x) {
    const int sg = it >> 4, h = (it >> 2) & 3, sl = it & 3;
    int c0, nch, b;
    seg_info(sg, NSEG_G, c0, nch, b);
    f32x4 accS[2][4];
#pragma unroll
    for (int mt = 0; mt < 2; ++mt)
#pragma unroll
      for (int nt = 0; nt < 4; ++nt) {
        const int d0 = 32 * wave + mt * 16 + q * 4, v = sl * 64 + nt * 16 + r;
        if (!passB) accS[mt][nt] = f32x4{0.f, 0.f, 0.f, 0.f};
        else if (sg < NSEG_G) {
          const float4 t4 = *(const float4*)(Sseg + ((size_t)(sg * 4 + h) * 256 + v) * 128 + d0);
          accS[mt][nt] = f32x4{t4.x, t4.y, t4.z, t4.w};
        } else {
#pragma unroll
          for (int jj = 0; jj < 4; ++jj)
            accS[mt][nt][jj] = st_in[((((size_t)layer * 8 + b) * 4 + h) * 128 + d0 + jj) * 256 + v];
        }
      }
    float dprod[8] = {1.f, 1.f, 1.f, 1.f, 1.f, 1.f, 1.f, 1.f};
    u32x4 pk[4], pv[2];
    float pdec[8];
#define GLA_ISSUE(cc_)                                                                                         \
  {                                                                                                            \
    const int cx_ = (cc_);                                                                                     \
    const int lenx_ = cx_ < 256 ? 64 : 16;                                                                     \
    _Pragma("unroll") for (int i = 0; i < 4; ++i) {                                                            \
      const int id = tid + 256 * i, row = id >> 3, c16 = id & 7;                                               \
      pk[i] = u32x4{0u, 0u, 0u, 0u};                                                                           \
      if (c16 * 8 < lenx_) pk[i] = *(const u32x4*)(kdT + ((size_t)cx_ * 512 + h * 128 + row) * 64 + c16 * 8);  \
    }                                                                                                          \
    _Pragma("unroll") for (int i = 0; i < 2; ++i) {                                                            \
      const int id = tid + 256 * i, row = id >> 3, c16 = id & 7;                                               \
      pv[i] = u32x4{0u, 0u, 0u, 0u};                                                                           \
      if (c16 * 8 < lenx_) pv[i] = *(const u32x4*)(vT + ((size_t)cx_ * 1024 + h * 256 + sl * 64 + row) * 64 + c16 * 8); \
    }                                                                                                          \
    _Pragma("unroll") for (int mt = 0; mt < 2; ++mt)                                                           \
    _Pragma("unroll") for (int jj = 0; jj < 4; ++jj)                                                           \
      pdec[mt * 4 + jj] = decay[(size_t)cx_ * 512 + h * 128 + 32 * wave + mt * 16 + q * 4 + jj];               \
  }
    GLA_ISSUE(c0)
    for (int ci = 0; ci < nch; ++ci) {
      const int c = c0 + ci;
      int t0, len;
      chunk_info(c, t0, len);
      __syncthreads();
#pragma unroll
      for (int i = 0; i < 4; ++i) {
        const int id = tid + 256 * i, row = id >> 3, c16 = id & 7;
        *(u32x4*)(sKT + row * 72 + c16 * 8) = pk[i];
      }
#pragma unroll
      for (int i = 0; i < 2; ++i) {
        const int id = tid + 256 * i, row = id >> 3, c16 = id & 7;
        *(u32x4*)(sVT + row * 72 + c16 * 8) = pv[i];
      }
      float dec8[8];
#pragma unroll
      for (int e = 0; e < 8; ++e) dec8[e] = pdec[e];
      if (passB) {
#pragma unroll
        for (int i = 0; i < 4; ++i) {
          const int id = tid + 256 * i, row = id >> 4, c16 = id & 15;
          uint4 vq = uint4{0u, 0u, 0u, 0u}, vk = uint4{0u, 0u, 0u, 0u};
          if (row < len) {
            const size_t a = (size_t)(t0 + row) * 512 + h * 128 + c16 * 8;
            vq = *(const uint4*)(qd + a);
            vk = *(const uint4*)(kd + a);
          }
          *(uint4*)(sQ + row * 136 + c16 * 8) = vq;
          *(uint4*)(sK + row * 136 + c16 * 8) = vk;
        }
      }
      __syncthreads();
      if (ci + 1 < nch) GLA_ISSUE(c0 + ci + 1)
      if (passB) {
        f32x4 att[1][4];
#pragma unroll
        for (int nt = 0; nt < 4; ++nt) att[0][nt] = f32x4{0.f, 0.f, 0.f, 0.f};
        mma_lds<1, 4, 4>(att, sQ + (16 * wave) * 136, 136, sK, 136, r, q);
#pragma unroll
        for (int mt = 0; mt < 2; ++mt)
#pragma unroll
          for (int nt = 0; nt < 4; ++nt) {
            const int d0 = 32 * wave + mt * 16 + q * 4, v = nt * 16 + r;
            uint2 u;
            u.x = pack2(accS[mt][nt][0], accS[mt][nt][1]);
            u.y = pack2(accS[mt][nt][2], accS[mt][nt][3]);
            *(uint2*)(sS + v * 136 + d0) = u;
          }
        __syncthreads();
#pragma unroll
        for (int nt = 0; nt < 4; ++nt)
#pragma unroll
          for (int jj = 0; jj < 4; ++jj) {
            const int i = 16 * wave + q * 4 + jj, j = nt * 16 + r;
            sAtt[i * 72 + j] = f2bf(j <= i ? att[0][nt][jj] : 0.f);
          }
        __syncthreads();
        f32x4 o[1][4];
#pragma unroll
        for (int nt = 0; nt < 4; ++nt) o[0][nt] = f32x4{0.f, 0.f, 0.f, 0.f};
        mma_lds<1, 4, 2>(o, sAtt + (16 * wave) * 72, 72, sVT, 72, r, q);
        mma_lds<1, 4, 4>(o, sQ + (16 * wave) * 136, 136, sS, 136, r, q);
        float ss[4] = {0.f, 0.f, 0.f, 0.f};
#pragma unroll
        for (int nt = 0; nt < 4; ++nt)
#pragma unroll
          for (int jj = 0; jj < 4; ++jj) {
            const float ov = o[0][nt][jj];
            ss[jj] += ov * ov;
            const int i = 16 * wave + q * 4 + jj;
            if (i < len) obuf[(size_t)(t0 + i) * 1024 + h * 256 + sl * 64 + nt * 16 + r] = f2bf(ov);
          }
#pragma unroll
        for (int jj = 0; jj < 4; ++jj) {
          float s = ss[jj];
          s += __shfl_xor(s, 1);
          s += __shfl_xor(s, 2);
          s += __shfl_xor(s, 4);
          s += __shfl_xor(s, 8);
          const int i = 16 * wave + q * 4 + jj;
          if (r == 0 && i < len) ssq[(size_t)(t0 + i) * 16 + h * 4 + sl] = s;
        }
      }
      mma_lds<2, 4, 2>(accS, sKT + (32 * wave) * 72, 72, sVT, 72, r, q);
#pragma unroll
      for (int mt = 0; mt < 2; ++mt)
#pragma unroll
        for (int jj = 0; jj < 4; ++jj) {
          const float dec = dec8[mt * 4 + jj];
          dprod[mt * 4 + jj] *= dec;
#pragma unroll
          for (int nt = 0; nt < 4; ++nt) accS[mt][nt][jj] *= dec;
        }
    }
#undef GLA_ISSUE
    if (!passB && sl == 0 && r == 0) {
#pragma unroll
      for (int mt = 0; mt < 2; ++mt)
#pragma unroll
        for (int jj = 0; jj < 4; ++jj)
          ((float*)(P.ws + G_DSEG))[(size_t)sg * 512 + h * 128 + 32 * wave + mt * 16 + q * 4 + jj] = dprod[mt * 4 + jj];
    }
#pragma unroll
    for (int mt = 0; mt < 2; ++mt)
#pragma unroll
      for (int nt = 0; nt < 4; ++nt) {
        const int d0 = 32 * wave + mt * 16 + q * 4, v = sl * 64 + nt * 16 + r;
        if (!passB) {
          float4 t4;
          t4.x = accS[mt][nt][0]; t4.y = accS[mt][nt][1]; t4.z = accS[mt][nt][2]; t4.w = accS[mt][nt][3];
          *(float4*)(Sseg + ((size_t)(sg * 4 + h) * 256 + v) * 128 + d0) = t4;
        } else if (sg == NSEG_G - 1) {
#pragma unroll
          for (int jj = 0; jj < 4; ++jj)
            P.out[O_GLA_P + (((size_t)layer * 4 + h) * 128 + d0 + jj) * 256 + v] = accS[mt][nt][jj];
        } else if (sg >= NSEG_G) {
#pragma unroll
          for (int jj = 0; jj < 4; ++jj)
            P.out[O_GLA_S + ((((size_t)layer * 8 + b) * 4 + h) * 128 + d0 + jj) * 256 + v] = accS[mt][nt][jj];
        }
      }
  }
}

__device__ __forceinline__ void ph_gla_scan(const Params& P) {
  float* Sseg = (float*)(P.ws + G_SSEG);
  const float* dseg = (const float*)(P.ws + G_DSEG);
  for (int idx = blockIdx.x * 256 + otid(); idx < 4 * 256 * 128; idx += gridDim.x * 256) {
    const int h = idx >> 15, d = idx & 127;
    float tv[NSEG_G - 1], dv[NSEG_G - 1];
#pragma unroll
    for (int s2 = 0; s2 < NSEG_G - 1; ++s2) {
      tv[s2] = Sseg[(size_t)s2 * 131072 + idx];
      dv[s2] = dseg[(size_t)s2 * 512 + h * 128 + d];
    }
    float cur = 0.f;
#pragma unroll
    for (int s2 = 0; s2 < NSEG_G; ++s2) {
      Sseg[(size_t)s2 * 131072 + idx] = cur;
      if (s2 < NSEG_G - 1) cur = dv[s2] * cur + tv[s2];
    }
  }
}

__device__ __forceinline__ void ph_gla_aprep(const Params& P, int layer) {
  bf16_t* obuf = (bf16_t*)(P.ws + G_O);
  const bf16_t* g = (const bf16_t*)(P.ws + G_G);
  const float* ssq = (const float*)(P.ws + G_SSQ);
  const float* nw = P.in[12] + (size_t)layer * 256;
  const int tid = otid();
  const int c8 = (tid & 127) * 8, hh = c8 >> 8;
  const float4 w0 = *(const float4*)(nw + (c8 & 255));
  const float4 w1 = *(const float4*)(nw + (c8 & 255) + 4);
  const int stride = gridDim.x * 256;
  for (int base = blockIdx.x * 256 + tid; base < T * 128; base += stride * 4) {
    u32x4 ov[4], gv[4];
    float4 s4[4];
#pragma unroll
    for (int u = 0; u < 4; ++u) {
      const int idx = base + u * stride;
      ov[u] = u32x4{0u, 0u, 0u, 0u};
      gv[u] = u32x4{0u, 0u, 0u, 0u};
      s4[u] = float4{1.f, 1.f, 1.f, 1.f};
      if (idx < T * 128) {
        const int t = idx >> 7;
        ov[u] = *(const u32x4*)(obuf + (size_t)t * 1024 + c8);
        gv[u] = *(const u32x4*)(g + (size_t)t * 1024 + c8);
        s4[u] = *(const float4*)(ssq + (size_t)t * 16 + hh * 4);
      }
    }
#pragma unroll
    for (int u = 0; u < 4; ++u) {
      const int idx = base + u * stride;
      if (idx < T * 128) {
        const int t = idx >> 7;
        const float rs = rsqrtf((s4[u].x + s4[u].y + s4[u].z + s4[u].w) * (1.f / 256.f) + EPS);
        u32x4 res;
        res[0] = pack2(lo_bf(ov[u][0]) * rs * w0.x * silu_(lo_bf(gv[u][0])), hi_bf(ov[u][0]) * rs * w0.y * silu_(hi_bf(gv[u][0])));
        res[1] = pack2(lo_bf(ov[u][1]) * rs * w0.z * silu_(lo_bf(gv[u][1])), hi_bf(ov[u][1]) * rs * w0.w * silu_(hi_bf(gv[u][1])));
        res[2] = pack2(lo_bf(ov[u][2]) * rs * w1.x * silu_(lo_bf(gv[u][2])), hi_bf(ov[u][2]) * rs * w1.y * silu_(hi_bf(gv[u][2])));
        res[3] = pack2(lo_bf(ov[u][3]) * rs * w1.z * silu_(lo_bf(gv[u][3])), hi_bf(ov[u][3]) * rs * w1.w * silu_(hi_bf(gv[u][3])));
        *(u32x4*)(obuf + (size_t)t * 1024 + c8) = res;
      }
    }
  }
}

__device__ __forceinline__ void ph_lru_pass(const bool passB, const Params& P, char* smem) {
  bf16_t* sRaw = (bf16_t*)smem;
  bf16_t* sXc = (bf16_t*)(smem + 11808);
  constexpr int SPS = 100, SPG = 64 * SPS;
  float* sP = (float*)(smem + 25120);
  float* sCst = (float*)(smem + 76320);
  const bf16_t* xb = (const bf16_t*)(P.ws + L_XB);
  const bf16_t* gate = (const bf16_t*)(P.ws + L_GATE);
  bf16_t* ybuf = (bf16_t*)(P.ws + L_Y);
  float* Asum = (float*)(P.ws + L_ASEG);
  float* Hsum = (float*)(P.ws + L_HSEG);
  const bf16_t* WG = (const bf16_t*)(P.ws + OFF_WG);
  const float* st_conv = P.in[3];
  const float* st_h = P.in[4];
  const int tid = otid(), lane = tid & 63, wave = tid >> 6, r = lane & 15, q = lane >> 4;
  const int NIT = NCH * 16;
  const int per = (NIT + (int)gridDim.x - 1) / (int)gridDim.x;
  const int it_lo = blockIdx.x * per;
  const int it_hi = it_lo + per < NIT ? it_lo + per : NIT;
  const int gt = wave >> 1, mh = wave & 1;
  int kprev = -1;
  bf16x8 bw[3][6];
#pragma unroll
  for (int ks = 0; ks < 3; ++ks)
#pragma unroll
    for (int nt = 0; nt < 6; ++nt) bw[ks][nt] = bf16x8{0, 0, 0, 0, 0, 0, 0, 0};
  const int cg8 = tid % 11, crow = tid / 11;
  const int gg4 = tid % 22, grow = tid / 22;
  float cw[5][8];
  float gc[3][4];
#pragma unroll
  for (int a_ = 0; a_ < 5; ++a_)
#pragma unroll
    for (int e = 0; e < 8; ++e) cw[a_][e] = 0.f;
#pragma unroll
  for (int a_ = 0; a_ < 3; ++a_)
#pragma unroll
    for (int e = 0; e < 4; ++e) gc[a_][e] = 0.f;
  for (int idx = tid; idx < 64 * 8; idx += 256) sXc[(idx >> 3) * 104 + 88 + (idx & 7)] = 0;
  for (int it = it_lo; it < it_hi; ++it) {
    const int k = it / NCH, c = it - k * NCH;
    int t0, len;
    chunk_info(c, t0, len);
    const int b = c - 256;
    const bool has_prev = (c < 256) && (c > 0);
    const int ch = k * 88 + tid;
    u32x4 rraw[3], rgate[3];
#pragma unroll
    for (int i = 0; i < 3; ++i) {
      const int idx = tid + 256 * i, row = idx / 11, c16 = idx - row * 11;
      rraw[i] = u32x4{0u, 0u, 0u, 0u};
      rgate[i] = u32x4{0u, 0u, 0u, 0u};
      if (row < len + 3) {
        if (row >= 3 || has_prev) {
          rraw[i] = *(const u32x4*)(xb + (size_t)(t0 + row - 3) * LW + k * 88 + c16 * 8);
        } else if (c >= 256) {
          const float* sp = st_conv + ((size_t)b * 3 + row) * LW + k * 88 + c16 * 8;
          const float4 f0 = *(const float4*)sp, f1 = *(const float4*)(sp + 4);
          rraw[i] = u32x4{pack2(f0.x, f0.y), pack2(f0.z, f0.w), pack2(f1.x, f1.y), pack2(f1.z, f1.w)};
        }
      }
      if (passB && row < len) rgate[i] = *(const u32x4*)(gate + (size_t)(t0 + row) * LW + k * 88 + c16 * 8);
    }
    float hcur = 0.f, aprod = 1.f;
    if (passB && tid < 88) hcur = c < 256 ? Hsum[(size_t)c * LW + ch] : st_h[b * LW + ch];
    __syncthreads();
    if (k != kprev) {
      if (tid < 88) {
        sCst[0 * 96 + tid] = -8.f * softplus_(-P.in[21][ch]);
        sCst[1 * 96 + tid] = P.in[18][ch];
        sCst[2 * 96 + tid] = P.in[20][ch];
        sCst[3 * 96 + tid] = P.in[16][ch];
        sCst[4 * 96 + tid] = P.in[15][0 * LW + ch];
        sCst[5 * 96 + tid] = P.in[15][1 * LW + ch];
        sCst[6 * 96 + tid] = P.in[15][2 * LW + ch];
        sCst[7 * 96 + tid] = P.in[15][3 * LW + ch];
      }
      const bf16_t* Wt = WG + ((size_t)(gt * 16 + k) * 96) * 96;
#pragma unroll
      for (int ks = 0; ks < 3; ++ks)
#pragma unroll
        for (int nt = 0; nt < 6; ++nt) bw[ks][nt] = *(const bf16x8*)(Wt + (nt * 16 + r) * 96 + ks * 32 + q * 8);
    }
#pragma unroll
    for (int i = 0; i < 3; ++i) {
      const int idx = tid + 256 * i, row = idx / 11, c16 = idx - row * 11;
      if (row < 67) *(u32x4*)(sRaw + row * 88 + c16 * 8) = rraw[i];
    }
    __syncthreads();
    if (k != kprev) {
#pragma unroll
      for (int a_ = 0; a_ < 5; ++a_)
#pragma unroll
        for (int e = 0; e < 8; ++e) cw[a_][e] = sCst[(3 + a_) * 96 + cg8 * 8 + e];
#pragma unroll
      for (int a_ = 0; a_ < 3; ++a_)
#pragma unroll
        for (int e = 0; e < 4; ++e) gc[a_][e] = sCst[a_ * 96 + gg4 * 4 + e];
      kprev = k;
    }
    if (crow < 23) {
#pragma unroll
      for (int i = 0; i < 3; ++i) {
        const int j = crow + 23 * i;
        if (j < 64) {
          u32x4 o = u32x4{0u, 0u, 0u, 0u};
          if (j < len) {
            u32x4 rr[4];
#pragma unroll
            for (int kk = 0; kk < 4; ++kk) rr[kk] = *(const u32x4*)(sRaw + (j + kk) * 88 + cg8 * 8);
            float xc[8];
#pragma unroll
            for (int e = 0; e < 8; ++e) {
              float acc_ = cw[0][e];
#pragma unroll
              for (int kk = 0; kk < 4; ++kk) {
                const unsigned w_ = rr[kk][e >> 1];
                acc_ += cw[1 + kk][e] * ((e & 1) ? hi_bf(w_) : lo_bf(w_));
              }
              xc[e] = acc_;
            }
            o = u32x4{pack2(xc[0], xc[1]), pack2(xc[2], xc[3]), pack2(xc[4], xc[5]), pack2(xc[6], xc[7])};
          }
          *(u32x4*)(sXc + j * 104 + cg8 * 8) = o;
        }
      }
    }
    __syncthreads();
    {
      f32x4 acc[2][6];
#pragma unroll
      for (int mt = 0; mt < 2; ++mt)
#pragma unroll
        for (int nt = 0; nt < 6; ++nt) acc[mt][nt] = f32x4{0.f, 0.f, 0.f, 0.f};
#pragma unroll
      for (int ks = 0; ks < 3; ++ks) {
        bf16x8 af[2];
#pragma unroll
        for (int mt = 0; mt < 2; ++mt) af[mt] = *(const bf16x8*)(sXc + (32 * mh + mt * 16 + r) * 104 + ks * 32 + q * 8);
#pragma unroll
        for (int mt = 0; mt < 2; ++mt)
#pragma unroll
          for (int nt = 0; nt < 6; ++nt)
            acc[mt][nt] = __builtin_amdgcn_mfma_f32_16x16x32_bf16(bw[ks][nt], af[mt], acc[mt][nt], 0, 0, 0);
      }
#pragma unroll
      for (int mt = 0; mt < 2; ++mt)
#pragma unroll
        for (int nt = 0; nt < 6; ++nt)
          *(f32x4*)(sP + gt * SPG + (32 * mh + mt * 16 + r) * SPS + nt * 16 + q * 4) = acc[mt][nt];
    }
    __syncthreads();
    if (grow < 11) {
#pragma unroll
      for (int i = 0; i < 6; ++i) {
        const int j = grow + 11 * i;
        if (j < len) {
          const f32x4 pr = *(const f32x4*)(sP + j * SPS + gg4 * 4);
          const f32x4 pi = *(const f32x4*)(sP + SPG + j * SPS + gg4 * 4);
          const uint2 xu = *(const uint2*)(sXc + j * 104 + gg4 * 4);
          float xv[4];
          xv[0] = lo_bf(xu.x); xv[1] = hi_bf(xu.x); xv[2] = lo_bf(xu.y); xv[3] = hi_bf(xu.y);
          f32x4 av, uv;
#pragma unroll
          for (int e = 0; e < 4; ++e) {
            const float rr_ = sigmoid_(pr[e] + gc[1][e]), ii_ = sigmoid_(pi[e] + gc[2][e]);
            const float a = __expf(gc[0][e] * rr_);
            const float m = __builtin_amdgcn_sqrtf(fmaxf(1.f - a * a, 0.f));
            av[e] = a;
            uv[e] = m * ii_ * xv[e];
          }
          *(f32x4*)(sP + j * SPS + gg4 * 4) = av;
          *(f32x4*)(sP + SPG + j * SPS + gg4 * 4) = uv;
        }
      }
    }
    __syncthreads();
    if (tid < 88) {
#pragma unroll 8
      for (int j = 0; j < len; ++j) {
        const float a = sP[j * SPS + tid], u = sP[SPG + j * SPS + tid];
        hcur = a * hcur + u;
        aprod *= a;
        if (passB) sP[SPG + j * SPS + tid] = hcur;
      }
      if (!passB) {
        Asum[(size_t)c * LW + ch] = aprod;
        Hsum[(size_t)c * LW + ch] = hcur;
      } else if (c == 255) {
        P.out[O_LH_P + ch] = hcur;
#pragma unroll
        for (int kk = 0; kk < 3; ++kk) P.out[O_LCONV_P + kk * LW + ch] = bf2f(sRaw[(len + kk) * 88 + tid]);
      } else if (c >= 256) {
        P.out[O_LH_S + b * LW + ch] = hcur;
#pragma unroll
        for (int kk = 0; kk < 3; ++kk) P.out[O_LCONV_S + ((size_t)b * 3 + kk) * LW + ch] = bf2f(sRaw[(len + kk) * 88 + tid]);
      }
    }
    if (passB) {
      __syncthreads();
#pragma unroll
      for (int i = 0; i < 3; ++i) {
        const int idx = tid + 256 * i, row = idx / 11, c16 = idx - row * 11;
        if (row < len) {
          const float4 h0 = *(const float4*)(sP + SPG + row * SPS + c16 * 8);
          const float4 h1 = *(const float4*)(sP + SPG + row * SPS + c16 * 8 + 4);
          const u32x4 gv = rgate[i];
          u32x4 o;
          o[0] = pack2(h0.x * silu_(lo_bf(gv[0])), h0.y * silu_(hi_bf(gv[0])));
          o[1] = pack2(h0.z * silu_(lo_bf(gv[1])), h0.w * silu_(hi_bf(gv[1])));
          o[2] = pack2(h1.x * silu_(lo_bf(gv[2])), h1.y * silu_(hi_bf(gv[2])));
          o[3] = pack2(h1.z * silu_(lo_bf(gv[3])), h1.w * silu_(hi_bf(gv[3])));
          *(u32x4*)(ybuf + (size_t)(t0 + row) * LW + k * 88 + c16 * 8) = o;
        }
      }
    }
  }
}

__device__ __forceinline__ void ph_lru_scan(const Params& P, char* smem) {
  float* sA = (float*)smem;
  float* sH = sA + 256;
  const float* Asum = (const float*)(P.ws + L_ASEG);
  float* Hsum = (float*)(P.ws + L_HSEG);
  const int tid = otid(), seg = tid >> 4, chl = tid & 15;
  for (int it = blockIdx.x; it < LW / 16; it += gridDim.x) {
    const int ch = it * 16 + chl;
    float a[16], h[16];
#pragma unroll
    for (int i = 0; i < 16; ++i) {
      a[i] = Asum[(size_t)(seg * 16 + i) * LW + ch];
      h[i] = Hsum[(size_t)(seg * 16 + i) * LW + ch];
    }
    float A = 1.f, H = 0.f;
#pragma unroll
    for (int i = 0; i < 16; ++i) { H = a[i] * H + h[i]; A *= a[i]; }
    __syncthreads();
    sA[seg * 16 + chl] = A;
    sH[seg * 16 + chl] = H;
    __syncthreads();
    float hin = 0.f;
    for (int s2 = 0; s2 < seg; ++s2) hin = sA[s2 * 16 + chl] * hin + sH[s2 * 16 + chl];
#pragma unroll
    for (int i = 0; i < 16; ++i) {
      Hsum[(size_t)(seg * 16 + i) * LW + ch] = hin;
      hin = a[i] * hin + h[i];
    }
  }
}

__device__ __forceinline__ void ph_ssd_conv(const Params& P) {
  bf16_t* xbcT = (bf16_t*)(P.ws + S_XBCT);
  const bf16_t* tails = (const bf16_t*)(P.ws + S_TAIL);
  bf16_t* Brm = (bf16_t*)(P.ws + S_BRM);
  bf16_t* Crm = (bf16_t*)(P.ws + S_CRM);
  const float* cw = P.in[24];
  const float* cb = P.in[25];
  const float* st_conv = P.in[5];
  const int tid = otid();
  for (int it = blockIdx.x; it < NCH * 12; it += gridDim.x) {
    const int c = it / 12, part = it - c * 12, cc = part * 256 + tid;
    int t0, len;
    chunk_info(c, t0, len);
    const float w0 = cw[cc], w1 = cw[3072 + cc], w2 = cw[2 * 3072 + cc], w3 = cw[3 * 3072 + cc], bias = cb[cc];
    float a0 = 0.f, a1 = 0.f, a2 = 0.f;
    if (c >= 256) {
      const int b = c - 256;
      a0 = st_conv[((size_t)b * 3 + 0) * 3072 + cc];
      a1 = st_conv[((size_t)b * 3 + 1) * 3072 + cc];
      a2 = st_conv[((size_t)b * 3 + 2) * 3072 + cc];
    } else if (c > 0) {
      const uint2 tv = *(const uint2*)(tails + ((size_t)(c - 1) * 3072 + cc) * 4);
      a0 = hi_bf(tv.x); a1 = lo_bf(tv.y); a2 = hi_bf(tv.y);
    }
    bf16_t* rowp = xbcT + ((size_t)c * 3072 + cc) * 64;
    bf16_t* rm = nullptr;
    if (cc >= 2560) rm = Crm + (cc - 2560);
    else if (cc >= 2048) rm = Brm + (cc - 2048);
    u32x4 rw[8];
#pragma unroll
    for (int g = 0; g < 8; ++g) {
      rw[g] = u32x4{0u, 0u, 0u, 0u};
      if (g * 8 < len) rw[g] = *(const u32x4*)(rowp + g * 8);
    }
#pragma unroll
    for (int g = 0; g < 8; ++g) {
      if (g * 8 < len) {
        const int g8 = g * 8;
        const u32x4 u = rw[g];
        float x[8], y[8];
        x[0] = lo_bf(u[0]); x[1] = hi_bf(u[0]); x[2] = lo_bf(u[1]); x[3] = hi_bf(u[1]);
        x[4] = lo_bf(u[2]); x[5] = hi_bf(u[2]); x[6] = lo_bf(u[3]); x[7] = hi_bf(u[3]);
#pragma unroll
        for (int e = 0; e < 8; ++e) {
          const float yy = bias + w0 * a0 + w1 * a1 + w2 * a2 + w3 * x[e];
          a0 = a1; a1 = a2; a2 = x[e];
          y[e] = silu_(yy);
        }
        *(u32x4*)(rowp + g8) = u32x4{pack2(y[0], y[1]), pack2(y[2], y[3]), pack2(y[4], y[5]), pack2(y[6], y[7])};
        if (rm) {
#pragma unroll
          for (int e = 0; e < 8; ++e) rm[(size_t)(t0 + g8 + e) * 512] = f2bf(y[e]);
        }
      }
    }
    if (c >= 255) {
      const uint2 tv = *(const uint2*)(tails + ((size_t)c * 3072 + cc) * 4);
      float* dst = c == 255 ? P.out + O_SCONV_P : P.out + O_SCONV_S + (size_t)(c - 256) * 3 * 3072;
      dst[0 * 3072 + cc] = hi_bf(tv.x);
      dst[1 * 3072 + cc] = lo_bf(tv.y);
      dst[2 * 3072 + cc] = hi_bf(tv.y);
    }
  }
}

__device__ __forceinline__ void ph_ssd_pass(const bool passB, const Params& P, char* smem) {
  bf16_t* sC = (bf16_t*)(smem);
  bf16_t* sBT = (bf16_t*)(smem + 17408);
  bf16_t* sXT = (bf16_t*)(smem + 35840);
  bf16_t* sS = (bf16_t*)(smem + 45056);
  bf16_t* sXW = (bf16_t*)(smem + 62464);
  bf16_t* sW = (bf16_t*)(smem + 71680);
  bf16_t* sB = sXW;
  float* sCum = (float*)(smem + 80896);
  float* sDt = sCum + 64;
  bf16_t* zbuf = (bf16_t*)(P.ws + S_Z);
  const bf16_t* xbcT = (const bf16_t*)(P.ws + S_XBCT);
  const bf16_t* Brm = (const bf16_t*)(P.ws + S_BRM);
  const bf16_t* Crm = (const bf16_t*)(P.ws + S_CRM);
  const float* dtb = (const float*)(P.ws + S_DT);
  float* ssq = (float*)(P.ws + S_SSQ);
  float* Sseg = (float*)(P.ws + S_SSEG);
  float* cdseg = (float*)(P.ws + S_CDSEG);
  const float* st_in = P.in[6];
  const int tid = otid(), lane = tid & 63, wave = tid >> 6, r = lane & 15, q = lane >> 4;
  const int nitems = passB ? NSEGT_S * 32 : (NSEG_S - 1) * 32;
  for (int it = blockIdx.x; it < nitems; it += gridDim.x) {
    const int sg = it >> 5, hd = it & 31, g = hd >> 3;
    int c0, nch, b;
    seg_info(sg, NSEG_S, c0, nch, b);
    const float Ah = -__expf(P.in[27][hd]);
    const float Dh = P.in[28][hd];
    f32x4 accS[2][4];
#pragma unroll
    for (int mt = 0; mt < 2; ++mt)
#pragma unroll
      for (int nt = 0; nt < 4; ++nt) {
        const int s0 = 32 * wave + mt * 16 + q * 4, p = nt * 16 + r;
        if (!passB) accS[mt][nt] = f32x4{0.f, 0.f, 0.f, 0.f};
        else {
          const float* src = sg < NSEG_S ? Sseg + (((size_t)sg * 32 + hd) * 64 + p) * 128 + s0
                                       : st_in + (((size_t)b * 32 + hd) * 64 + p) * 128 + s0;
          const float4 t4 = *(const float4*)src;
          accS[mt][nt] = f32x4{t4.x, t4.y, t4.z, t4.w};
        }
      }
    float totcum = 0.f;
    u32x4 pb[4], px[2];
    float pdt = 0.f;
    const float dtbias = P.in[26][hd];
#define SSD_ISSUE(cc_)                                                                                          \
  {                                                                                                             \
    const int cx_ = (cc_);                                                                                      \
    const int lenx_ = cx_ < 256 ? 64 : 16;                                                                      \
    const int t0x_ = cx_ < 256 ? cx_ * 64 : T_P + (cx_ - 256) * 16;                                             \
    _Pragma("unroll") for (int i = 0; i < 4; ++i) {                                                             \
      const int id = tid + 256 * i, row = id >> 3, c16 = id & 7;                                                \
      pb[i] = u32x4{0u, 0u, 0u, 0u};                                                                            \
      if (c16 * 8 < lenx_) pb[i] = *(const u32x4*)(xbcT + ((size_t)cx_ * 3072 + 2048 + g * 128 + row) * 64 + c16 * 8); \
    }                                                                                                           \
    _Pragma("unroll") for (int i = 0; i < 2; ++i) {                                                             \
      const int id = tid + 256 * i, row = id >> 3, c16 = id & 7;                                                \
      px[i] = u32x4{0u, 0u, 0u, 0u};                                                                            \
      if (c16 * 8 < lenx_) px[i] = *(const u32x4*)(xbcT + ((size_t)cx_ * 3072 + hd * 64 + row) * 64 + c16 * 8);  \
    }                                                                                                           \
    pdt = 0.f;                                                                                                  \
    if (wave == 0 && lane < lenx_) pdt = dtb[(size_t)(t0x_ + lane) * 32 + hd];                                  \
  }
    SSD_ISSUE(c0)
    for (int ci = 0; ci < nch; ++ci) {
      const int c = c0 + ci;
      int t0, len;
      chunk_info(c, t0, len);
      __syncthreads();
      if (wave == 0) {
        const float dtv = lane < len ? softplus_(pdt + dtbias) : 0.f;
        float x = dtv * Ah;
#pragma unroll
        for (int off = 1; off < 64; off <<= 1) {
          const float y = __shfl_up(x, off);
          if (lane >= off) x += y;
        }
        sCum[lane] = x;
        sDt[lane] = dtv;
      }
#pragma unroll
      for (int i = 0; i < 4; ++i) {
        const int id = tid + 256 * i, row = id >> 3, c16 = id & 7;
        *(u32x4*)(sBT + row * 72 + c16 * 8) = pb[i];
      }
#pragma unroll
      for (int i = 0; i < 2; ++i) {
        const int id = tid + 256 * i, row = id >> 3, c16 = id & 7;
        *(u32x4*)(sXT + row * 72 + c16 * 8) = px[i];
      }
      if (passB) {
#pragma unroll
        for (int i = 0; i < 4; ++i) {
          const int id = tid + 256 * i, row = id >> 4, c16 = id & 15;
          uint4 vc = uint4{0u, 0u, 0u, 0u}, vb = uint4{0u, 0u, 0u, 0u};
          if (row < len) {
            const size_t a = (size_t)(t0 + row) * 512 + g * 128 + c16 * 8;
            vc = *(const uint4*)(Crm + a);
            vb = *(const uint4*)(Brm + a);
          }
          *(uint4*)(sC + row * 136 + c16 * 8) = vc;
          *(uint4*)(sB + row * 136 + c16 * 8) = vb;
        }
      }
      __syncthreads();
      if (ci + 1 < nch) SSD_ISSUE(c0 + ci + 1)
      const float cumlast = sCum[63];
      f32x4 cbm[1][4];
      if (passB) {
#pragma unroll
        for (int nt = 0; nt < 4; ++nt) cbm[0][nt] = f32x4{0.f, 0.f, 0.f, 0.f};
        mma_lds<1, 4, 4>(cbm, sC + (16 * wave) * 136, 136, sB, 136, r, q);
#pragma unroll
        for (int mt = 0; mt < 2; ++mt)
#pragma unroll
          for (int nt = 0; nt < 4; ++nt) {
            const int s0 = 32 * wave + mt * 16 + q * 4, p = nt * 16 + r;
            uint2 u;
            u.x = pack2(accS[mt][nt][0], accS[mt][nt][1]);
            u.y = pack2(accS[mt][nt][2], accS[mt][nt][3]);
            *(uint2*)(sS + p * 136 + s0) = u;
          }
        __syncthreads();
#pragma unroll
        for (int nt = 0; nt < 4; ++nt)
#pragma unroll
          for (int jj = 0; jj < 4; ++jj) {
            const int i = 16 * wave + q * 4 + jj, j = nt * 16 + r;
            float wv = 0.f;
            if (j <= i) wv = cbm[0][nt][jj] * __expf(sCum[i] - sCum[j]) * sDt[j];
            sW[i * 72 + j] = f2bf(wv);
          }
      }
#pragma unroll
      for (int i = 0; i < 2; ++i) {
        const int id = tid + 256 * i, p = id >> 3, j0 = (id & 7) * 8;
        const uint4 u = *(const uint4*)(sXT + p * 72 + j0);
        float wb[8];
#pragma unroll
        for (int e = 0; e < 8; ++e) wb[e] = __expf(cumlast - sCum[j0 + e]) * sDt[j0 + e];
        uint4 o;
        o.x = pack2(lo_bf(u.x) * wb[0], hi_bf(u.x) * wb[1]);
        o.y = pack2(lo_bf(u.y) * wb[2], hi_bf(u.y) * wb[3]);
        o.z = pack2(lo_bf(u.z) * wb[4], hi_bf(u.z) * wb[5]);
        o.w = pack2(lo_bf(u.w) * wb[6], hi_bf(u.w) * wb[7]);
        *(uint4*)(sXW + p * 72 + j0) = o;
      }
      __syncthreads();
      if (passB) {
        f32x4 y1[1][4], y2[1][4];
#pragma unroll
        for (int nt = 0; nt < 4; ++nt) { y1[0][nt] = f32x4{0.f, 0.f, 0.f, 0.f}; y2[0][nt] = f32x4{0.f, 0.f, 0.f, 0.f}; }
        mma_lds<1, 4, 2>(y1, sW + (16 * wave) * 72, 72, sXT, 72, r, q);
        mma_lds<1, 4, 4>(y2, sC + (16 * wave) * 136, 136, sS, 136, r, q);
        float ss[4] = {0.f, 0.f, 0.f, 0.f};
        float ec[4];
#pragma unroll
        for (int jj = 0; jj < 4; ++jj) ec[jj] = __expf(sCum[16 * wave + q * 4 + jj]);
#pragma unroll
        for (int nt = 0; nt < 4; ++nt) {
          const int p = nt * 16 + r;
          const uint2 xu = *(const uint2*)(sXT + p * 72 + 16 * wave + q * 4);
          float xv[4];
          xv[0] = lo_bf(xu.x); xv[1] = hi_bf(xu.x); xv[2] = lo_bf(xu.y); xv[3] = hi_bf(xu.y);
#pragma unroll
          for (int jj = 0; jj < 4; ++jj) {
            const int i = 16 * wave + q * 4 + jj;
            if (i < len) {
              const float yv = y1[0][nt][jj] + ec[jj] * y2[0][nt][jj] + Dh * xv[jj];
              const size_t a = (size_t)(t0 + i) * 2048 + hd * 64 + p;
              const float yz = yv * silu_(bf2f(zbuf[a]));
              zbuf[a] = f2bf(yz);
              ss[jj] += yz * yz;
            }
          }
        }
#pragma unroll
        for (int jj = 0; jj < 4; ++jj) {
          float s = ss[jj];
          s += __shfl_xor(s, 1);
          s += __shfl_xor(s, 2);
          s += __shfl_xor(s, 4);
          s += __shfl_xor(s, 8);
          const int i = 16 * wave + q * 4 + jj;
          if (r == 0 && i < len) ssq[(size_t)(t0 + i) * 32 + hd] = s;
        }
      }
      {
        const float cd = __expf(cumlast);
#pragma unroll
        for (int mt = 0; mt < 2; ++mt)
#pragma unroll
          for (int nt = 0; nt < 4; ++nt)
#pragma unroll
            for (int jj = 0; jj < 4; ++jj) accS[mt][nt][jj] *= cd;
        mma_lds<2, 4, 2>(accS, sBT + (32 * wave) * 72, 72, sXW, 72, r, q);
        totcum += cumlast;
      }
    }
#pragma unroll
    for (int mt = 0; mt < 2; ++mt)
#pragma unroll
      for (int nt = 0; nt < 4; ++nt) {
        const int s0 = 32 * wave + mt * 16 + q * 4, p = nt * 16 + r;
        float4 t4;
        t4.x = accS[mt][nt][0]; t4.y = accS[mt][nt][1]; t4.z = accS[mt][nt][2]; t4.w = accS[mt][nt][3];
        if (!passB) *(float4*)(Sseg + (((size_t)sg * 32 + hd) * 64 + p) * 128 + s0) = t4;
        else if (sg == NSEG_S - 1) *(float4*)(P.out + O_SH_P + ((size_t)hd * 64 + p) * 128 + s0) = t4;
        else if (sg >= NSEG_S) *(float4*)(P.out + O_SH_S + (((size_t)b * 32 + hd) * 64 + p) * 128 + s0) = t4;
      }
#undef SSD_ISSUE
    if (!passB && tid == 0) cdseg[sg * 32 + hd] = __expf(totcum);
  }
}

__device__ __forceinline__ void ph_ssd_scan(const Params& P) {
  float* Sseg = (float*)(P.ws + S_SSEG);
  const float* cdseg = (const float*)(P.ws + S_CDSEG);
  for (int idx = blockIdx.x * 256 + otid(); idx < 32 * 64 * 128; idx += gridDim.x * 256) {
    const int hd = idx >> 13;
    float tv[NSEG_S - 1], dv[NSEG_S - 1];
#pragma unroll
    for (int s2 = 0; s2 < NSEG_S - 1; ++s2) {
      tv[s2] = Sseg[(size_t)s2 * 262144 + idx];
      dv[s2] = cdseg[s2 * 32 + hd];
    }
    float cur = 0.f;
#pragma unroll
    for (int s2 = 0; s2 < NSEG_S; ++s2) {
      Sseg[(size_t)s2 * 262144 + idx] = cur;
      if (s2 < NSEG_S - 1) cur = dv[s2] * cur + tv[s2];
    }
  }
}

constexpr size_t OFF_BAR = 268435456ull - 4096;
#define XB_CNT(x) (32 + 32 * (x))
#define XB_SUB(x) (320 + 32 * (x))
#define XB_GEN(x) (608 + 32 * (x))
#define XB_TOP 896
#define XB_TOPGEN 928
__device__ __forceinline__ unsigned xb_ld(unsigned* p) { return __hip_atomic_load(p, __ATOMIC_RELAXED, __HIP_MEMORY_SCOPE_AGENT); }
__device__ __forceinline__ unsigned xb_add(unsigned* p, unsigned v) { return __hip_atomic_fetch_add(p, v, __ATOMIC_RELAXED, __HIP_MEMORY_SCOPE_AGENT); }
__device__ __forceinline__ void grid_barrier(unsigned* bar, char* smem) {
  asm volatile("s_waitcnt vmcnt(0)" ::: "memory");
  __syncthreads();
  if (otid() == 0) {
    volatile unsigned* st = (volatile unsigned*)(smem + SMEM_XB);
    const unsigned x = st[2];
    unsigned nloc = st[0], nx = st[1];
    if (nloc == 0u) {
      const unsigned G = gridDim.x;
      for (;;) {
        unsigned sum = 0u, cnt = 0u, mine = 0u;
#pragma unroll
        for (unsigned j = 0; j < 8; ++j) {
          const unsigned c = xb_ld(&bar[XB_CNT(j)]);
          sum += c;
          cnt += (c > 0u) ? 1u : 0u;
          mine = (j == x) ? c : mine;
        }
        if (sum == G) { nloc = mine; nx = cnt; break; }
        __builtin_amdgcn_s_sleep(1);
      }
      st[0] = nloc;
      st[1] = nx;
    }
    const unsigned old = xb_add(&bar[XB_SUB(x)], 1u);
    const unsigned gen = old / nloc;
    if (old + 1u == (gen + 1u) * nloc) {
      __builtin_amdgcn_fence(__ATOMIC_RELEASE, "agent");
      asm volatile("s_waitcnt vmcnt(0)" ::: "memory");
      const unsigned og = xb_add(&bar[XB_TOP], 1u);
      const unsigned tg = og / nx;
      if (og + 1u == (tg + 1u) * nx) xb_add(&bar[XB_TOPGEN], 1u);
      else while (xb_ld(&bar[XB_TOPGEN]) == tg) __builtin_amdgcn_s_sleep(1);
      __builtin_amdgcn_fence(__ATOMIC_ACQUIRE, "agent");
      xb_add(&bar[XB_GEN(x)], 1u);
      asm volatile("s_waitcnt vmcnt(0)" ::: "memory");
    } else {
      while (xb_ld(&bar[XB_GEN(x)]) == gen) __builtin_amdgcn_s_sleep(1);
      __builtin_amdgcn_fence(__ATOMIC_ACQUIRE, "agent");
      asm volatile("s_waitcnt vmcnt(0)" ::: "memory");
    }
  }
  __syncthreads();
}

constexpr int NPH = 30;

__device__ __forceinline__ void run_gla(const int sub, const int layer, const int li, const Params& P, char* smem) {
  const float* xin_p = li == 0 ? P.in[0] : P.out + O_YP;
  const float* xin_s = li == 0 ? P.in[1] : P.out + O_YS;
  bf16_t* Win = (bf16_t*)(P.ws + OFF_WIN);
  bf16_t* Wout = (bf16_t*)(P.ws + (layer == 0 ? OFF_WOUT : OFF_WOUT1));
  bf16_t* H = (bf16_t*)(P.ws + OFF_H);
  switch (sub) {
    case 0:
      if (li == 0) {
        ph_convT(P.in[9], 1024, 3088, 3136, Win, nullptr, smem);
        ph_convT(P.in[13], 1024, 1024, 1024, Wout, nullptr, smem);
      }
      ph_norm(xin_p, xin_s, P.in[7] + li * 1024, H, li == 0 ? P.out : nullptr);
      break;
    case 1: {
      EpiGlaIn e{(bf16_t*)(P.ws + G_QD), (bf16_t*)(P.ws + G_KD), (bf16_t*)(P.ws + G_VT), (bf16_t*)(P.ws + G_G),
                 (float*)(P.ws + G_GLR)};
      gemm_phase(H, 1024, Win, 1024, 1024, 3088, e, smem);
    } break;
    case 2: ph_gla_prep(P, layer, smem); break;
    case 3: ph_gla_pass(false, layer, P, smem); break;
    case 4:
      ph_gla_scan(P);
      if (layer == 0) {
        ph_convT(P.in[14], 1024, 2816, 2816, Win, nullptr, smem);
        ph_convT(P.in[22], 1408, 1024, 1024, (bf16_t*)(P.ws + OFF_WOUT1), nullptr, smem);
        ph_conv_gate(P.in[17], (bf16_t*)(P.ws + OFF_WG));
        ph_conv_gate(P.in[19], (bf16_t*)(P.ws + OFF_WG) + 16 * 96 * 96);
      }
      break;
    case 5: ph_gla_pass(true, layer, P, smem); break;
    case 6: ph_gla_aprep(P, layer); break;
    case 7: {
      EpiResid e{xin_p, xin_s, P.out};
      gemm_phase((const bf16_t*)(P.ws + G_O), 1024, Wout, 1024, 1024, 1024, e, smem);
    } break;
  }
}

__device__ __forceinline__ void run_phase(const int ph, const Params& P, char* smem) {
  bf16_t* Win = (bf16_t*)(P.ws + OFF_WIN);
  bf16_t* Wout = (bf16_t*)(P.ws + OFF_WOUT);
  bf16_t* H = (bf16_t*)(P.ws + OFF_H);
  const float* xin_p = P.out + O_YP;
  const float* xin_s = P.out + O_YS;
  if (ph < 8) { run_gla(ph, 0, 0, P, smem); return; }
  if (ph >= 21 && ph < 29) { run_gla(ph - 21, 1, 3, P, smem); return; }
  switch (ph) {
    case 8:
      ph_norm(xin_p, xin_s, P.in[7] + 1 * 1024, H, nullptr);
      break;
    case 9: {
      EpiLruIn e{(bf16_t*)(P.ws + L_XB), (bf16_t*)(P.ws + L_GATE)};
      gemm_phase(H, 1024, Win, 1024, 1024, 2816, e, smem);
    } break;
    case 10: ph_lru_pass(false, P, smem); break;
    case 11:
      ph_lru_scan(P, smem);
      ph_convT(P.in[23], 1024, 5152, 5184, Win, nullptr, smem);
      ph_convT(P.in[30], 2048, 1024, 1024, Wout, P.in[29], smem);
      break;
    case 12: ph_lru_pass(true, P, smem); break;
    case 13: {
      EpiResid e{xin_p, xin_s, P.out};
      gemm_phase((const bf16_t*)(P.ws + L_Y), LW, (const bf16_t*)(P.ws + OFF_WOUT1), LW, LW, 1024, e, smem);
    } break;
    case 14:
      ph_norm(xin_p, xin_s, P.in[7] + 2 * 1024, H, nullptr);
      break;
    case 15: {
      EpiSsdIn e{(bf16_t*)(P.ws + S_Z), (bf16_t*)(P.ws + S_XBCT), (bf16_t*)(P.ws + S_TAIL), (float*)(P.ws + S_DT), P.in[26]};
      gemm_phase(H, 1024, Win, 1024, 1024, 5152, e, smem);
    } break;
    case 16: ph_ssd_conv(P); break;
    case 17: ph_ssd_pass(false, P, smem); break;
    case 18:
      ph_ssd_scan(P);
      ph_convT(P.in[9] + (size_t)1024 * 3088, 1024, 3088, 3136, Win, nullptr, smem);
      ph_convT(P.in[13] + (size_t)1024 * 1024, 1024, 1024, 1024, (bf16_t*)(P.ws + OFF_WOUT1), nullptr, smem);
      break;
    case 19: ph_ssd_pass(true, P, smem); break;
    case 20: {
      EpiResidScaled e{xin_p, xin_s, P.out, (const float*)(P.ws + S_SSQ), 0.f, 0.f, 0};
      gemm_phase((const bf16_t*)(P.ws + S_Z), 2048, Wout, 2048, 2048, 1024, e, smem);
    } break;
    case 29: ph_final_norm(P.out, P.in[8]); break;
    default: break;
  }
}

__global__ void __launch_bounds__(256, 2) mega(Params P) {
  __shared__ __attribute__((aligned(16))) char smem[SMEM_BYTES];
  unsigned* bar = (unsigned*)(P.ws + OFF_BAR);
  if (threadIdx.x == 0) {
    const unsigned xcc = (unsigned)__builtin_amdgcn_s_getreg((3 << 11) | 20) & 7u;
    (void)xb_add(&bar[XB_CNT(xcc)], 1u);
    volatile unsigned* st = (volatile unsigned*)(smem + SMEM_XB);
    st[0] = 0u; st[1] = 0u; st[2] = xcc;
  }
  __syncthreads();
  if (P.out == nullptr) cg::this_grid().sync();
#define PRE(n) if (PREMASK & (1u << (n))) { run_phase((n), P, smem); grid_barrier(bar, smem); }
  PRE(0) PRE(1) PRE(2) PRE(3) PRE(4) PRE(5) PRE(6) PRE(7) PRE(8) PRE(9)
  PRE(10) PRE(11) PRE(12) PRE(13) PRE(14) PRE(15) PRE(16) PRE(17) PRE(18) PRE(19)
  PRE(20) PRE(21) PRE(22) PRE(23) PRE(24) PRE(25) PRE(26) PRE(27) PRE(28) PRE(29)
#undef PRE
#define PHASE(n) { if ((n) > 0 || PREMASK) grid_barrier(bar, smem); run_phase((n), P, smem); if (DUPMASK & (1u << (n))) { grid_barrier(bar, smem); run_phase((n), P, smem); } }
  PHASE(0) PHASE(1) PHASE(2) PHASE(3) PHASE(4) PHASE(5) PHASE(6) PHASE(7) PHASE(8) PHASE(9)
  PHASE(10) PHASE(11) PHASE(12) PHASE(13) PHASE(14) PHASE(15) PHASE(16) PHASE(17) PHASE(18) PHASE(19)
  PHASE(20) PHASE(21) PHASE(22) PHASE(23) PHASE(24) PHASE(25) PHASE(26) PHASE(27) PHASE(28) PHASE(29)
#undef PHASE
}

extern "C" void kernel_launch(void* const* d_in, const int* in_sizes, int n_in, void* d_out, int out_size, void* d_ws,
                              size_t ws_size, hipStream_t stream) {
  Params P{};
  for (int i = 0; i < 31; ++i) P.in[i] = (const float*)d_in[i];
  P.out = (float*)d_out;
  P.ws = (char*)d_ws;
  static int grid = 0;
  void* args[] = {&P};
  (void)hipMemsetAsync(P.ws + OFF_BAR, 0, 4096, stream);
  if (!grid) {
    int dev = 0, cus = 0;
    (void)hipGetDevice(&dev);
    (void)hipDeviceGetAttribute(&cus, hipDeviceAttributeMultiprocessorCount, dev);
    grid = cus * 2;
    hipError_t e0 = hipLaunchCooperativeKernel((void*)mega, dim3(grid), dim3(256), args, 0, stream);
    if (e0 != hipSuccess) {
      (void)hipGetLastError();
      grid = cus;
      e0 = hipLaunchCooperativeKernel((void*)mega, dim3(grid), dim3(256), args, 0, stream);
      if (e0 != hipSuccess) fprintf(stderr, "cooperative launch failed: %s (grid %d)\n", hipGetErrorString(e0), grid);
    }
    return;
  }
  hipError_t e = hipLaunchCooperativeKernel((void*)mega, dim3(grid), dim3(256), args, 0, stream);
  if (e != hipSuccess) fprintf(stderr, "cooperative launch failed: %s (grid %d)\n", hipGetErrorString(e), grid);
}
```
